# Optimizing an MI355X kernel written in HIP

```python
import jax
import jax.numpy as jnp
from jax import lax
import numpy as np

D_MODEL = 1024
BATCH = 8
SEQ = 2048
DEPTH = 2

GRID_W = 64
CTX_LEN = 256
N_ADA = 9
D_FF = 2816
NORM_EPS = 1e-6

RET_HEADS = 8
RET_QK_DIM = 64
RET_V_DIM = 128
RET_CHUNK = 128
RET_ROPE_BASE = 10000.0

ATT_HEADS = 8
ATT_KV_HEADS = 2
ATT_HEAD_DIM = 64
ATT_GROUP = ATT_HEADS // ATT_KV_HEADS
WINDOW = 128
ATT_BLOCK = 128
ROPE_BASE = 10000.0

RWKV_HEADS = 8
RWKV_HEAD_DIM = 64
DECAY_LORA = 64
AAA_LORA = 64
MV_LORA = 32
GATE_LORA = 128
RWKV_GN_EPS = 64e-5
RWKV_DECAY_SCALE = 0.6065306597126334

RET_QK_W = RET_HEADS * RET_QK_DIM
RET_V_W = RET_HEADS * RET_V_DIM
ATT_Q_W = ATT_HEADS * ATT_HEAD_DIM
ATT_KV_W = ATT_KV_HEADS * ATT_HEAD_DIM
RWKV_W = RWKV_HEADS * RWKV_HEAD_DIM
RWKV_SPLITS = (RWKV_W, RWKV_W, RWKV_W, DECAY_LORA, DECAY_LORA, AAA_LORA, AAA_LORA, GATE_LORA)
RWKV_IN = sum(RWKV_SPLITS)
N_BRANCH = 3
IN_SPLITS = (RET_QK_W, RET_QK_W, RET_V_W, RET_V_W, ATT_Q_W, ATT_KV_W, ATT_KV_W, RWKV_IN, N_BRANCH * D_MODEL)
N_IN = sum(IN_SPLITS)

kernel_name = 'hybrid_retention_swa_rwkv7_macaron_dit'


def split_cols(t, sizes):
    idx = np.cumsum(sizes)[:-1].tolist()
    return jnp.split(t, idx, axis=-1)


def split_heads(t, n_heads):
    return t.reshape(t.shape[0], t.shape[1], n_heads, -1)


def rms_norm(x, w, eps=NORM_EPS):
    xf = x.astype(jnp.float32)
    y = xf * lax.rsqrt(jnp.mean(jnp.square(xf), -1, keepdims=True) + eps)
    return (y * w.astype(jnp.float32)).astype(x.dtype)


def head_layer_norm(x, eps):
    xf = x.astype(jnp.float32)
    mu = jnp.mean(xf, -1, keepdims=True)
    var = jnp.mean(jnp.square(xf - mu), -1, keepdims=True)
    return (xf - mu) * lax.rsqrt(var + eps)


def modulate(h, shift, scale):
    return h * (1.0 + scale) + shift


def swiglu(h, w_in, w_out):
    gate, up = jnp.split(h @ w_in, 2, axis=-1)
    return (jax.nn.silu(gate) * up) @ w_out


def ffn_sublayer(x, mod, base, norm_w, w_in, w_out):
    h = modulate(rms_norm(x, norm_w), mod[:, :, base], mod[:, :, base + 1])
    return x + 0.5 * mod[:, :, base + 2] * swiglu(h, w_in, w_out)


def rope_angles_1d(pos, dim, base):
    n_freq = dim // 2
    inv = jnp.power(base, -(jnp.arange(n_freq, dtype=jnp.float32) / n_freq))
    return pos.astype(jnp.float32)[:, None] * inv[None, :]


def axial_rope_angles(rows, dim):
    row = jnp.repeat(jnp.arange(rows), GRID_W)
    col = jnp.arange(rows * GRID_W) % GRID_W
    return jnp.concatenate([rope_angles_1d(row, dim // 2, ROPE_BASE),
                            rope_angles_1d(col, dim // 2, ROPE_BASE)], -1)


def apply_rope(t, ang):
    half = t.shape[-1] // 2
    cos = jnp.cos(ang)[:, None, :]
    sin = jnp.sin(ang)[:, None, :]
    t1, t2 = t[..., :half], t[..., half:]
    return jnp.concatenate([t1 * cos - t2 * sin, t1 * sin + t2 * cos], -1)


def flip_seq(t):
    return jnp.flip(t, axis=2)


def centred_conv3(t, w):
    zero = jnp.zeros_like(t[:, :1])
    prev = jnp.concatenate([zero, t[:, :-1]], 1)
    nxt = jnp.concatenate([t[:, 1:], zero], 1)
    return prev * w[0] + t * w[1] + nxt * w[2]


def retention_qkv(q, k, v, ang):
    f32 = jnp.float32
    q = apply_rope(split_heads(q, RET_HEADS).astype(f32), ang)
    k = apply_rope(split_heads(k, RET_HEADS).astype(f32), ang) * (RET_QK_DIM ** -0.5)
    v = split_heads(v, RET_HEADS).astype(f32)
    return q.transpose(0, 2, 1, 3), k.transpose(0, 2, 1, 3), v.transpose(0, 2, 1, 3)


def retention_direction(q, k, v, log_g, s0):
    b, h, n, dk = q.shape
    dv = v.shape[-1]
    nc = n // RET_CHUNK
    qc = q.reshape(b, h, nc, RET_CHUNK, dk)
    kc = k.reshape(b, h, nc, RET_CHUNK, dk)
    vc = v.reshape(b, h, nc, RET_CHUNK, dv)
    pos = jnp.arange(RET_CHUNK, dtype=jnp.float32)
    lg = log_g[:, None]
    diff = pos[:, None] - pos[None, :]
    decay_in = jnp.where(diff >= 0, jnp.exp(lg[:, :, None] * jnp.maximum(diff, 0.0)), 0.0)
    zeta = jnp.exp(lg * (RET_CHUNK - 1.0 - pos))
    xi = jnp.exp(lg * (pos + 1.0))
    chunk_decay = jnp.exp(log_g * RET_CHUNK)[None, :, None, None]
    u = jnp.einsum('bhcmk,hm,bhcmv->bhckv', kc, zeta, vc)

    def step(state, u_c):
        return chunk_decay * state + u_c, state

    s_last, s_prev = lax.scan(step, s0, jnp.moveaxis(u, 2, 0))
    s_prev = jnp.moveaxis(s_prev, 0, 2)
    scores = jnp.einsum('bhcjk,bhcmk->bhcjm', qc, kc) * decay_in[None, :, None]
    out = (jnp.einsum('bhcjm,bhcmv->bhcjv', scores, vc)
           + jnp.einsum('bhcjk,bhckv->bhcjv', qc, s_prev) * xi[None, :, None, :, None])
    return out.reshape(b, h, n, dv), s_last


def retention_output(o, g):
    y = head_layer_norm(o, NORM_EPS).transpose(0, 2, 1, 3)
    y = y.reshape(y.shape[0], y.shape[1], RET_V_W)
    return (jax.nn.silu(g.astype(jnp.float32)) * y).astype(g.dtype)


def attention_qkv(q, k, v, p, ang):
    f32 = jnp.float32
    q = rms_norm(split_heads(q, ATT_HEADS), p['q_norm']).astype(f32)
    k = rms_norm(split_heads(k, ATT_KV_HEADS), p['k_norm']).astype(f32)
    if ang is not None:
        q = apply_rope(q, ang)
        k = apply_rope(k, ang)
    b, n = q.shape[:2]
    q = q.reshape(b, n, ATT_KV_HEADS, ATT_GROUP, ATT_HEAD_DIM).transpose(0, 2, 3, 1, 4)
    k = k.transpose(0, 2, 1, 3)
    v = split_heads(v, ATT_KV_HEADS).astype(f32).transpose(0, 2, 1, 3)
    return q, k, v


def window_context_attention(q, k, v, kc, vc, sink):
    b, hk, g, n, d = q.shape
    nb = n // ATT_BLOCK
    halo = WINDOW // ATT_BLOCK
    span = (2 * halo + 1) * ATT_BLOCK
    pad = ((0, 0), (0, 0), (halo * ATT_BLOCK, halo * ATT_BLOCK), (0, 0))
    kb = jnp.pad(k, pad).reshape(b, hk, nb + 2 * halo, ATT_BLOCK, d)
    vb = jnp.pad(v, pad).reshape(b, hk, nb + 2 * halo, ATT_BLOCK, d)
    kwin = jnp.concatenate([kb[:, :, o:o + nb] for o in range(2 * halo + 1)], axis=3)
    vwin = jnp.concatenate([vb[:, :, o:o + nb] for o in range(2 * halo + 1)], axis=3)
    qb = q.reshape(b, hk, g, nb, ATT_BLOCK, d)
    scale = d ** -0.5
    s_win = jnp.einsum('bhgnqd,bhnkd->bhgnqk', qb, kwin) * scale
    qi = jnp.arange(ATT_BLOCK)
    kj = jnp.arange(span)
    rel = kj[None, :] - halo * ATT_BLOCK - qi[:, None]
    kpos = (jnp.arange(nb)[:, None] - halo) * ATT_BLOCK + kj[None, :]
    valid = (jnp.abs(rel) <= WINDOW)[None] & ((kpos >= 0) & (kpos < n))[:, None, :]
    s_win = jnp.where(valid, s_win, -jnp.inf)
    s_ctx = jnp.einsum('bhgnqd,bhld->bhgnql', qb, kc) * scale
    s_sink = jnp.broadcast_to(sink[None, :, :, None, None, None], s_win.shape[:-1] + (1,))
    prob = jax.nn.softmax(jnp.concatenate([s_win, s_ctx, s_sink], -1), axis=-1)
    n_ctx = kc.shape[2]
    out = (jnp.einsum('bhgnqk,bhnkd->bhgnqd', prob[..., :span], vwin)
           + jnp.einsum('bhgnql,bhld->bhgnqd', prob[..., span:span + n_ctx], vc))
    return out.reshape(b, hk, g, n, d)


def context_attention(q, k, v, sink):
    s = jnp.einsum('bhgqd,bhkd->bhgqk', q, k) * (q.shape[-1] ** -0.5)
    s_sink = jnp.broadcast_to(sink[None, :, :, None, None], s.shape[:-1] + (1,))
    prob = jax.nn.softmax(jnp.concatenate([s, s_sink], -1), axis=-1)
    return jnp.einsum('bhgqk,bhkd->bhgqd', prob[..., :-1], v)


def merge_att_heads(o, dtype):
    b, hk, g, n, d = o.shape
    return o.transpose(0, 3, 1, 2, 4).reshape(b, n, ATT_Q_W).astype(dtype)


def rwkv_prepare(cols, h, v_first, p):
    f32 = jnp.float32

    def heads(t):
        return split_heads(t, RWKV_HEADS).astype(f32)

    cols = centred_conv3(cols, p['shift'])
    r, k, v, wd_f, wd_b, ad_f, ad_b, gd = split_cols(cols, RWKV_SPLITS)
    if v_first is None:
        v_first = v
    else:
        v = v + (v_first - v) * jax.nn.sigmoid(p['v0'] + (h @ p['v_down']) @ p['v_up'])
    g = jax.nn.sigmoid(gd) @ p['g_up']
    kk = heads(k * p['k_k'])
    kk = kk / jnp.maximum(jnp.sqrt(jnp.sum(kk * kk, -1, keepdims=True)), 1e-12)
    dirs = []
    for i, (wd, ad) in enumerate(((wd_f, ad_f), (wd_b, ad_b))):
        z = (p['w0'][i] + jnp.tanh(wd) @ p['w_up'][i]).astype(f32)
        w = jnp.exp(-RWKV_DECAY_SCALE * jax.nn.sigmoid(z))
        a = jax.nn.sigmoid(p['a0'][i] + ad @ p['a_up'][i])
        k_d = k * (1.0 + (a - 1.0) * p['k_a'])
        dirs.append((heads(w), heads(k_d), heads(a)))
    return heads(r), heads(v), kk, g, dirs, v_first


def rwkv7_scan(r, w, k, a, v, kk, s0, reverse):
    def step(S, inp):
        r_t, w_t, k_t, a_t, v_t, kk_t = inp
        sa = -jnp.einsum('bhvk,bhk->bhv', S, kk_t)
        S = (S * w_t[:, :, None, :] + sa[..., None] * (kk_t * a_t)[:, :, None, :]
             + v_t[..., None] * k_t[:, :, None, :])
        return S, jnp.einsum('bhvk,bhk->bhv', S, r_t)

    xs = tuple(jnp.moveaxis(t, 1, 0) for t in (r, w, k, a, v, kk))
    S, ys = lax.scan(step, s0, xs, reverse=reverse)
    return jnp.moveaxis(ys, 0, 1), S


def rwkv_output(y, r, v, dirs, g, p):
    b, n = y.shape[:2]
    yn = head_layer_norm(y, RWKV_GN_EPS).reshape(b, n, RWKV_W) * p['gn_w'] + p['gn_b']
    (_, k_f, _), (_, k_b, _) = dirs
    bonus = (jnp.sum(r * k_f * p['r_k'], -1, keepdims=True)
             + jnp.sum(r * k_b * p['r_k'], -1, keepdims=True)) * v
    return ((yn + bonus.reshape(b, n, RWKV_W)) * g).astype(g.dtype)


def branch_merge(ret, att, rw, gate_logits, p):
    g_ret, g_att, g_rw = jnp.split(jax.nn.sigmoid(gate_logits), N_BRANCH, axis=-1)
    merged = g_ret * (ret @ p['w_ret']) + g_att * (att @ p['w_att']) + g_rw * (rw @ p['w_rwkv'])
    return merged @ p['w_out']


def token_mixing(hx, hs, p, v_first, att_ang, ret_ang_x, ret_ang_s, want_ctx):
    f32 = jnp.float32
    bsz = hx.shape[0]
    cols_x = split_cols(hx @ p['w_in'], IN_SPLITS)
    cols_s = split_cols(hs @ p['w_in'], IN_SPLITS)

    log_g = jax.nn.log_sigmoid(p['ret_decay_logit'].astype(f32))
    qx, kx, vx = retention_qkv(cols_x[0], cols_x[1], cols_x[2], ret_ang_x)
    qs, ks, vs = retention_qkv(cols_s[0], cols_s[1], cols_s[2], ret_ang_s)
    zero_ret = jnp.zeros((bsz, RET_HEADS, RET_QK_DIM, RET_V_DIM), f32)
    os_f, st_f = retention_direction(qs, ks, vs, log_g[0], zero_ret)
    os_b, st_b = retention_direction(flip_seq(qs), flip_seq(ks), flip_seq(vs), log_g[1], zero_ret)
    ox_f, _ = retention_direction(qx, kx, vx, log_g[0], st_f)
    ox_b, _ = retention_direction(flip_seq(qx), flip_seq(kx), flip_seq(vx), log_g[1], st_b)
    ret_x = retention_output(ox_f + flip_seq(ox_b), cols_x[3])

    sink = p['att_sink'].astype(f32).reshape(ATT_KV_HEADS, ATT_GROUP)
    aqx, akx, avx = attention_qkv(cols_x[4], cols_x[5], cols_x[6], p, att_ang)
    aqs, aks, avs = attention_qkv(cols_s[4], cols_s[5], cols_s[6], p, None)
    att_x = merge_att_heads(window_context_attention(aqx, akx, avx, aks, avs, sink), hx.dtype)

    r_x, v_x, kk_x, g_x, dirs_x, vf_x = rwkv_prepare(cols_x[7], hx, v_first[0], p)
    r_s, v_s, kk_s, g_s, dirs_s, vf_s = rwkv_prepare(cols_s[7], hs, v_first[1], p)
    zero_rw = jnp.zeros((bsz, RWKV_HEADS, RWKV_HEAD_DIM, RWKV_HEAD_DIM), f32)
    ys_f, S_f = rwkv7_scan(r_s, *dirs_s[0], v_s, kk_s, zero_rw, False)
    ys_b, S_b = rwkv7_scan(r_s, *dirs_s[1], v_s, kk_s, zero_rw, True)
    yx_f, _ = rwkv7_scan(r_x, *dirs_x[0], v_x, kk_x, S_f, False)
    yx_b, _ = rwkv7_scan(r_x, *dirs_x[1], v_x, kk_x, S_b, True)
    rwkv_x = rwkv_output(yx_f + yx_b, r_x, v_x, dirs_x, g_x, p)

    out_x = branch_merge(ret_x, att_x, rwkv_x, cols_x[8], p)
    out_s = None
    if want_ctx:
        ret_s = retention_output(os_f + flip_seq(os_b), cols_s[3])
        att_s = merge_att_heads(context_attention(aqs, aks, avs, sink), hs.dtype)
        rwkv_s = rwkv_output(ys_f + ys_b, r_s, v_s, dirs_s, g_s, p)
        out_s = branch_merge(ret_s, att_s, rwkv_s, cols_s[8], p)
    return out_x, out_s, (vf_x, vf_s)


def setup_inputs(seed: int = 0) -> dict:
    key = jax.random.key(seed)
    keys = iter(jax.random.split(key, 48))
    f32 = jnp.float32

    def nrm(shape, scale):
        return jax.random.normal(next(keys), shape, f32) * scale

    D = D_MODEL
    h_idx = jnp.arange(RET_HEADS, dtype=f32)
    ret_logit = jnp.log(jnp.exp2(5.0 + h_idx) - 1.0)
    ratio = jnp.linspace(0.0, 1.0, RWKV_W, dtype=f32)
    w0_base = -6.5 + 5.0 * ratio ** 0.85
    shift_base = jnp.array([0.25, 0.5, 0.25], f32)[None, :, None]
    return {
        'x': nrm((BATCH, SEQ, D), 1.0),
        'c': nrm((BATCH, D), 1.0),
        'ctx': nrm((BATCH, CTX_LEN, D), 1.0),
        'c_ctx': nrm((D,), 1.0),
        'ada_w': nrm((DEPTH, D, N_ADA * D), 0.5 * D ** -0.5),
        'ada_b': nrm((DEPTH, N_ADA * D), 0.02),
        'norm_w': 1.0 + nrm((DEPTH, 3, D), 0.05),
        'ffn1_w_in': nrm((DEPTH, D, 2 * D_FF), D ** -0.5),
        'ffn1_w_out': nrm((DEPTH, D_FF, D), D_FF ** -0.5),
        'ffn2_w_in': nrm((DEPTH, D, 2 * D_FF), D ** -0.5),
        'ffn2_w_out': nrm((DEPTH, D_FF, D), D_FF ** -0.5),
        'mix_w_in': nrm((DEPTH, D, N_IN), D ** -0.5),
        'ret_decay_logit': ret_logit[None, None, :] + nrm((DEPTH, 2, RET_HEADS), 0.05),
        'att_q_norm': 1.0 + nrm((DEPTH, ATT_HEAD_DIM), 0.05),
        'att_k_norm': 1.0 + nrm((DEPTH, ATT_HEAD_DIM), 0.05),
        'att_sink': nrm((DEPTH, ATT_HEADS), 0.5),
        'rwkv_shift': shift_base + nrm((DEPTH, 3, RWKV_IN), 0.05),
        'rwkv_w0': w0_base + nrm((DEPTH, 2, RWKV_W), 0.1),
        'rwkv_w_up': nrm((DEPTH, 2, DECAY_LORA, RWKV_W), 0.5 * DECAY_LORA ** -0.5),
        'rwkv_a0': nrm((DEPTH, 2, RWKV_W), 0.1),
        'rwkv_a_up': nrm((DEPTH, 2, AAA_LORA, RWKV_W), 0.5 * AAA_LORA ** -0.5),
        'rwkv_g_up': nrm((DEPTH, GATE_LORA, RWKV_W), GATE_LORA ** -0.5),
        'rwkv_k_k': 0.85 + nrm((DEPTH, RWKV_W), 0.02),
        'rwkv_k_a': 1.0 + nrm((DEPTH, RWKV_W), 0.02),
        'rwkv_r_k': -0.04 + nrm((DEPTH, RWKV_HEADS, RWKV_HEAD_DIM), 0.02),
        'rwkv_v0': 1.0 + nrm((DEPTH - 1, RWKV_W), 0.1),
        'rwkv_v_down': nrm((DEPTH - 1, D, MV_LORA), D ** -0.5),
        'rwkv_v_up': nrm((DEPTH - 1, MV_LORA, RWKV_W), MV_LORA ** -0.5),
        'rwkv_gn_w': 1.0 + nrm((DEPTH, RWKV_W), 0.05),
        'rwkv_gn_b': nrm((DEPTH, RWKV_W), 0.01),
        'w_branch_ret': nrm((DEPTH, RET_V_W, D), RET_V_W ** -0.5),
        'w_branch_att': nrm((DEPTH, ATT_Q_W, D), ATT_Q_W ** -0.5),
        'w_branch_rwkv': nrm((DEPTH, RWKV_W, D), RWKV_W ** -0.5),
        'w_out': nrm((DEPTH, D, D), D ** -0.5),
    }


def reference(x, c, ctx, c_ctx, ada_w, ada_b, norm_w, ffn1_w_in, ffn1_w_out, ffn2_w_in, ffn2_w_out,
              mix_w_in, ret_decay_logit, att_q_norm, att_k_norm, att_sink, rwkv_shift, rwkv_w0, rwkv_w_up,
              rwkv_a0, rwkv_a_up, rwkv_g_up, rwkv_k_k, rwkv_k_a, rwkv_r_k, rwkv_v0, rwkv_v_down, rwkv_v_up,
              rwkv_gn_w, rwkv_gn_b, w_branch_ret, w_branch_att, w_branch_rwkv, w_out):
    n_lat = x.shape[1]
    n_ctx = ctx.shape[1]
    rows = n_lat // GRID_W
    att_ang = axial_rope_angles(rows, ATT_HEAD_DIM)
    ret_ang_s = rope_angles_1d(jnp.arange(n_ctx), RET_QK_DIM, RET_ROPE_BASE)
    ret_ang_x = rope_angles_1d(n_ctx + jnp.arange(n_lat), RET_QK_DIM, RET_ROPE_BASE)
    cond_x = jax.nn.silu(c)[:, None, :]
    cond_s = jax.nn.silu(c_ctx)[None, None, :]
    s = ctx
    v_first = (None, None)
    for l in range(DEPTH):
        last = l == DEPTH - 1
        mod_x = (cond_x @ ada_w[l] + ada_b[l]).reshape(x.shape[0], 1, N_ADA, D_MODEL)
        mod_s = (cond_s @ ada_w[l] + ada_b[l]).reshape(1, 1, N_ADA, D_MODEL)
        x = ffn_sublayer(x, mod_x, 0, norm_w[l, 0], ffn1_w_in[l], ffn1_w_out[l])
        s = ffn_sublayer(s, mod_s, 0, norm_w[l, 0], ffn1_w_in[l], ffn1_w_out[l])
        p = {
            'w_in': mix_w_in[l], 'ret_decay_logit': ret_decay_logit[l],
            'q_norm': att_q_norm[l], 'k_norm': att_k_norm[l], 'att_sink': att_sink[l],
            'shift': rwkv_shift[l], 'w0': rwkv_w0[l], 'w_up': rwkv_w_up[l],
            'a0': rwkv_a0[l], 'a_up': rwkv_a_up[l], 'g_up': rwkv_g_up[l],
            'k_k': rwkv_k_k[l], 'k_a': rwkv_k_a[l], 'r_k': rwkv_r_k[l],
            'gn_w': rwkv_gn_w[l], 'gn_b': rwkv_gn_b[l],
            'w_ret': w_branch_ret[l], 'w_att': w_branch_att[l], 'w_rwkv': w_branch_rwkv[l],
            'w_out': w_out[l],
        }
        if l > 0:
            p['v0'] = rwkv_v0[l - 1]
            p['v_down'] = rwkv_v_down[l - 1]
            p['v_up'] = rwkv_v_up[l - 1]
        hx = modulate(rms_norm(x, norm_w[l, 1]), mod_x[:, :, 3], mod_x[:, :, 4])
        hs = modulate(rms_norm(s, norm_w[l, 1]), mod_s[:, :, 3], mod_s[:, :, 4])
        out_x, out_s, v_first = token_mixing(hx, hs, p, v_first, att_ang, ret_ang_x, ret_ang_s, not last)
        x = x + mod_x[:, :, 5] * out_x
        x = ffn_sublayer(x, mod_x, 6, norm_w[l, 2], ffn2_w_in[l], ffn2_w_out[l])
        if not last:
            s = s + mod_s[:, :, 5] * out_s
            s = ffn_sublayer(s, mod_s, 6, norm_w[l, 2], ffn2_w_in[l], ffn2_w_out[l])
    return x
```

```cpp
#include <hip/hip_runtime.h>
#include <hip/hip_cooperative_groups.h>
#include <cstdio>
#include <cstdint>
namespace cg = cooperative_groups;

#ifndef RW_DBG
#define RW_DBG 0
#endif
#ifndef BR_MASK
#define BR_MASK 7
#endif
#ifndef STOP_AFTER
#define STOP_AFTER 100
#endif

#define LAS __attribute__((address_space(3)))
typedef unsigned short bf16_t;
typedef short bf16x8 __attribute__((ext_vector_type(8)));
typedef float f32x4 __attribute__((ext_vector_type(4)));
typedef float f32x2 __attribute__((ext_vector_type(2)));
typedef unsigned u32x4 __attribute__((ext_vector_type(4)));
typedef unsigned u32x2 __attribute__((ext_vector_type(2)));

constexpr int D = 1024, NB = 8, SEQ = 2048, CTX = 256, DFF = 2816, NADA = 9, NIN = 8832;
constexpr int T_CTX = NB * CTX, T_LAT = NB * SEQ, T_ALL = T_CTX + T_LAT;
constexpr int NA = 2816;
constexpr int NBW = 3072;
constexpr int NWAVES = 8, NTHR = 512;

constexpr size_t MiB = 1u << 20;
constexpr size_t WS_CTL = 0, WS_MODS = 1 * MiB, WS_ZERO_BYTES = 2 * MiB;
constexpr size_t WS_S = 2 * MiB;
constexpr size_t WS_H = 10 * MiB;
constexpr size_t WS_W = 46 * MiB;
constexpr size_t WS_VFIRST = 103 * MiB;
constexpr size_t WS_AO = 121 * MiB;
constexpr size_t WS_F = 157 * MiB;
constexpr size_t WS_F2 = WS_F + 108 * MiB;
constexpr size_t WS_BONUS = 301 * MiB;
constexpr size_t WS_GSCR = 303 * MiB;
constexpr size_t WS_VMIX = 335 * MiB;
constexpr size_t WS_END = 353 * MiB;
constexpr size_t W_FFN1_IN = 0, W_FFN1_OUT = 11 * MiB, W_FFN2_IN = W_FFN1_OUT + 5632 * 1024, W_FFN2_OUT = W_FFN2_IN + 11 * MiB,
                 W_MIXA = W_FFN2_OUT + 5632 * 1024, W_MIXB = W_MIXA + 5632 * 1024, W_GATE = W_MIXB + 6 * MiB, W_RET = W_GATE + 6 * MiB,
                 W_ATT = W_RET + 2 * MiB, W_RWKV = W_ATT + 1 * MiB, W_OUT = W_RWKV + 1 * MiB, W_GUP = W_OUT + 2 * MiB, W_END = W_GUP + 131072;
static_assert(W_END <= 57 * MiB, "W map");
constexpr int CW_BAR = 4096;

constexpr int LDS_BYTES = 163840;
constexpr int LDS_MISC = LDS_BYTES - 1024;

__device__ __forceinline__ unsigned f2bf(float f) { unsigned u = __builtin_bit_cast(unsigned, f); return (u + 0x7fffu + ((u >> 16) & 1u)) >> 16; }
__device__ __forceinline__ unsigned pk2(float lo, float hi) { return f2bf(lo) | (f2bf(hi) << 16); }
__device__ __forceinline__ float bf2f(unsigned short b) { return __builtin_bit_cast(float, (unsigned)b << 16); }
__device__ __forceinline__ float bflo(unsigned w) { return __builtin_bit_cast(float, w << 16); }
__device__ __forceinline__ float bfhi(unsigned w) { return __builtin_bit_cast(float, w & 0xffff0000u); }
__device__ __forceinline__ float sigmoidf_(float x) { return 1.0f / (1.0f + __expf(-x)); }
__device__ __forceinline__ float siluf_(float x) { return x / (1.0f + __expf(-x)); }
#define DPP_MOV(x, ctrl) __builtin_bit_cast(float, __builtin_amdgcn_update_dpp(0, __builtin_bit_cast(int, (x)), (ctrl), 0xf, 0xf, true))
__device__ __forceinline__ float allreduce16(float x) {
    x += DPP_MOV(x, 0xB1); x += DPP_MOV(x, 0x4E); x += DPP_MOV(x, 0x141); x += DPP_MOV(x, 0x140); return x;
}
__device__ __forceinline__ float allreduce16_max(float x) {
    x = fmaxf(x, DPP_MOV(x, 0xB1)); x = fmaxf(x, DPP_MOV(x, 0x4E)); x = fmaxf(x, DPP_MOV(x, 0x141)); x = fmaxf(x, DPP_MOV(x, 0x140)); return x;
}
__device__ __forceinline__ float wave_sum(float v) {
    v = allreduce16(v);
    const float a = __builtin_bit_cast(float, __builtin_amdgcn_readlane(__builtin_bit_cast(int, v), 0)), b = __builtin_bit_cast(float, __builtin_amdgcn_readlane(__builtin_bit_cast(int, v), 16));
    const float c = __builtin_bit_cast(float, __builtin_amdgcn_readlane(__builtin_bit_cast(int, v), 32)), d = __builtin_bit_cast(float, __builtin_amdgcn_readlane(__builtin_bit_cast(int, v), 48));
    return (a + b) + (c + d);
}
#define LDS_WAIT() asm volatile("s_waitcnt lgkmcnt(0)" ::: "memory")

#define XB_TMO      128
#define XB_XCNT(j)  (256  + 64 * (j))
#define XB_XSUB(j)  (1280 + 64 * (j))
#define XB_XGEN(j)  (2304 + 64 * (j))
#define XB_TOP      3328
#define XB_TOPGEN   3392
#define XCD_BAR_WORDS 3456
#define XB_SPIN_CAP (1u << 20)
__device__ __forceinline__ unsigned xb_ld(unsigned* p)              { return __hip_atomic_load(p, __ATOMIC_RELAXED, __HIP_MEMORY_SCOPE_AGENT); }
__device__ __forceinline__ unsigned xb_add(unsigned* p, unsigned v) { return __hip_atomic_fetch_add(p, v, __ATOMIC_RELAXED, __HIP_MEMORY_SCOPE_AGENT); }
__device__ __forceinline__ unsigned xb_xcc_id() { return (unsigned)__builtin_amdgcn_s_getreg((3 << 11) | 20) & 0xFu; }
#define XB_SPIN(cond, bar) do { unsigned _sp = 0; while (cond) { __builtin_amdgcn_s_sleep(1); \
    if ((++_sp & 255u) == 0u) { if (xb_ld(&(bar)[XB_TMO])) break; if (_sp > XB_SPIN_CAP) { atomicAdd(&(bar)[XB_TMO], 1u); break; } } } } while (0)
struct XcdBarrier { unsigned* bar; unsigned x; volatile LAS unsigned* st; };
__device__ __forceinline__ XcdBarrier xcd_barrier_post(unsigned* bar, volatile LAS unsigned* st) {
    XcdBarrier b; b.bar = bar; b.x = xb_xcc_id(); b.st = st;
    if (threadIdx.x == 0) (void)xb_add(&bar[XB_XCNT(b.x)], 1u);
    return b;
}
__device__ __forceinline__ void xcd_barrier_complete(unsigned* bar, unsigned x, unsigned& nloc, unsigned& nx) {
    const unsigned G = gridDim.x * gridDim.y * gridDim.z;
    unsigned sum, cnt, mine, sp = 0u;
    for (;;) {
        sum = 0u; cnt = 0u; mine = 0u;
#pragma unroll
        for (unsigned j = 0; j < 16; ++j) { const unsigned c = xb_ld(&bar[XB_XCNT(j)]); sum += c; cnt += (c > 0u) ? 1u : 0u; mine = (j == x) ? c : mine; }
        if (sum == G) break;
        __builtin_amdgcn_s_sleep(1);
        if ((++sp & 255u) == 0u) { if (xb_ld(&bar[XB_TMO])) break; if (sp > XB_SPIN_CAP) { atomicAdd(&bar[XB_TMO], 1u); break; } }
    }
    nloc = mine > 0u ? mine : 1u; nx = cnt > 0u ? cnt : 1u;
}
__device__ __forceinline__ void xcd_barrier(const XcdBarrier& b) {
    asm volatile("s_waitcnt vmcnt(0)" ::: "memory");
    __syncthreads();
    if (threadIdx.x == 0) {
        unsigned* bar = b.bar;
        __builtin_amdgcn_s_waitcnt(0);
        unsigned nloc = b.st[0], nx = b.st[1];
        if (nloc == 0u) { xcd_barrier_complete(bar, b.x, nloc, nx); b.st[0] = nloc; b.st[1] = nx; }
        const unsigned old = xb_add(&bar[XB_XSUB(b.x)], 1u);
        const unsigned gen = old / nloc;
        if (old + 1u == (gen + 1u) * nloc) {
            __builtin_amdgcn_fence(__ATOMIC_RELEASE, "agent");
            asm volatile("s_waitcnt vmcnt(0)" ::: "memory");
            const unsigned og = xb_add(&bar[XB_TOP], 1u);
            const unsigned tg = og / nx;
            if (og + 1u == (tg + 1u) * nx) xb_add(&bar[XB_TOPGEN], 1u);
            else XB_SPIN(xb_ld(&bar[XB_TOPGEN]) == tg, bar);
            __builtin_amdgcn_fence(__ATOMIC_ACQUIRE, "agent");
            xb_add(&bar[XB_XGEN(b.x)], 1u);
            asm volatile("s_waitcnt vmcnt(0)" ::: "memory");
        } else {
            XB_SPIN(xb_ld(&bar[XB_XGEN(b.x)]) == gen, bar);
            __builtin_amdgcn_fence(__ATOMIC_ACQUIRE, "agent");
            asm volatile("s_waitcnt vmcnt(0)" ::: "memory");
        }
    }
    __syncthreads();
}

namespace pg8 {
constexpr int BM = 256, BK = 64, HALF = 128, HTB = HALF * BK * 2, NXCD = 8, WGM = 8;
__host__ __device__ __forceinline__ int lds_byte(int r, int c) { const int st = (r >> 4) * 2 + (c >> 5), rr = r & 15, cc = c & 31, ob = rr * 64 + cc * 2; return st * 1024 + (ob ^ (((ob >> 9) & 1) << 5)); }
__host__ __device__ __forceinline__ void stage_rc(int b, int& R, int& C) { const int st = b / 1024, sb = b % 1024, swz = sb ^ (((sb >> 9) & 1) << 5); R = (st >> 1) * 16 + swz / 64; C = (st & 1) * 32 + (swz % 64) / 2; }
__host__ __device__ __forceinline__ int perm32(int rho) { const int n = rho >> 4, i = rho & 15; return 8 * (i >> 2) + 4 * n + (i & 3); }
__device__ __forceinline__ unsigned cvt_pk_bf16(float lo, float hi) { unsigned r; asm volatile("v_cvt_pk_bf16_f32 %0, %1, %2" : "=v"(r) : "v"(lo), "v"(hi)); return r; }

__device__ __forceinline__ void glds16_s(const char* sbase, unsigned voff, unsigned lds_dst) {
    unsigned keep;
    asm volatile("s_mov_b32 %0, m0\n\ts_mov_b32 m0, %3\n\ts_nop 0\n\tglobal_load_lds_dwordx4 %1, %2\n\ts_mov_b32 m0, %0" : "=&s"(keep) : "v"(voff), "s"(sbase), "s"(lds_dst) : "memory");
}
struct Unit { int pm, pn, op; };
__device__ __forceinline__ const char* opaque_sptr(const char* p) { unsigned long long v = (unsigned long long)p; asm volatile("" : "+s"(v)); return (const char*)v; }
struct Opnd { const char* A; const char* B; unsigned lda, ldb; int nt; };

__device__ __forceinline__ bool tile_order(int i, int G, int c, int nM, int nN, int& pm, int& pn) {
    const int nwg = nM * nN; const long L = (long)i * G + c; if (L >= nwg) return false;
    int wgid = (int)L; { const int q = nwg / NXCD, r = nwg % NXCD, xcd = wgid % NXCD, off = wgid / NXCD; wgid = (xcd < r ? xcd * (q + 1) : r * (q + 1) + (xcd - r) * q) + off; }
    const int nig = WGM * nN, gid = wgid / nig, fm = gid * WGM, gsz = (nM - fm) < WGM ? (nM - fm) : WGM;
    pm = fm + ((wgid % nig) % gsz); pn = (wgid % nig) / gsz; return true;
}

template <class Epi, class Sched, bool VARLD = false>
__device__ __forceinline__ void gemm_phase(LAS unsigned char* lds, int tid, const Sched& S, const Epi& E) {
    const int wid = __builtin_amdgcn_readfirstlane(tid >> 6), lane = tid & 63, wr = wid >> 2, wc = wid & 3, fr = lane & 15, fq = lane >> 4;
    int sR[2], sRb[2], sC[2];
#pragma unroll
    for (int i = 0; i < 2; ++i) { int R, C; stage_rc(tid * 16 + i * 8192, R, C); sR[i] = R; sRb[i] = Epi::PERM ? ((R & ~31) + perm32(R & 31)) : R; sC[i] = C * 2; }
    constexpr unsigned kstep = BK * 2;
    const unsigned ldsw = (unsigned)wid * 1024u, ldsbase = (unsigned)(unsigned long long)lds;
    const int aoff = lds_byte(wr * 64 + fr, fq * 8), boff = lds_byte(wc * 32 + fr, fq * 8);
#define PG8_SA(b, h) (((b) * 2 + (h)) * HTB)
#define PG8_SB(b, h) ((4 + (b) * 2 + (h)) * HTB)
#define PG8_STAGE(bufoff, gbase, voff) do { _Pragma("unroll") for (int _i = 0; _i < 2; ++_i) \
        glds16_s((const char*)(gbase), (voff)[_i], ldsbase + (unsigned)(bufoff) + ldsw + _i * 8192); } while (0)
#define PG8_LDA(dst, b, h) do { _Pragma("unroll") for (int m = 0; m < 4; ++m) _Pragma("unroll") for (int k = 0; k < 2; ++k) dst[m][k] = *(const LAS bf16x8*)(lds + PG8_SA(b, h) + aoff + m * 2048 + k * 1024); } while (0)
#define PG8_LDB(dst, b, h) do { _Pragma("unroll") for (int n = 0; n < 2; ++n) _Pragma("unroll") for (int k = 0; k < 2; ++k) dst[n][k] = *(const LAS bf16x8*)(lds + PG8_SB(b, h) + boff + n * 2048 + k * 1024); } while (0)
#define PG8_MMA(ai, bj, At, Bt) do { __builtin_amdgcn_s_setprio(1); _Pragma("unroll") for (int m = 0; m < 4; ++m) _Pragma("unroll") for (int n = 0; n < 2; ++n) _Pragma("unroll") for (int k = 0; k < 2; ++k) \
        acc[ai][bj][m][n] = __builtin_amdgcn_mfma_f32_16x16x32_bf16(Bt[n][k], At[m][k], acc[ai][bj][m][n], 0, 0, 0); __builtin_amdgcn_s_setprio(0); } while (0)
#define PG8_WAIT_V(n) asm volatile("s_waitcnt vmcnt(" #n ")" ::: "memory")
#define PG8_WAIT_L(n) asm volatile("s_waitcnt lgkmcnt(" #n ")" ::: "memory")
#define PG8_BAR __builtin_amdgcn_s_barrier()
#define PG8_SCHED __builtin_amdgcn_sched_barrier(0)
#define PG8_VOFF(o, vA, vB, hA, hB) do { _Pragma("unroll") for (int _i = 0; _i < 2; ++_i) { vA[_i] = (unsigned)sR[_i] * (o).lda + (unsigned)sC[_i]; vB[_i] = (unsigned)sRb[_i] * (o).ldb + (unsigned)sC[_i]; } \
        hA = (unsigned)HALF * (o).lda; hB = (unsigned)HALF * (o).ldb; asm volatile("" : "+s"(hA), "+s"(hB)); } while (0)
    Unit cur, nxt; Opnd co, no; int ui = 0;
    if (!S.next(0, cur, co)) return;
    f32x4 acc[2][2][4][2];
#pragma unroll
    for (int a = 0; a < 2; ++a)
#pragma unroll
        for (int b = 0; b < 2; ++b)
#pragma unroll
            for (int m = 0; m < 4; ++m)
#pragma unroll
                for (int n = 0; n < 2; ++n) acc[a][b][m][n] = (f32x4){0.f, 0.f, 0.f, 0.f};
    bf16x8 At[4][2], B0[2][2], B1[2][2];
    unsigned cvA[2], cvB[2], nvA[2], nvB[2]; unsigned chA, chB, nhA, nhB;
    PG8_VOFF(co, cvA, cvB, chA, chB);
    const char* cA = opaque_sptr(co.A); const char* cB = opaque_sptr(co.B); int nt = co.nt;
    PG8_STAGE(PG8_SB(0, 0), cB, cvB); PG8_STAGE(PG8_SB(0, 1), cB + chB, cvB); PG8_STAGE(PG8_SA(0, 0), cA, cvA); PG8_STAGE(PG8_SA(0, 1), cA + chA, cvA);
    if (wr == 1) PG8_BAR;
    PG8_WAIT_V(2); PG8_BAR;
    PG8_STAGE(PG8_SB(1, 0), cB + kstep, cvB); PG8_STAGE(PG8_SA(1, 0), cA + kstep, cvA); PG8_STAGE(PG8_SB(1, 1), cB + chB + kstep, cvB);
    PG8_WAIT_V(6); PG8_BAR;
    for (;;) {
        const bool has_next = S.next(ui + 1, nxt, no);
        const char* nA = opaque_sptr(has_next ? no.A : cA); const char* nB = opaque_sptr(has_next ? no.B : cB);
        int nnt = nt;
        if constexpr (VARLD) { if (has_next) { PG8_VOFF(no, nvA, nvB, nhA, nhB); nnt = no.nt; } else { nvA[0] = cvA[0]; nvA[1] = cvA[1]; nvB[0] = cvB[0]; nvB[1] = cvB[1]; nhA = chA; nhB = chB; } }
        for (int t = 0; t < nt; t += 2) {
            const bool last = (t == nt - 2);
            const char* a1 = cA + (size_t)(t + 1) * kstep;
            const char* a2 = last ? nA : cA + (size_t)(t + 2) * kstep; const char* b2 = last ? nB : cB + (size_t)(t + 2) * kstep;
            const char* a3 = a2 + kstep; const char* b3 = b2 + kstep;
            unsigned vA2[2], vB2[2]; unsigned hA2, hB2;
            if constexpr (VARLD) { vA2[0] = last ? nvA[0] : cvA[0]; vA2[1] = last ? nvA[1] : cvA[1]; vB2[0] = last ? nvB[0] : cvB[0]; vB2[1] = last ? nvB[1] : cvB[1]; hA2 = last ? nhA : chA; hB2 = last ? nhB : chB; }
            else { vA2[0] = cvA[0]; vA2[1] = cvA[1]; vB2[0] = cvB[0]; vB2[1] = cvB[1]; hA2 = chA; hB2 = chB; }
            PG8_LDB(B0, 0, 0); PG8_LDB(B1, 0, 1); PG8_SCHED; PG8_LDA(At, 0, 0); PG8_STAGE(PG8_SA(1, 1), a1 + chA, cvA);
            PG8_WAIT_V(8); PG8_WAIT_L(0); PG8_BAR; PG8_MMA(0, 0, At, B0); PG8_MMA(0, 1, At, B1); PG8_BAR; PG8_SCHED;
            PG8_LDA(At, 0, 1); PG8_STAGE(PG8_SB(0, 0), b2, vB2); PG8_STAGE(PG8_SB(0, 1), b2 + hB2, vB2); PG8_STAGE(PG8_SA(0, 0), a2, vA2);
            PG8_WAIT_V(8); PG8_WAIT_L(0); PG8_BAR; PG8_MMA(1, 0, At, B0); PG8_MMA(1, 1, At, B1); PG8_BAR; PG8_SCHED;
            PG8_LDB(B0, 1, 0); PG8_LDB(B1, 1, 1); PG8_SCHED; PG8_LDA(At, 1, 0); PG8_STAGE(PG8_SA(0, 1), a2 + hA2, vA2);
            PG8_WAIT_V(8); PG8_WAIT_L(0); PG8_BAR; PG8_MMA(0, 0, At, B0); PG8_MMA(0, 1, At, B1); PG8_BAR; PG8_SCHED;
            PG8_LDA(At, 1, 1); PG8_STAGE(PG8_SB(1, 0), b3, vB2); PG8_STAGE(PG8_SB(1, 1), b3 + hB2, vB2); PG8_STAGE(PG8_SA(1, 0), a3, vA2);
            PG8_WAIT_V(8); PG8_WAIT_L(0); PG8_BAR; PG8_MMA(1, 0, At, B0); PG8_MMA(1, 1, At, B1); PG8_BAR; PG8_SCHED;
        }
        if (wr == 0) PG8_BAR;
        E(acc, cur, wr, wc, fr, fq);
        if (!has_next) break;
#pragma unroll
        for (int a = 0; a < 2; ++a)
#pragma unroll
            for (int b = 0; b < 2; ++b)
#pragma unroll
                for (int m = 0; m < 4; ++m)
#pragma unroll
                    for (int n = 0; n < 2; ++n) acc[a][b][m][n] = (f32x4){0.f, 0.f, 0.f, 0.f};
        cur = nxt; cA = nA; cB = nB; ++ui;
        if constexpr (VARLD) { cvA[0] = nvA[0]; cvA[1] = nvA[1]; cvB[0] = nvB[0]; cvB[1] = nvB[1]; chA = nhA; chB = nhB; nt = nnt; }
        if (wr == 1) PG8_BAR;
    }
    PG8_WAIT_V(0);
    PG8_BAR;
#undef PG8_SA
#undef PG8_SB
#undef PG8_STAGE
#undef PG8_LDA
#undef PG8_LDB
#undef PG8_MMA
#undef PG8_WAIT_V
#undef PG8_WAIT_L
#undef PG8_BAR
#undef PG8_SCHED
#undef PG8_VOFF
}

struct StdSched {
    const char* A; const char* B; unsigned lda, ldb; int nt, pm0, nM, nN, G, c;
    __device__ __forceinline__ bool next(int i, Unit& u, Opnd& o) const {
        int pm, pn; if (!tile_order(i, G, c, nM, nN, pm, pn)) return false;
        pm += pm0; o.A = A + (size_t)pm * 256 * lda; o.B = B + (size_t)pn * 256 * ldb; o.lda = lda; o.ldb = ldb; o.nt = nt; u.pm = pm; u.pn = pn; u.op = 0; return true;
    }
};
}

struct Params { const float* in[34]; float* out; unsigned char* ws; int stop, pad; };

#define AS4 __attribute__((address_space(4)))
__device__ __forceinline__ unsigned long long karg_u64(int byte_off) { const AS4 char* ka = (const AS4 char*)__builtin_amdgcn_kernarg_segment_ptr(); asm volatile("" : "+s"(byte_off)); return *(const AS4 unsigned long long*)(ka + byte_off); }
#define GAS __attribute__((address_space(1)))
__device__ __forceinline__ const float* arg_in(int i) { return (const float*)(const GAS float*)karg_u64(8 * i); }
__device__ __forceinline__ float* arg_out() { return (float*)(GAS float*)karg_u64(8 * 34); }
__device__ __forceinline__ unsigned char* arg_ws() { return (unsigned char*)(GAS unsigned char*)karg_u64(8 * 35); }

struct Ctx {
    LAS unsigned char* lds;
    unsigned char* ws;
    int tid, lane, wave, G, bid, wave_s;
    __device__ __forceinline__ void refresh() { int w = wave_s; asm volatile("" : "+s"(w)); int ln = __builtin_amdgcn_mbcnt_hi(~0u, __builtin_amdgcn_mbcnt_lo(~0u, 0u)); asm volatile("" : "+v"(ln));
        lane = ln; wave = w; tid = w * 64 + ln;
        int b_ = blockIdx.x, g_ = gridDim.x; asm volatile("" : "+s"(b_), "+s"(g_)); bid = b_; G = g_; ws = arg_ws(); }
};
__device__ __forceinline__ float* xrow_ptr(const Ctx& C, int r) { return r < T_CTX ? (float*)(C.ws + WS_S) + (size_t)r * D : arg_out() + (size_t)(r - T_CTX) * D; }
__device__ __forceinline__ int mod_idx(int r) { return r < T_CTX ? 8 : (r - T_CTX) >> 11; }
__device__ __forceinline__ const float* mod_ptr(const Ctx& C, int l, int bidx, int k) { return (const float*)(C.ws + WS_MODS) + ((size_t)(l * 9 + bidx) * NADA + k) * D; }

__device__ __forceinline__ void phase_init(Ctx& C) {
    C.refresh();
    {
        const size_t n4x = (size_t)T_LAT * D / 4, n4s = (size_t)T_CTX * D / 4;
        const f32x4* sx = (const f32x4*)arg_in(0); f32x4* dx = (f32x4*)arg_out();
        const f32x4* ss = (const f32x4*)arg_in(2); f32x4* ds = (f32x4*)(C.ws + WS_S);
        for (size_t i = (size_t)C.bid * NTHR + C.tid; i < n4x; i += (size_t)C.G * NTHR) dx[i] = sx[i];
        for (size_t i = (size_t)C.bid * NTHR + C.tid; i < n4s; i += (size_t)C.G * NTHR) ds[i] = ss[i];
    }
    LAS float* sc = (LAS float*)C.lds;
    LAS float* part = (LAS float*)(C.lds + 40960);
    __syncthreads();
    for (int e = C.tid; e < 9 * 1024; e += NTHR) { const int bi = e >> 10, i = e & 1023; const float v = bi < 8 ? arg_in(1)[bi * D + i] : arg_in(3)[i]; sc[e] = siluf_(v); }
    __syncthreads();
    for (int it = C.bid; it < 2 * 144; it += C.G) {
        const int l = it / 144, cb = it % 144;
        const int j = cb * 64 + C.lane, i0 = C.wave * 128;
        const float* w = arg_in(4) + (size_t)l * D * (NADA * D) + (size_t)i0 * (NADA * D) + j;
        float a[9];
#pragma unroll
        for (int b = 0; b < 9; ++b) a[b] = 0.f;
#pragma unroll 8
        for (int i = 0; i < 128; ++i) { const float wv = w[(size_t)i * (NADA * D)];
#pragma unroll
            for (int b = 0; b < 9; ++b) a[b] += sc[b * 1024 + i0 + i] * wv; }
#pragma unroll
        for (int b = 0; b < 9; ++b) part[(C.wave * 9 + b) * 64 + C.lane] = a[b];
        __syncthreads();
        for (int e = C.tid; e < 9 * 64; e += NTHR) { const int b = e >> 6, c = e & 63; float sum = arg_in(5)[(size_t)l * NADA * D + cb * 64 + c];
#pragma unroll
            for (int w8 = 0; w8 < 8; ++w8) sum += part[(w8 * 9 + b) * 64 + c];
            ((float*)(C.ws + WS_MODS))[((size_t)l * 9 + b) * NADA * D + cb * 64 + c] = sum; }
        __syncthreads();
    }
    __syncthreads();
}

__device__ __forceinline__ void transpose_item(const float* src, int ldsrc, int col0, int K, bf16_t* dst, int row0, int kb, LAS float* scr, int lane) {
    const int k0 = 64 * kb;
    if (src) {
#pragma unroll 8
        for (int i = 0; i < 32; ++i) { const int kk = 2 * i + (lane >> 5); scr[kk * 33 + (lane & 31)] = src[(size_t)(k0 + kk) * ldsrc + col0 + (lane & 31)]; }
    } else {
#pragma unroll 8
        for (int i = 0; i < 32; ++i) { const int kk = 2 * i + (lane >> 5); scr[kk * 33 + (lane & 31)] = 0.f; }
    }
    LDS_WAIT(); asm volatile("" ::: "memory");
    const int c = lane & 7;
#pragma unroll
    for (int j = 0; j < 4; ++j) { const int n = (lane >> 3) + 8 * j; const LAS float* s = scr + (8 * c) * 33 + n;
        u32x4 o; o.x = pk2(s[0 * 33], s[1 * 33]); o.y = pk2(s[2 * 33], s[3 * 33]); o.z = pk2(s[4 * 33], s[5 * 33]); o.w = pk2(s[6 * 33], s[7 * 33]);
        *(u32x4*)(dst + (size_t)(row0 + n) * K + k0 + 8 * c) = o; }
    LDS_WAIT(); asm volatile("" ::: "memory");
}
__device__ __forceinline__ void phase_convert(Ctx& C, int l) {
    C.refresh();
    LAS float* scr = (LAS float*)(C.lds + C.wave * 16384);
    unsigned char* W = C.ws + WS_W;
    const int gw = C.bid * NWAVES + C.wave, NGW = C.G * NWAVES;
    constexpr int I_FI = 16 * 176, I_FO = 44 * 32, I_MA = 16 * 88, I_MB = 16 * 96, I_G = 16 * 96, I_R = 16 * 32, I_A = 8 * 32, I_O = 16 * 32;
    constexpr int I_GU = 2 * 16;
    constexpr int NITEMS = 2 * I_FI + 2 * I_FO + I_MA + I_MB + I_G + I_R + 2 * I_A + I_O + I_GU;
    for (int it = gw; it < NITEMS; it += NGW) {
        int r = it;
        if (r < 2 * I_FI) { const int which = r / I_FI; r %= I_FI; const int nb = r / 16, kb = r % 16; const int np = nb * 32, t = np >> 8, q = np & 255;
            const int col = q < 128 ? 128 * t + q : DFF + 128 * t + (q - 128);
            transpose_item(arg_in(which ? 9 : 7) + (size_t)l * D * 2 * DFF, 2 * DFF, col, D, (bf16_t*)(W + (which ? W_FFN2_IN : W_FFN1_IN)), np, kb, scr, C.lane); continue; }
        r -= 2 * I_FI;
        if (r < 2 * I_FO) { const int which = r / I_FO; r %= I_FO; const int nb = r / 44, kb = r % 44;
            transpose_item(arg_in(which ? 10 : 8) + (size_t)l * DFF * D, D, nb * 32, DFF, (bf16_t*)(W + (which ? W_FFN2_OUT : W_FFN1_OUT)), nb * 32, kb, scr, C.lane); continue; }
        r -= 2 * I_FO;
        if (r < I_MA) { const int nb = r / 16, kb = r % 16, np = nb * 32; const float* src; int ld, col;
            if (np < 2688) { src = arg_in(11) + (size_t)l * D * NIN; ld = NIN; col = 3072 + np; }
            else if (np < 2720 && l > 0) { src = arg_in(26) + (size_t)(l - 1) * D * 32; ld = 32; col = 0; }
            else { src = nullptr; ld = 0; col = 0; }
            transpose_item(src, ld, col, D, (bf16_t*)(W + W_MIXA), np, kb, scr, C.lane); continue; }
        r -= I_MA;
        if (r < I_MB) { const int nb = r / 16, kb = r % 16; transpose_item(arg_in(11) + (size_t)l * D * NIN, NIN, nb * 32, D, (bf16_t*)(W + W_MIXB), nb * 32, kb, scr, C.lane); continue; }
        r -= I_MB;
        if (r < I_G) { const int nb = r / 16, kb = r % 16; transpose_item(arg_in(11) + (size_t)l * D * NIN, NIN, 5760 + nb * 32, D, (bf16_t*)(W + W_GATE), nb * 32, kb, scr, C.lane); continue; }
        r -= I_G;
        if (r < I_R) { const int nb = r / 16, kb = r % 16; transpose_item(arg_in(30) + (size_t)l * 1024 * D, D, nb * 32, 1024, (bf16_t*)(W + W_RET), nb * 32, kb, scr, C.lane); continue; }
        r -= I_R;
        if (r < 2 * I_A) { const int which = r / I_A; r %= I_A; const int nb = r / 8, kb = r % 8;
            transpose_item(arg_in(which ? 32 : 31) + (size_t)l * 512 * D, D, nb * 32, 512, (bf16_t*)(W + (which ? W_RWKV : W_ATT)), nb * 32, kb, scr, C.lane); continue; }
        r -= 2 * I_A;
        if (r < I_O) { const int nb = r / 16, kb = r % 16; transpose_item(arg_in(33) + (size_t)l * D * D, D, nb * 32, D, (bf16_t*)(W + W_OUT), nb * 32, kb, scr, C.lane); continue; }
        r -= I_O;
        { const int nb = r / 2, kb = r % 2; transpose_item(arg_in(21) + (size_t)l * 128 * 512, 512, nb * 32, 128, (bf16_t*)(W + W_GUP), nb * 32, kb, scr, C.lane); }
    }
}

__device__ __forceinline__ void phase_norm(Ctx& C, int l, int which, int row_lo) {
    C.refresh();
    const int gw = C.bid * NWAVES + C.wave, NGW = C.G * NWAVES;
    const f32x4* nw = (const f32x4*)(arg_in(6) + ((size_t)l * 3 + which) * D) + C.lane;
    f32x4 nwv[4];
#pragma unroll
    for (int j = 0; j < 4; ++j) nwv[j] = nw[64 * j];
    bf16_t* H = (bf16_t*)(C.ws + WS_H);
    for (int r = row_lo + gw; r < T_ALL; r += NGW) {
        const f32x4* xr = (const f32x4*)xrow_ptr(C, r) + C.lane;
        const int bi = mod_idx(r);
        const f32x4* sh = (const f32x4*)mod_ptr(C, l, bi, 3 * which) + C.lane;
        const f32x4* scl = (const f32x4*)mod_ptr(C, l, bi, 3 * which + 1) + C.lane;
        f32x4 v[4]; float s = 0.f;
#pragma unroll
        for (int j = 0; j < 4; ++j) { v[j] = xr[64 * j]; s += (v[j].x * v[j].x + v[j].y * v[j].y) + (v[j].z * v[j].z + v[j].w * v[j].w); }
        const float rstd = 1.0f / sqrtf(wave_sum(s) * (1.0f / D) + 1e-6f);
        unsigned long long* o8 = (unsigned long long*)(H + (size_t)r * D) + C.lane;
#pragma unroll
        for (int j = 0; j < 4; ++j) { const f32x4 a = sh[64 * j], b = scl[64 * j]; const f32x4 y = (v[j] * rstd * nwv[j]) * (b + 1.0f) + a;
            o8[64 * j] = (unsigned long long)pk2(y.x, y.y) | ((unsigned long long)pk2(y.z, y.w) << 32); }
    }
}

struct EpiSwiglu {
    static constexpr bool PERM = true;
    bf16_t* O;
    __device__ __forceinline__ void operator()(const f32x4 (&acc)[2][2][4][2], const pg8::Unit& u, int wr, int wc, int fr, int fq) const {
        const int row0 = u.pm * 256 + wr * 64 + fr, col0 = u.pn * 128 + wc * 32 + 8 * fq;
#pragma unroll
        for (int ai = 0; ai < 2; ++ai)
#pragma unroll
            for (int m = 0; m < 4; ++m) { bf16_t* rowp = O + (size_t)(row0 + ai * 128 + m * 16) * DFF + col0;
                const f32x4 g0 = acc[ai][0][m][0], g1 = acc[ai][0][m][1], u0 = acc[ai][1][m][0], u1 = acc[ai][1][m][1];
                float o[8];
#pragma unroll
                for (int j = 0; j < 4; ++j) { o[j] = siluf_(g0[j]) * u0[j]; o[4 + j] = siluf_(g1[j]) * u1[j]; }
                u32x4 w; w.x = pg8::cvt_pk_bf16(o[0], o[1]); w.y = pg8::cvt_pk_bf16(o[2], o[3]); w.z = pg8::cvt_pk_bf16(o[4], o[5]); w.w = pg8::cvt_pk_bf16(o[6], o[7]);
                *(u32x4*)rowp = w; }
    }
};
struct EpiResid {
    static constexpr bool PERM = false;
    float* S; float* OUT; const float* mods_l; int k; float coef;
    __device__ __forceinline__ void operator()(const f32x4 (&acc)[2][2][4][2], const pg8::Unit& u, int wr, int wc, int fr, int fq) const {
        const int rt = u.pm * 256;
        float* base = rt < T_CTX ? S + (size_t)rt * D : OUT + (size_t)(rt - T_CTX) * D;
        const int bi = rt < T_CTX ? 8 : (rt - T_CTX) >> 11;
        const int col0 = u.pn * 256 + wc * 32 + 4 * fq;
        const float* mg = mods_l + ((size_t)bi * NADA + k) * D + col0;
        f32x4 gv[2][2];
#pragma unroll
        for (int bj = 0; bj < 2; ++bj)
#pragma unroll
            for (int n = 0; n < 2; ++n) gv[bj][n] = *(const f32x4*)(mg + bj * 128 + n * 16) * coef;
#pragma unroll
        for (int ai = 0; ai < 2; ++ai)
#pragma unroll
            for (int m = 0; m < 4; ++m) { float* rowp = base + (size_t)(wr * 64 + fr + ai * 128 + m * 16) * D + col0;
#pragma unroll
                for (int bj = 0; bj < 2; ++bj)
#pragma unroll
                    for (int n = 0; n < 2; ++n) { f32x4* p = (f32x4*)(rowp + bj * 128 + n * 16); *p = *p + gv[bj][n] * acc[ai][bj][m][n]; } }
    }
};

__device__ __forceinline__ void phase_ffn_in(Ctx& C, size_t w_off, int pm0, int nM) {
    C.refresh();
    pg8::StdSched S{(const char*)(C.ws + WS_H), (const char*)(C.ws + WS_W + w_off), D * 2, D * 2, D / 64, pm0, nM, 22, C.G, C.bid};
    EpiSwiglu E{(bf16_t*)(C.ws + WS_F)};
    pg8::gemm_phase<EpiSwiglu, pg8::StdSched>(C.lds, C.tid, S, E);
}
__device__ __forceinline__ void phase_ffn_out(Ctx& C, int l, size_t w_off, int k, int pm0, int nM) {
    C.refresh();
    pg8::StdSched S{(const char*)(C.ws + WS_F), (const char*)(C.ws + WS_W + w_off), DFF * 2, DFF * 2, DFF / 64, pm0, nM, 4, C.G, C.bid};
    EpiResid E{(float*)(C.ws + WS_S), arg_out(), (const float*)(C.ws + WS_MODS) + (size_t)l * 9 * NADA * D, k, 0.5f};
    pg8::gemm_phase<EpiResid, pg8::StdSched>(C.lds, C.tid, S, E);
}

struct EpiBf16 {
    static constexpr bool PERM = true;
    bf16_t* O; int ldc;
    __device__ __forceinline__ void operator()(const f32x4 (&acc)[2][2][4][2], const pg8::Unit& u, int wr, int wc, int fr, int fq) const {
        const int row0 = u.pm * 256 + wr * 64 + fr, col0 = u.pn * 256 + wc * 32 + 8 * fq;
#pragma unroll
        for (int ai = 0; ai < 2; ++ai)
#pragma unroll
            for (int m = 0; m < 4; ++m) { bf16_t* rowp = O + (size_t)(row0 + ai * 128 + m * 16) * ldc + col0;
#pragma unroll
                for (int bj = 0; bj < 2; ++bj) { const f32x4 v0 = acc[ai][bj][m][0], v1 = acc[ai][bj][m][1];
                    u32x4 w; w.x = pg8::cvt_pk_bf16(v0[0], v0[1]); w.y = pg8::cvt_pk_bf16(v0[2], v0[3]); w.z = pg8::cvt_pk_bf16(v1[0], v1[1]); w.w = pg8::cvt_pk_bf16(v1[2], v1[3]);
                    *(u32x4*)(rowp + bj * 128) = w; } }
    }
};
__device__ __forceinline__ void phase_mix(Ctx& C, size_t w_off, int ncols) {
    C.refresh();
    pg8::StdSched S{(const char*)(C.ws + WS_H), (const char*)(C.ws + WS_W + w_off), D * 2, D * 2, D / 64, 0, 72, ncols / 256, C.G, C.bid};
    EpiBf16 E{(bf16_t*)(C.ws + WS_F), ncols};
    pg8::gemm_phase<EpiBf16, pg8::StdSched>(C.lds, C.tid, S, E);
}

__device__ __forceinline__ int urow(int seg, int b, int pos) { return seg ? T_CTX + b * SEQ + pos : b * CTX + pos; }

__device__ __forceinline__ void att_prep(Ctx& C, int l) {
    C.refresh();
    bf16_t* CA = (bf16_t*)(C.ws + WS_F);
    const int gw = C.bid * NWAVES + C.wave, NGW = C.G * NWAVES;
    const int i = C.lane;
    const float qn = arg_in(13)[l * 64 + i], kn = arg_in(14)[l * 64 + i];
    const int p = i & 31;
    const float inv = __expf(-(float)(p & 15) * (9.210340371976184f / 16.0f));
    for (int it = gw; it < T_ALL * 10; it += NGW) {
        const int r = it / 10, hh = it % 10;
        bf16_t* ptr = CA + (size_t)r * NA + (hh < 8 ? hh * 64 : 512 + (hh - 8) * 64) + i;
        float v = bf2f(*ptr);
        const float ss = wave_sum(v * v);
        v = v * (1.0f / sqrtf(ss * (1.0f / 64.0f) + 1e-6f)) * (hh < 8 ? qn : kn);
        if (r >= T_CTX) {
            const int pos = (r - T_CTX) & (SEQ - 1);
            const float ang = (float)(p < 16 ? (pos >> 6) : (pos & 63)) * inv;
            float sn, cs; __sincosf(ang, &sn, &cs);
            const float o = __builtin_bit_cast(float, __builtin_amdgcn_ds_bpermute((i ^ 32) << 2, __builtin_bit_cast(int, v)));
            v = i < 32 ? v * cs - o * sn : o * sn + v * cs;
        }
        if (hh < 8) v *= 0.125f;
        *ptr = (bf16_t)f2bf(v);
    }
}

namespace rw {
constexpr int OFF_W = 0, OFF_KK = 16384, OFF_BB = 32768, OFF_KD = 49152, OFF_RR = 65536, OFF_VV = 81920, OFF_YB = 90112,
              OFF_AWD = 98304, OFF_AAD = 107520, OFF_BW = 116736, OFF_BA = 125952, OFF_VL = 135168, OFF_VUP = 143360, LDS_END = 147456;
constexpr int RC = 768;
}
__device__ __forceinline__ void phase_rwkv_scan(Ctx& C, int l) {
    using namespace rw;
    C.refresh();
    const int tid = C.tid, lane = C.lane, wave = C.wave;
    const int half = C.bid & 1, dir = (C.bid >> 1) & 1, h = (C.bid >> 2) & 7, b = C.bid >> 5;
    const bf16_t* CA = (const bf16_t*)(C.ws + WS_F);
    bf16_t* Y = (bf16_t*)(C.ws + WS_F2);
    bf16_t* VF = (bf16_t*)(C.ws + WS_VFIRST);
    bf16_t* VM = (bf16_t*)(C.ws + WS_VMIX);
    float* BON = (float*)(C.ws + WS_BONUS);
    LAS unsigned char* lds = C.lds;
    LAS float* LW = (LAS float*)(lds + OFF_W); LAS float* LKK = (LAS float*)(lds + OFF_KK); LAS float* LBB = (LAS float*)(lds + OFF_BB);
    LAS float* LKD = (LAS float*)(lds + OFF_KD); LAS float* LRR = (LAS float*)(lds + OFF_RR); LAS float* LVV = (LAS float*)(lds + OFF_VV);
    LAS float* LYB = (LAS float*)(lds + OFF_YB); LAS float* LVL = (LAS float*)(lds + OFF_VL); LAS float* LVUP = (LAS float*)(lds + OFF_VUP);
    LAS bf16_t* AWD = (LAS bf16_t*)(lds + OFF_AWD); LAS bf16_t* AAD = (LAS bf16_t*)(lds + OFF_AAD);
    LAS bf16_t* BW = (LAS bf16_t*)(lds + OFF_BW); LAS bf16_t* BA = (LAS bf16_t*)(lds + OFF_BA);
    {
        const float* wup = arg_in(18) + ((size_t)(l * 2 + dir) * 64) * 512 + h * 64;
        const float* aup = arg_in(20) + ((size_t)(l * 2 + dir) * 64) * 512 + h * 64;
        for (int e = tid; e < 4096; e += NTHR) { const int j = e >> 6, c = e & 63; BW[c * 72 + j] = (bf16_t)f2bf(wup[(size_t)j * 512 + c]); BA[c * 72 + j] = (bf16_t)f2bf(aup[(size_t)j * 512 + c]); }
        if (l > 0) { const float* vup = arg_in(27) + (size_t)(l - 1) * 32 * 512 + h * 64 + half * 32;
            for (int e = tid; e < 1024; e += NTHR) { const int j = e >> 5, vr = e & 31; LVUP[j * 32 + vr] = vup[(size_t)j * 512 + vr]; } }
    }
    const float* shiftw = arg_in(16) + (size_t)l * 3 * 1920;
    const int c64 = tid & 63, s8 = tid >> 6;
    const int vr32 = tid & 31, s16 = tid >> 5;
    const int col_r = h * 64 + c64, col_k = 512 + h * 64 + c64, col_wd = 1536 + dir * 64 + c64, col_ad = 1664 + dir * 64 + c64, col_v = 1024 + h * 64 + half * 32 + vr32;
    float cw_r[3], cw_k[3], cw_wd[3], cw_ad[3], cw_v[3];
#pragma unroll
    for (int j = 0; j < 3; ++j) { cw_r[j] = shiftw[j * 1920 + col_r]; cw_k[j] = shiftw[j * 1920 + col_k]; cw_wd[j] = shiftw[j * 1920 + col_wd]; cw_ad[j] = shiftw[j * 1920 + col_ad]; cw_v[j] = shiftw[j * 1920 + col_v]; }
    const float kk_c = arg_in(22)[l * 512 + h * 64 + lane], ka_c = arg_in(23)[l * 512 + h * 64 + lane], rk_c = arg_in(24)[l * 512 + h * 64 + lane];
    const float v0_c = l > 0 ? arg_in(25)[(size_t)(l - 1) * 512 + h * 64 + half * 32 + vr32] : 0.f;
    const int mm = wave >> 2, mt = wave & 3, fr = lane & 15, fq = lane >> 4;
    float bias4[4];
    { const float* bsrc = (mm == 0 ? arg_in(17) : arg_in(19)) + (size_t)(l * 2 + dir) * 512 + h * 64;
#pragma unroll
      for (int nt = 0; nt < 4; ++nt) bias4[nt] = bsrc[nt * 16 + fr]; }
    const int rloc = tid >> 4, q = tid & 15;
    float S0 = 0.f, S1 = 0.f, S2 = 0.f, S3 = 0.f;
    __syncthreads();
    for (int blk = 0; blk < 36; ++blk) {
        const int seg = blk >= 4 ? 1 : 0, bi = seg ? blk - 4 : blk, len = seg ? SEQ : CTX;
        {
#pragma unroll 2
            for (int it = 0; it < 8; ++it) {
                const int s = s8 + 8 * it, sidx = bi * 64 + s, pos = dir ? len - 1 - sidx : sidx;
                const bf16_t* r0 = CA + (size_t)urow(seg, b, pos) * NA + RC;
                const bool hm = pos >= 1, hp = pos + 1 < len;
                const bf16_t* rm = hm ? r0 - NA : r0; const bf16_t* rp = hp ? r0 + NA : r0;
                const float zm = hm ? 1.f : 0.f, zp = hp ? 1.f : 0.f;
                const float vr_ = zm * bf2f(rm[col_r]) * cw_r[0] + bf2f(r0[col_r]) * cw_r[1] + zp * bf2f(rp[col_r]) * cw_r[2];
                const float vk_ = zm * bf2f(rm[col_k]) * cw_k[0] + bf2f(r0[col_k]) * cw_k[1] + zp * bf2f(rp[col_k]) * cw_k[2];
                const float vw_ = zm * bf2f(rm[col_wd]) * cw_wd[0] + bf2f(r0[col_wd]) * cw_wd[1] + zp * bf2f(rp[col_wd]) * cw_wd[2];
                const float va_ = zm * bf2f(rm[col_ad]) * cw_ad[0] + bf2f(r0[col_ad]) * cw_ad[1] + zp * bf2f(rp[col_ad]) * cw_ad[2];
                LRR[s * 64 + c64] = vr_; LKD[s * 64 + c64] = vk_;
                AWD[s * 72 + c64] = (bf16_t)f2bf(tanhf(vw_)); AAD[s * 72 + c64] = (bf16_t)f2bf(va_);
            }
#pragma unroll 2
            for (int it = 0; it < 4; ++it) {
                const int s = s16 + 16 * it, sidx = bi * 64 + s, pos = dir ? len - 1 - sidx : sidx;
                const bf16_t* r0 = CA + (size_t)urow(seg, b, pos) * NA + RC;
                const bool hm = pos >= 1, hp = pos + 1 < len;
                const bf16_t* rm = hm ? r0 - NA : r0; const bf16_t* rp = hp ? r0 + NA : r0;
                const float zm = hm ? 1.f : 0.f, zp = hp ? 1.f : 0.f;
                LVV[s * 32 + vr32] = zm * bf2f(rm[col_v]) * cw_v[0] + bf2f(r0[col_v]) * cw_v[1] + zp * bf2f(rp[col_v]) * cw_v[2];
                if (l > 0) LVL[s * 32 + vr32] = bf2f(r0[2688 - RC + vr32]);
            }
        }
        __syncthreads();
        {
            LAS bf16_t* Aarr = mm == 0 ? AWD : AAD; LAS bf16_t* Barr = mm == 0 ? BW : BA;
            f32x4 acc[4];
#pragma unroll
            for (int nt = 0; nt < 4; ++nt) acc[nt] = (f32x4){0.f, 0.f, 0.f, 0.f};
#pragma unroll
            for (int ks = 0; ks < 2; ++ks) {
                const bf16x8 af = *(const LAS bf16x8*)(Aarr + (mt * 16 + fr) * 72 + ks * 32 + fq * 8);
#pragma unroll
                for (int nt = 0; nt < 4; ++nt) { const bf16x8 bfr = *(const LAS bf16x8*)(Barr + (nt * 16 + fr) * 72 + ks * 32 + fq * 8);
                    acc[nt] = __builtin_amdgcn_mfma_f32_16x16x32_bf16(af, bfr, acc[nt], 0, 0, 0); }
            }
            LAS float* dst = mm == 0 ? LW : LBB;
#pragma unroll
            for (int nt = 0; nt < 4; ++nt)
#pragma unroll
                for (int j = 0; j < 4; ++j) { const float z = bias4[nt] + acc[nt][j]; const float sg = sigmoidf_(z);
                    dst[(mt * 16 + fq * 4 + j) * 64 + nt * 16 + fr] = mm == 0 ? __expf(-0.6065306597126334f * sg) : sg; }
        }
        __syncthreads();
        {
#pragma unroll 2
            for (int it = 0; it < 8; ++it) {
                const int s = wave + 8 * it;
                const float kraw = LKD[s * 64 + lane], a = LBB[s * 64 + lane], kkv = kraw * kk_c;
                const float n2 = wave_sum(kkv * kkv);
                const float kap = kkv / fmaxf(sqrtf(n2), 1e-12f);
                const float kd = kraw * (1.0f + (a - 1.0f) * ka_c);
                LKK[s * 64 + lane] = kap; LBB[s * 64 + lane] = kap * a; LKD[s * 64 + lane] = kd;
                const float bo = wave_sum(LRR[s * 64 + lane] * kd * rk_c);
                if (half == 0 && lane == 0) { const int sidx = bi * 64 + s, pos = dir ? len - 1 - sidx : sidx; BON[((size_t)dir * T_ALL + urow(seg, b, pos)) * 8 + h] = bo; }
            }
#pragma unroll 2
            for (int it = 0; it < 4; ++it) {
                const int s = s16 + 16 * it, sidx = bi * 64 + s, pos = dir ? len - 1 - sidx : sidx;
                const size_t vidx = (size_t)urow(seg, b, pos) * 512 + h * 64 + half * 32 + vr32;
                float v = LVV[s * 32 + vr32];
                if (l > 0) {
                    float g = v0_c;
#pragma unroll 8
                    for (int j = 0; j < 32; ++j) g += LVL[s * 32 + j] * LVUP[j * 32 + vr32];
                    const float vf = bf2f(VF[vidx]);
                    v = v + (vf - v) * sigmoidf_(g);
                    LVV[s * 32 + vr32] = v;
                    if (dir == 0) VM[vidx] = (bf16_t)f2bf(v);
                } else if (dir == 0) VF[vidx] = (bf16_t)f2bf(v);
            }
        }
        __syncthreads();
        {
            const LAS f32x4* pW = (const LAS f32x4*)LW + q; const LAS f32x4* pK = (const LAS f32x4*)LKK + q; const LAS f32x4* pB = (const LAS f32x4*)LBB + q;
            const LAS f32x4* pD = (const LAS f32x4*)LKD + q; const LAS f32x4* pR = (const LAS f32x4*)LRR + q;
#pragma unroll 4
            for (int s = 0; s < 64; ++s) {
                const f32x4 kk = pK[s * 16], w = pW[s * 16], bb = pB[s * 16], kd = pD[s * 16], rr = pR[s * 16];
                const float v = LVV[s * 32 + rloc];
                float sa = (S0 * kk.x + S1 * kk.y) + (S2 * kk.z + S3 * kk.w);
                sa = -allreduce16(sa);
                S0 = S0 * w.x + (sa * bb.x + v * kd.x); S1 = S1 * w.y + (sa * bb.y + v * kd.y);
                S2 = S2 * w.z + (sa * bb.z + v * kd.z); S3 = S3 * w.w + (sa * bb.w + v * kd.w);
                float y = (S0 * rr.x + S1 * rr.y) + (S2 * rr.z + S3 * rr.w);
                y = allreduce16(y);
                if (q == 0) LYB[s * 32 + rloc] = y;
            }
        }
        __syncthreads();
        {
            const int s = tid >> 3, v4 = (tid & 7) * 4, sidx = bi * 64 + s, pos = dir ? len - 1 - sidx : sidx;
            const f32x4 yv = *(const LAS f32x4*)(LYB + s * 32 + v4);
            u32x2 o; o.x = pk2(yv.x, yv.y); o.y = pk2(yv.z, yv.w);
            *(u32x2*)(Y + (size_t)urow(seg, b, pos) * 1024 + dir * 512 + h * 64 + half * 32 + v4) = o;
        }
    }
}

__device__ __forceinline__ void phase_rwkv_out(Ctx& C, int l, int unit_lo) {
    C.refresh();
    const int tid = C.tid, lane = C.lane, wave = C.wave;
    constexpr int OFF_AG = 0, AG_LD = 136, OFF_PRE = 17408, PRE_LD = 520;
    LAS bf16_t* AG = (LAS bf16_t*)(C.lds + OFF_AG); LAS bf16_t* PRE = (LAS bf16_t*)(C.lds + OFF_PRE);
    const bf16_t* CA = (const bf16_t*)(C.ws + WS_F);
    const bf16_t* Y = (const bf16_t*)(C.ws + WS_F2);
    const bf16_t* VV = (const bf16_t*)(C.ws + (l == 0 ? WS_VFIRST : WS_VMIX));
    const float* BON = (const float*)(C.ws + WS_BONUS);
    const bf16_t* GUP = (const bf16_t*)(C.ws + WS_W + W_GUP);
    bf16_t* AO = (bf16_t*)(C.ws + WS_AO);
    const float* shiftw = arg_in(16) + (size_t)l * 3 * 1920;
    const float* gnw = arg_in(28) + (size_t)l * 512; const float* gnb = arg_in(29) + (size_t)l * 512;
    const int cg = tid & 127, sg0 = tid >> 7;
    float cw_g[3];
#pragma unroll
    for (int j = 0; j < 3; ++j) cw_g[j] = shiftw[j * 1920 + 1792 + cg];
    const int fr = lane & 15, fq = lane >> 4;
    for (int u = unit_lo + C.bid; u < T_ALL / 64; u += C.G) {
        const int row0 = u * 64;
        const int seg = row0 >= T_CTX ? 1 : 0, len = seg ? SEQ : CTX, pos0 = seg ? ((row0 - T_CTX) & (SEQ - 1)) : (row0 & (CTX - 1));
        __syncthreads();
#pragma unroll 4
        for (int it = 0; it < 16; ++it) {
            const int s = sg0 + 4 * it, pos = pos0 + s;
            const bf16_t* r0 = CA + (size_t)(row0 + s) * NA + rw::RC + 1792 + cg;
            const bool hm = pos >= 1, hp = pos + 1 < len;
            const float xm = hm ? bf2f(r0[-NA]) : 0.f, xp = hp ? bf2f(r0[NA]) : 0.f;
            AG[s * AG_LD + cg] = (bf16_t)f2bf(sigmoidf_(xm * cw_g[0] + bf2f(r0[0]) * cw_g[1] + xp * cw_g[2]));
        }
#pragma unroll 1
        for (int pass = 0; pass < 2; ++pass) {
            const int pr = (tid >> 1) + pass * 256, s = pr >> 3, hh = pr & 7, row = row0 + s, hf = tid & 1;
            const u32x4* yf = (const u32x4*)(Y + (size_t)row * 1024 + hh * 64 + hf * 32); const u32x4* yb = (const u32x4*)(Y + (size_t)row * 1024 + 512 + hh * 64 + hf * 32);
            float y[32]; float sum = 0.f;
#pragma unroll
            for (int k = 0; k < 4; ++k) { const u32x4 a = yf[k], bq = yb[k];
                y[8 * k + 0] = bflo(a.x) + bflo(bq.x); y[8 * k + 1] = bfhi(a.x) + bfhi(bq.x); y[8 * k + 2] = bflo(a.y) + bflo(bq.y); y[8 * k + 3] = bfhi(a.y) + bfhi(bq.y);
                y[8 * k + 4] = bflo(a.z) + bflo(bq.z); y[8 * k + 5] = bfhi(a.z) + bfhi(bq.z); y[8 * k + 6] = bflo(a.w) + bflo(bq.w); y[8 * k + 7] = bfhi(a.w) + bfhi(bq.w); }
#pragma unroll
            for (int k = 0; k < 32; ++k) sum += y[k];
            sum += DPP_MOV(sum, 0xB1);
            const float mean = sum * (1.0f / 64.0f); float var = 0.f;
#pragma unroll
            for (int k = 0; k < 32; ++k) { y[k] -= mean; var += y[k] * y[k]; }
            var += DPP_MOV(var, 0xB1);
            const float rstd = 1.0f / sqrtf(var * (1.0f / 64.0f) + 64e-5f);
            const float bon = BON[(size_t)row * 8 + hh] + BON[((size_t)T_ALL + row) * 8 + hh];
            const u32x4* vv = (const u32x4*)(VV + (size_t)row * 512 + hh * 64 + hf * 32);
            const f32x4* gw4 = (const f32x4*)(gnw + hh * 64 + hf * 32); const f32x4* gb4 = (const f32x4*)(gnb + hh * 64 + hf * 32);
#pragma unroll
            for (int k = 0; k < 4; ++k) { const u32x4 v = vv[k]; const f32x4 w0 = gw4[2 * k], w1 = gw4[2 * k + 1], b0 = gb4[2 * k], b1 = gb4[2 * k + 1];
                u32x4 o;
                const float ys = RW_DBG == 4 ? 0.f : rstd, bs = RW_DBG == 5 ? 0.f : bon;
                o.x = pk2(y[8 * k + 0] * ys * w0.x + b0.x + bs * bflo(v.x), y[8 * k + 1] * ys * w0.y + b0.y + bs * bfhi(v.x));
                o.y = pk2(y[8 * k + 2] * ys * w0.z + b0.z + bs * bflo(v.y), y[8 * k + 3] * ys * w0.w + b0.w + bs * bfhi(v.y));
                o.z = pk2(y[8 * k + 4] * ys * w1.x + b1.x + bs * bflo(v.z), y[8 * k + 5] * ys * w1.y + b1.y + bs * bfhi(v.z));
                o.w = pk2(y[8 * k + 6] * ys * w1.z + b1.z + bs * bflo(v.w), y[8 * k + 7] * ys * w1.w + b1.w + bs * bfhi(v.w));
                *(LAS u32x4*)(PRE + s * PRE_LD + hh * 64 + hf * 32 + 8 * k) = o; }
        }
        __syncthreads();
        {
            f32x4 acc[4][4];
#pragma unroll
            for (int mt = 0; mt < 4; ++mt)
#pragma unroll
                for (int nt = 0; nt < 4; ++nt) acc[mt][nt] = (f32x4){0.f, 0.f, 0.f, 0.f};
#pragma unroll
            for (int ks = 0; ks < 4; ++ks) {
                bf16x8 af[4], bfr[4];
#pragma unroll
                for (int mt = 0; mt < 4; ++mt) af[mt] = *(const LAS bf16x8*)(AG + (mt * 16 + fr) * AG_LD + ks * 32 + fq * 8);
#pragma unroll
                for (int nt = 0; nt < 4; ++nt) bfr[nt] = *(const bf16x8*)(GUP + (size_t)(wave * 64 + nt * 16 + fr) * 128 + ks * 32 + fq * 8);
#pragma unroll
                for (int mt = 0; mt < 4; ++mt)
#pragma unroll
                    for (int nt = 0; nt < 4; ++nt) acc[mt][nt] = __builtin_amdgcn_mfma_f32_16x16x32_bf16(af[mt], bfr[nt], acc[mt][nt], 0, 0, 0);
            }
#pragma unroll
            for (int mt = 0; mt < 4; ++mt)
#pragma unroll
                for (int nt = 0; nt < 4; ++nt)
#pragma unroll
                    for (int j = 0; j < 4; ++j) { LAS bf16_t* pp = PRE + (mt * 16 + fq * 4 + j) * PRE_LD + wave * 64 + nt * 16 + fr;
                        *pp = (bf16_t)f2bf((RW_DBG == 1 || RW_DBG >= 4) ? bf2f(*pp) : RW_DBG == 2 ? acc[mt][nt][j] : RW_DBG == 3 ? bf2f(AG[(mt * 16 + fq * 4 + j) * AG_LD + ((nt * 16 + fr) & 127)]) : bf2f(*pp) * acc[mt][nt][j]); }
        }
        __syncthreads();
#pragma unroll 2
        for (int i = 0; i < 8; ++i) { const int e = tid + i * NTHR, sr = e >> 6, ch = e & 63;
            *(u32x4*)(AO + (size_t)(row0 + sr) * 1024 + 512 + ch * 8) = *(const LAS u32x4*)(PRE + sr * PRE_LD + ch * 8); }
    }
}

__device__ __forceinline__ void phase_attention(Ctx& C, int l, bool with_ctx_units) {
    C.refresh();
    const int tid = C.tid, lane = C.lane, wave = C.wave, fr = lane & 15, fq = lane >> 4;
    constexpr int KS_LD = 72, VT_LD = 136, P_LD = 136, OFF_KS = 0, OFF_VT = 18432, OFF_P = 35840;
    LAS bf16_t* KS = (LAS bf16_t*)(C.lds + OFF_KS); LAS bf16_t* VT = (LAS bf16_t*)(C.lds + OFF_VT);
    LAS bf16_t* PW = (LAS bf16_t*)(C.lds + OFF_P + wave * (16 * P_LD * 2));
    const bf16_t* CA = (const bf16_t*)(C.ws + WS_F);
    bf16_t* AO = (bf16_t*)(C.ws + WS_AO);
    const int nunits = 256 + (with_ctx_units ? 32 : 0);
    const int g = wave >> 1, qhalf = wave & 1;
    for (int u = C.bid; u < nunits; u += C.G) {
        int b, kvh, qb, qseg;
        if (u < 256) { qseg = 1; b = u >> 5; kvh = (u >> 4) & 1; qb = u & 15; } else { const int v = u - 256; qseg = 0; b = v >> 2; kvh = (v >> 1) & 1; qb = v & 1; }
        const int qhead = kvh * 4 + g;
        const float sink = arg_in(15)[l * 8 + qhead];
        bf16x8 qf[4][2];
        const int qrow0 = urow(qseg, b, qb * 128 + qhalf * 64);
#pragma unroll
        for (int mt = 0; mt < 4; ++mt)
#pragma unroll
            for (int ks = 0; ks < 2; ++ks) qf[mt][ks] = *(const bf16x8*)(CA + (size_t)(qrow0 + mt * 16 + fr) * NA + qhead * 64 + ks * 32 + fq * 8);
        f32x4 O[4][4]; float mrow[4][4], lrow[4][4];
#pragma unroll
        for (int mt = 0; mt < 4; ++mt)
#pragma unroll
            for (int j = 0; j < 4; ++j) { O[mt][j] = (f32x4){0.f, 0.f, 0.f, 0.f}; mrow[mt][j] = sink; lrow[mt][j] = 1.0f; }
        const int nkb = qseg ? 5 : 2;
        for (int kbi = 0; kbi < nkb; ++kbi) {
            int kseg, kblk;
            if (qseg) { if (kbi < 3) { kseg = 1; kblk = qb - 1 + kbi; } else { kseg = 0; kblk = kbi - 3; } } else { kseg = 0; kblk = kbi; }
            if (kseg == 1 && (kblk < 0 || kblk > 15)) continue;
            __syncthreads();
            {
                const int krow0 = urow(kseg, b, kblk * 128);
#pragma unroll
                for (int i = 0; i < 2; ++i) { const int e = tid + i * NTHR, kr = e >> 3, ch = e & 7;
                    const bf16_t* src = CA + (size_t)(krow0 + kr) * NA;
                    const u32x4 kv = *(const u32x4*)(src + 512 + kvh * 64 + ch * 8);
                    *(LAS u32x4*)(KS + kr * KS_LD + ch * 8) = kv;
                    const u32x4 vv = *(const u32x4*)(src + 640 + kvh * 64 + ch * 8);
                    LAS bf16_t* vd = VT + (ch * 8) * VT_LD + kr;
                    vd[0 * VT_LD] = (bf16_t)(vv.x & 0xffff); vd[1 * VT_LD] = (bf16_t)(vv.x >> 16); vd[2 * VT_LD] = (bf16_t)(vv.y & 0xffff); vd[3 * VT_LD] = (bf16_t)(vv.y >> 16);
                    vd[4 * VT_LD] = (bf16_t)(vv.z & 0xffff); vd[5 * VT_LD] = (bf16_t)(vv.z >> 16); vd[6 * VT_LD] = (bf16_t)(vv.w & 0xffff); vd[7 * VT_LD] = (bf16_t)(vv.w >> 16); }
            }
            __syncthreads();
            const bool windowed = (qseg == 1 && kseg == 1);
            const int dblk = (kblk - qb) * 128;
#pragma unroll
            for (int mt = 0; mt < 4; ++mt) {
                f32x4 S[8];
#pragma unroll
                for (int nt = 0; nt < 8; ++nt) S[nt] = (f32x4){0.f, 0.f, 0.f, 0.f};
#pragma unroll
                for (int ks = 0; ks < 2; ++ks)
#pragma unroll
                    for (int nt = 0; nt < 8; ++nt) { const bf16x8 kf = *(const LAS bf16x8*)(KS + (nt * 16 + fr) * KS_LD + ks * 32 + fq * 8);
                        S[nt] = __builtin_amdgcn_mfma_f32_16x16x32_bf16(qf[mt][ks], kf, S[nt], 0, 0, 0); }
                if (windowed) {
#pragma unroll
                    for (int nt = 0; nt < 8; ++nt)
#pragma unroll
                        for (int j = 0; j < 4; ++j) { const int d = dblk + (nt * 16 + fr) - (qhalf * 64 + mt * 16 + fq * 4 + j); if (d > 128 || d < -128) S[nt][j] = -1e30f; }
                }
#pragma unroll
                for (int j = 0; j < 4; ++j) {
                    float mx = S[0][j];
#pragma unroll
                    for (int nt = 1; nt < 8; ++nt) mx = fmaxf(mx, S[nt][j]);
                    mx = allreduce16_max(mx);
                    const float mn = fmaxf(mrow[mt][j], mx), alpha = __expf(mrow[mt][j] - mn);
                    mrow[mt][j] = mn;
                    float rs = 0.f;
#pragma unroll
                    for (int nt = 0; nt < 8; ++nt) { const float p = __expf(S[nt][j] - mn); rs += p; PW[(fq * 4 + j) * P_LD + nt * 16 + fr] = (bf16_t)f2bf(p); }
                    rs = allreduce16(rs);
                    lrow[mt][j] = lrow[mt][j] * alpha + rs;
#pragma unroll
                    for (int nd = 0; nd < 4; ++nd) O[mt][nd][j] *= alpha;
                }
#pragma unroll
                for (int ks = 0; ks < 4; ++ks) { const bf16x8 pf = *(const LAS bf16x8*)(PW + fr * P_LD + ks * 32 + fq * 8);
#pragma unroll
                    for (int nd = 0; nd < 4; ++nd) { const bf16x8 vf = *(const LAS bf16x8*)(VT + (nd * 16 + fr) * VT_LD + ks * 32 + fq * 8);
                        O[mt][nd] = __builtin_amdgcn_mfma_f32_16x16x32_bf16(pf, vf, O[mt][nd], 0, 0, 0); } }
            }
        }
#pragma unroll
        for (int mt = 0; mt < 4; ++mt) {
#pragma unroll
            for (int j = 0; j < 4; ++j) { const float inv = 1.0f / lrow[mt][j];
#pragma unroll
                for (int nd = 0; nd < 4; ++nd) PW[(fq * 4 + j) * P_LD + nd * 16 + fr] = (bf16_t)f2bf(O[mt][nd][j] * inv); }
#pragma unroll
            for (int i = 0; i < 2; ++i) { const int e = lane + i * 64, rr = e >> 3, ch = e & 7;
                *(u32x4*)(AO + (size_t)(qrow0 + mt * 16 + rr) * 1024 + qhead * 64 + ch * 8) = *(const LAS u32x4*)(PW + rr * P_LD + ch * 8); }
        }
    }
}

namespace rt {
__device__ __forceinline__ int chunk_row0(int b, int c) { return c < 2 ? b * CTX + c * 128 : T_CTX + b * SEQ + (c - 2) * 128; }
__device__ __forceinline__ int chunk_gpos0(int c) { return c < 2 ? c * 128 : CTX + (c - 2) * 128; }
__device__ __forceinline__ float log_g(int l, int dir, int h) { const float x = arg_in(12)[(l * 2 + dir) * 8 + h]; return -log1pf(__expf(-x)); }
}
__device__ __forceinline__ void phase_ret_u(Ctx& C, int l) {
    C.refresh();
    const int tid = C.tid, lane = C.lane, wave = C.wave, fr = lane & 15, fq = lane >> 4;
    constexpr int KT_LD = 136, VT_LD = 136, OFF_KF = 0, OFF_KB = 17408, OFF_VT = 34816;
    LAS bf16_t* KF = (LAS bf16_t*)(C.lds + OFF_KF); LAS bf16_t* KB = (LAS bf16_t*)(C.lds + OFF_KB); LAS bf16_t* VT = (LAS bf16_t*)(C.lds + OFF_VT);
    bf16_t* CB = (bf16_t*)(C.ws + WS_F);
    bf16_t* RS = (bf16_t*)(C.ws + WS_F2);
    const int p = tid & 31, i0 = tid >> 5;
    const float inv = __expf(-(float)p * (9.210340371976184f / 32.0f));
    for (int u = C.bid; u < 8 * 8 * 18; u += C.G) {
        const int b = u / 144, h = (u / 18) & 7, c = u % 18;
        const int row0 = rt::chunk_row0(b, c), gpos0 = rt::chunk_gpos0(c);
        const float lgf = rt::log_g(l, 0, h), lgb = rt::log_g(l, 1, h);
        __syncthreads();
#pragma unroll 2
        for (int it = 0; it < 8; ++it) {
            const int m = i0 + 16 * it;
            bf16_t* rowp = CB + (size_t)(row0 + m) * NBW;
            float sn, cs; __sincosf((float)(gpos0 + m) * inv, &sn, &cs);
            const float q1 = bf2f(rowp[h * 64 + p]), q2 = bf2f(rowp[h * 64 + 32 + p]);
            const float k1 = bf2f(rowp[512 + h * 64 + p]) * 0.125f, k2 = bf2f(rowp[512 + h * 64 + 32 + p]) * 0.125f;
            const float qa = q1 * cs - q2 * sn, qb = q1 * sn + q2 * cs, ka = k1 * cs - k2 * sn, kb = k1 * sn + k2 * cs;
            const bf16_t kab = (bf16_t)f2bf(ka), kbb = (bf16_t)f2bf(kb);
            rowp[h * 64 + p] = (bf16_t)f2bf(qa); rowp[h * 64 + 32 + p] = (bf16_t)f2bf(qb); rowp[512 + h * 64 + p] = kab; rowp[512 + h * 64 + 32 + p] = kbb;
            const float zf = __expf(lgf * (float)(127 - m)), zb = __expf(lgb * (float)m);
            const float kar = bf2f(kab), kbr = bf2f(kbb);
            KF[p * KT_LD + m] = (bf16_t)f2bf(kar * zf); KF[(p + 32) * KT_LD + m] = (bf16_t)f2bf(kbr * zf);
            KB[p * KT_LD + m] = (bf16_t)f2bf(kar * zb); KB[(p + 32) * KT_LD + m] = (bf16_t)f2bf(kbr * zb);
        }
#pragma unroll
        for (int i = 0; i < 4; ++i) { const int e = tid + i * NTHR, m = e >> 4, ch = e & 15;
            const u32x4 vv = *(const u32x4*)(CB + (size_t)(row0 + m) * NBW + 1024 + h * 128 + ch * 8);
            LAS bf16_t* vd = VT + (ch * 8) * VT_LD + m;
            vd[0 * VT_LD] = (bf16_t)(vv.x & 0xffff); vd[1 * VT_LD] = (bf16_t)(vv.x >> 16); vd[2 * VT_LD] = (bf16_t)(vv.y & 0xffff); vd[3 * VT_LD] = (bf16_t)(vv.y >> 16);
            vd[4 * VT_LD] = (bf16_t)(vv.z & 0xffff); vd[5 * VT_LD] = (bf16_t)(vv.z >> 16); vd[6 * VT_LD] = (bf16_t)(vv.w & 0xffff); vd[7 * VT_LD] = (bf16_t)(vv.w >> 16); }
        __syncthreads();
        f32x4 acc[2][4];
#pragma unroll
        for (int d = 0; d < 2; ++d)
#pragma unroll
            for (int nt = 0; nt < 4; ++nt) acc[d][nt] = (f32x4){0.f, 0.f, 0.f, 0.f};
#pragma unroll
        for (int ks = 0; ks < 4; ++ks) { const bf16x8 af = *(const LAS bf16x8*)(VT + (wave * 16 + fr) * VT_LD + ks * 32 + fq * 8);
#pragma unroll
            for (int nt = 0; nt < 4; ++nt) { const bf16x8 b0 = *(const LAS bf16x8*)(KF + (nt * 16 + fr) * KT_LD + ks * 32 + fq * 8), b1 = *(const LAS bf16x8*)(KB + (nt * 16 + fr) * KT_LD + ks * 32 + fq * 8);
                acc[0][nt] = __builtin_amdgcn_mfma_f32_16x16x32_bf16(af, b0, acc[0][nt], 0, 0, 0); acc[1][nt] = __builtin_amdgcn_mfma_f32_16x16x32_bf16(af, b1, acc[1][nt], 0, 0, 0); } }
        const int idxf = c, idxb = c < 2 ? 1 - c : 19 - c;
        LAS bf16_t* ST = (LAS bf16_t*)(C.lds + 69632 + wave * 2304);
#pragma unroll
        for (int d = 0; d < 2; ++d) { bf16_t* dst = RS + ((size_t)(((b * 8 + h) * 2 + d) * 18 + (d ? idxb : idxf))) * 8192 + (size_t)(wave * 16) * 64;
#pragma unroll
            for (int nt = 0; nt < 4; ++nt)
#pragma unroll
                for (int j = 0; j < 4; ++j) ST[(fq * 4 + j) * 72 + nt * 16 + fr] = (bf16_t)f2bf(acc[d][nt][j]);
#pragma unroll
            for (int i = 0; i < 2; ++i) { const int e = lane + i * 64, rr = e >> 3, ch = e & 7; *(u32x4*)(dst + rr * 64 + ch * 8) = *(const LAS u32x4*)(ST + rr * 72 + ch * 8); } }
    }
}
__device__ __forceinline__ void phase_ret_o(Ctx& C, int l, int c_lo) {
    C.refresh();
    const int tid = C.tid, lane = C.lane, wave = C.wave, fr = lane & 15, fq = lane >> 4;
    constexpr int Q_LD = 72, VT_LD = 136, S_LD = 72, P_LD = 136;
    constexpr int OFF_Q = 0, OFF_K = 18432, OFF_VT = 36864, OFF_SF = 71680, OFF_SB = 90112, OFF_P = 108544;
    LAS bf16_t* QS = (LAS bf16_t*)(C.lds + OFF_Q); LAS bf16_t* KS = (LAS bf16_t*)(C.lds + OFF_K); LAS bf16_t* VT = (LAS bf16_t*)(C.lds + OFF_VT);
    LAS bf16_t* SF = (LAS bf16_t*)(C.lds + OFF_SF); LAS bf16_t* SB = (LAS bf16_t*)(C.lds + OFF_SB);
    LAS bf16_t* PW = (LAS bf16_t*)(C.lds + OFF_P + wave * (16 * P_LD * 2));
    bf16_t* CB = (bf16_t*)(C.ws + WS_F);
    const bf16_t* RS = (const bf16_t*)(C.ws + WS_F2);
    const int ncl = 18 - c_lo;
    for (int u = C.bid; u < 64 * ncl; u += C.G) {
        const int b = u / (8 * ncl), h = (u / ncl) & 7, c = c_lo + u % ncl;
        const int row0 = rt::chunk_row0(b, c);
        const float lgf = rt::log_g(l, 0, h), lgb = rt::log_g(l, 1, h);
        __syncthreads();
#pragma unroll
        for (int i = 0; i < 2; ++i) { const int e = tid + i * NTHR, m = e >> 3, ch = e & 7; const bf16_t* src = CB + (size_t)(row0 + m) * NBW + h * 64 + ch * 8;
            *(LAS u32x4*)(QS + m * Q_LD + ch * 8) = *(const u32x4*)src; *(LAS u32x4*)(KS + m * Q_LD + ch * 8) = *(const u32x4*)(src + 512); }
#pragma unroll
        for (int i = 0; i < 4; ++i) { const int e = tid + i * NTHR, m = e >> 4, ch = e & 15;
            const u32x4 vv = *(const u32x4*)(CB + (size_t)(row0 + m) * NBW + 1024 + h * 128 + ch * 8);
            LAS bf16_t* vd = VT + (ch * 8) * VT_LD + m;
            vd[0 * VT_LD] = (bf16_t)(vv.x & 0xffff); vd[1 * VT_LD] = (bf16_t)(vv.x >> 16); vd[2 * VT_LD] = (bf16_t)(vv.y & 0xffff); vd[3 * VT_LD] = (bf16_t)(vv.y >> 16);
            vd[4 * VT_LD] = (bf16_t)(vv.z & 0xffff); vd[5 * VT_LD] = (bf16_t)(vv.z >> 16); vd[6 * VT_LD] = (bf16_t)(vv.w & 0xffff); vd[7 * VT_LD] = (bf16_t)(vv.w >> 16); }
#pragma unroll
        for (int d = 0; d < 2; ++d) {
            const int idx = d ? (c < 2 ? 1 - c : 19 - c) : c;
            const float cd = __expf((d ? lgb : lgf) * 128.0f);
            const bf16_t* base = RS + ((size_t)(((b * 8 + h) * 2 + d) * 18)) * 8192;
            LAS bf16_t* dst = d ? SB : SF;
#pragma unroll
            for (int i = 0; i < 2; ++i) { const int e = tid + i * NTHR, er = e >> 3, ch = e & 7;
                float a[8];
#pragma unroll
                for (int k = 0; k < 8; ++k) a[k] = 0.f;
                float wgt = 1.0f;
                for (int ip = idx - 1; ip >= 0; --ip) { const u32x4 uv = *(const u32x4*)(base + (size_t)ip * 8192 + er * 64 + ch * 8);
                    a[0] += wgt * bflo(uv.x); a[1] += wgt * bfhi(uv.x); a[2] += wgt * bflo(uv.y); a[3] += wgt * bfhi(uv.y); a[4] += wgt * bflo(uv.z); a[5] += wgt * bfhi(uv.z); a[6] += wgt * bflo(uv.w); a[7] += wgt * bfhi(uv.w);
                    wgt *= cd; }
                u32x4 o; o.x = pk2(a[0], a[1]); o.y = pk2(a[2], a[3]); o.z = pk2(a[4], a[5]); o.w = pk2(a[6], a[7]);
                *(LAS u32x4*)(dst + er * S_LD + ch * 8) = o; }
        }
        __syncthreads();
        bf16x8 qf[2];
#pragma unroll
        for (int ks = 0; ks < 2; ++ks) qf[ks] = *(const LAS bf16x8*)(QS + (wave * 16 + fr) * Q_LD + ks * 32 + fq * 8);
        f32x4 O[8];
        {
            f32x4 t[8];
#pragma unroll
            for (int nt = 0; nt < 8; ++nt) t[nt] = (f32x4){0.f, 0.f, 0.f, 0.f};
#pragma unroll
            for (int ks = 0; ks < 2; ++ks)
#pragma unroll
                for (int nt = 0; nt < 8; ++nt) t[nt] = __builtin_amdgcn_mfma_f32_16x16x32_bf16(qf[ks], *(const LAS bf16x8*)(SF + (nt * 16 + fr) * S_LD + ks * 32 + fq * 8), t[nt], 0, 0, 0);
            float xi[4];
#pragma unroll
            for (int j = 0; j < 4; ++j) xi[j] = __expf(lgf * (float)(wave * 16 + fq * 4 + j + 1));
#pragma unroll
            for (int nt = 0; nt < 8; ++nt)
#pragma unroll
                for (int j = 0; j < 4; ++j) O[nt][j] = xi[j] * t[nt][j];
#pragma unroll
            for (int nt = 0; nt < 8; ++nt) t[nt] = (f32x4){0.f, 0.f, 0.f, 0.f};
#pragma unroll
            for (int ks = 0; ks < 2; ++ks)
#pragma unroll
                for (int nt = 0; nt < 8; ++nt) t[nt] = __builtin_amdgcn_mfma_f32_16x16x32_bf16(qf[ks], *(const LAS bf16x8*)(SB + (nt * 16 + fr) * S_LD + ks * 32 + fq * 8), t[nt], 0, 0, 0);
#pragma unroll
            for (int j = 0; j < 4; ++j) xi[j] = __expf(lgb * (float)(128 - (wave * 16 + fq * 4 + j)));
#pragma unroll
            for (int nt = 0; nt < 8; ++nt)
#pragma unroll
                for (int j = 0; j < 4; ++j) O[nt][j] += xi[j] * t[nt][j];
        }
        {
            f32x4 S[8];
#pragma unroll
            for (int nt = 0; nt < 8; ++nt) S[nt] = (f32x4){0.f, 0.f, 0.f, 0.f};
#pragma unroll
            for (int ks = 0; ks < 2; ++ks)
#pragma unroll
                for (int nt = 0; nt < 8; ++nt) S[nt] = __builtin_amdgcn_mfma_f32_16x16x32_bf16(qf[ks], *(const LAS bf16x8*)(KS + (nt * 16 + fr) * Q_LD + ks * 32 + fq * 8), S[nt], 0, 0, 0);
#pragma unroll
            for (int nt = 0; nt < 8; ++nt)
#pragma unroll
                for (int j = 0; j < 4; ++j) { const int i = wave * 16 + fq * 4 + j, jj = nt * 16 + fr, df = i - jj;
                    const float dec = (df >= 0 ? __expf(lgf * (float)df) : 0.f) + (df <= 0 ? __expf(lgb * (float)(-df)) : 0.f);
                    PW[(fq * 4 + j) * P_LD + jj] = (bf16_t)f2bf(S[nt][j] * dec); }
        }
#pragma unroll
        for (int ks = 0; ks < 4; ++ks) { const bf16x8 pf = *(const LAS bf16x8*)(PW + fr * P_LD + ks * 32 + fq * 8);
#pragma unroll
            for (int nt = 0; nt < 8; ++nt) O[nt] = __builtin_amdgcn_mfma_f32_16x16x32_bf16(pf, *(const LAS bf16x8*)(VT + (nt * 16 + fr) * VT_LD + ks * 32 + fq * 8), O[nt], 0, 0, 0); }
        {
            bf16_t* gbase = CB + (size_t)(row0 + wave * 16) * NBW + 2048 + h * 128;
#pragma unroll
            for (int i = 0; i < 4; ++i) { const int e = lane + i * 64, rr = e >> 4, ch = e & 15; *(LAS u32x4*)(PW + rr * P_LD + ch * 8) = *(const u32x4*)(gbase + (size_t)rr * NBW + ch * 8); }
#pragma unroll
            for (int j = 0; j < 4; ++j) {
                float sm = 0.f;
#pragma unroll
                for (int nt = 0; nt < 8; ++nt) sm += O[nt][j];
                const float mean = allreduce16(sm) * (1.0f / 128.0f);
                float vr = 0.f;
#pragma unroll
                for (int nt = 0; nt < 8; ++nt) { const float dd = O[nt][j] - mean; vr += dd * dd; }
                const float rstd = 1.0f / sqrtf(allreduce16(vr) * (1.0f / 128.0f) + 1e-6f);
#pragma unroll
                for (int nt = 0; nt < 8; ++nt) { LAS bf16_t* pp = PW + (fq * 4 + j) * P_LD + nt * 16 + fr; *pp = (bf16_t)f2bf(siluf_(bf2f(*pp)) * (O[nt][j] - mean) * rstd); }
            }
#pragma unroll
            for (int i = 0; i < 4; ++i) { const int e = lane + i * 64, rr = e >> 4, ch = e & 15; *(u32x4*)(gbase + (size_t)rr * NBW + ch * 8) = *(const LAS u32x4*)(PW + rr * P_LD + ch * 8); }
        }
    }
}

struct MergeSched {
    unsigned char* ws; int pm0, nM, G, c;
    __device__ __forceinline__ bool next(int i, pg8::Unit& u, pg8::Opnd& o) const {
        const int ti = i / 6, op = i - ti * 6;
        int pm, pn; if (!pg8::tile_order(ti, G, c, nM, 4, pm, pn)) return false;
        pm += pm0; u.pm = pm; u.pn = pn; u.op = op;
        const char* W = (const char*)(ws + WS_W);
        if ((op & 1) == 0) { o.A = (const char*)(ws + WS_H) + (size_t)pm * 256 * 2048; o.lda = 2048; o.B = W + W_GATE + (size_t)((op >> 1) * 1024 + pn * 256) * 2048; o.ldb = 2048; o.nt = 16; }
        else if (op == 1) { o.A = (const char*)(ws + WS_F) + (size_t)pm * 256 * (NBW * 2) + 2048 * 2; o.lda = NBW * 2; o.B = W + W_RET + (size_t)pn * 256 * 2048; o.ldb = 2048; o.nt = 16; }
        else { o.A = (const char*)(ws + WS_AO) + (size_t)pm * 256 * 2048 + (op == 5 ? 1024 : 0); o.lda = 2048; o.B = W + (op == 3 ? W_ATT : W_RWKV) + (size_t)pn * 256 * 1024; o.ldb = 1024; o.nt = 8; }
        return true;
    }
};
struct EpiMerge {
    static constexpr bool PERM = true;
    bf16_t* scr; bf16_t* MG;
    __device__ __forceinline__ void operator()(const f32x4 (&acc)[2][2][4][2], const pg8::Unit& u, int wr, int wc, int fr, int fq) const {
        const int lr0 = wr * 64 + fr, lc0 = wc * 32 + 8 * fq;
#pragma unroll
        for (int ai = 0; ai < 2; ++ai)
#pragma unroll
            for (int m = 0; m < 4; ++m) { const int lr = lr0 + ai * 128 + m * 16;
#pragma unroll
                for (int bj = 0; bj < 2; ++bj) { const f32x4 v0 = acc[ai][bj][m][0], v1 = acc[ai][bj][m][1];
                    u32x4* sp = (u32x4*)(scr + lr * 256 + lc0 + bj * 128);
                    if ((u.op & 1) == 0) {
                        u32x4 w; w.x = pg8::cvt_pk_bf16(sigmoidf_(v0[0]), sigmoidf_(v0[1])); w.y = pg8::cvt_pk_bf16(sigmoidf_(v0[2]), sigmoidf_(v0[3]));
                        w.z = pg8::cvt_pk_bf16(sigmoidf_(v1[0]), sigmoidf_(v1[1])); w.w = pg8::cvt_pk_bf16(sigmoidf_(v1[2]), sigmoidf_(v1[3])); *sp = w;
                    } else {
                        const u32x4 gq = *sp; const bool keep = ((BR_MASK >> (u.op >> 1)) & 1) != 0; u32x4* mp = (u32x4*)(MG + (size_t)(u.pm * 256 + lr) * 1024 + u.pn * 256 + lc0 + bj * 128);
                        u32x4 pv = (u32x4){0u, 0u, 0u, 0u}; if (u.op != 1) pv = *mp;
                        u32x4 w;
                        if (keep) {
                        w.x = pg8::cvt_pk_bf16(bflo(pv.x) + bflo(gq.x) * v0[0], bfhi(pv.x) + bfhi(gq.x) * v0[1]); w.y = pg8::cvt_pk_bf16(bflo(pv.y) + bflo(gq.y) * v0[2], bfhi(pv.y) + bfhi(gq.y) * v0[3]);
                        w.z = pg8::cvt_pk_bf16(bflo(pv.z) + bflo(gq.z) * v1[0], bfhi(pv.z) + bfhi(gq.z) * v1[1]); w.w = pg8::cvt_pk_bf16(bflo(pv.w) + bflo(gq.w) * v1[2], bfhi(pv.w) + bfhi(gq.w) * v1[3]);
                        } else w = pv;
                        *mp = w;
                    } } }
    }
};
__device__ __forceinline__ void phase_merge(Ctx& C, int pm0, int nM) {
    C.refresh();
    MergeSched S{C.ws, pm0, nM, C.G, C.bid};
    EpiMerge E{(bf16_t*)(C.ws + WS_GSCR) + (size_t)C.bid * 65536, (bf16_t*)(C.ws + WS_F2)};
    pg8::gemm_phase<EpiMerge, MergeSched, true>(C.lds, C.tid, S, E);
}
__device__ __forceinline__ void phase_wout(Ctx& C, int l, int pm0, int nM) {
    C.refresh();
    pg8::StdSched S{(const char*)(C.ws + WS_F2), (const char*)(C.ws + WS_W + W_OUT), D * 2, D * 2, D / 64, pm0, nM, 4, C.G, C.bid};
    EpiResid E{(float*)(C.ws + WS_S), arg_out(), (const float*)(C.ws + WS_MODS) + (size_t)l * 9 * NADA * D, 5, 1.0f};
    pg8::gemm_phase<EpiResid, pg8::StdSched>(C.lds, C.tid, S, E);
}

__global__ void __launch_bounds__(NTHR, 2) fwd_megakernel(Params prm) {
    cg::grid_group grid = cg::this_grid();
    extern __shared__ __attribute__((aligned(16))) unsigned char lds_raw[];
    Ctx C; C.lds = (LAS unsigned char*)lds_raw;
    C.wave_s = __builtin_amdgcn_readfirstlane((int)threadIdx.x >> 6); C.refresh();
    volatile LAS unsigned* MISC = (volatile LAS unsigned*)(C.lds + LDS_MISC);
    if (C.tid < 64) MISC[C.tid] = 0u;
    __syncthreads();
    XcdBarrier bar = xcd_barrier_post((unsigned*)(C.ws + WS_CTL) + CW_BAR, MISC + 8);
#define GRID_BAR() xcd_barrier(bar)
    int ph = 0; const int stop_after = (int)(unsigned)karg_u64(8 * 36);
#define DONE_IF_STOP() do { if (++ph >= stop_after) return; } while (0)

    phase_init(C);
    grid.sync();
#pragma unroll 1
    for (int l = 0; l < 2; ++l) {
        phase_convert(C, l);
        phase_norm(C, l, 0, 0);
        GRID_BAR();
        phase_ffn_in(C, W_FFN1_IN, 0, 72);
        GRID_BAR();
        phase_ffn_out(C, l, W_FFN1_OUT, 2, 0, 72);
        GRID_BAR();
        DONE_IF_STOP();
        phase_norm(C, l, 1, 0);
        GRID_BAR();
        phase_mix(C, W_MIXA, NA);
        GRID_BAR();
        att_prep(C, l);
        phase_rwkv_scan(C, l);
        GRID_BAR();
        phase_rwkv_out(C, l, l == 0 ? 0 : T_CTX / 64);
        phase_attention(C, l, l == 0);
        GRID_BAR();
        phase_mix(C, W_MIXB, NBW);
        GRID_BAR();
        phase_ret_u(C, l);
        GRID_BAR();
        phase_ret_o(C, l, l == 0 ? 0 : 2);
        GRID_BAR();
        DONE_IF_STOP();
        const int pm0 = l == 0 ? 0 : 8, nM = l == 0 ? 72 : 64;
        phase_merge(C, pm0, nM);
        GRID_BAR();
        phase_wout(C, l, pm0, nM);
        GRID_BAR();
        DONE_IF_STOP();
        phase_norm(C, l, 2, pm0 * 256);
        GRID_BAR();
        phase_ffn_in(C, W_FFN2_IN, pm0, nM);
        GRID_BAR();
        phase_ffn_out(C, l, W_FFN2_OUT, 8, pm0, nM);
        GRID_BAR();
        DONE_IF_STOP();
    }
}

extern "C" void kernel_launch(void* const* d_in, const int* in_sizes, int n_in, void* d_out, int out_size, void* d_ws, size_t ws_size, hipStream_t stream) {
    static int grid_blocks = 0;
    if (!grid_blocks) {
        if (n_in != 34 || ws_size < WS_END) { fprintf(stderr, "kernel_launch: unexpected n_in %d / ws_size %zu\n", n_in, ws_size); grid_blocks = -1; return; }
        int dev = 0, cus = 0, per_cu = 0;
        (void)hipGetDevice(&dev);
        (void)hipDeviceGetAttribute(&cus, hipDeviceAttributeMultiprocessorCount, dev);
        (void)hipFuncSetAttribute((const void*)fwd_megakernel, hipFuncAttributeMaxDynamicSharedMemorySize, LDS_BYTES);
        (void)hipOccupancyMaxActiveBlocksPerMultiprocessor(&per_cu, (const void*)fwd_megakernel, NTHR, LDS_BYTES);
        if (per_cu < 1) { fprintf(stderr, "kernel_launch: occupancy query says %d blocks per CU\n", per_cu); per_cu = 1; }
        grid_blocks = cus * 1;
        (void)hipGetLastError();
    }
    if (grid_blocks < 0) return;
    (void)hipMemsetAsync((char*)d_ws + WS_CTL, 0, WS_ZERO_BYTES, stream);
    Params p{};
    for (int i = 0; i < 34; ++i) p.in[i] = (const float*)d_in[i];
    p.out = (float*)d_out; p.ws = (unsigned char*)d_ws; p.stop = STOP_AFTER; p.pad = 0;
    void* args[] = {&p};
    hipError_t e = hipLaunchCooperativeKernel((void*)fwd_megakernel, dim3(grid_blocks), dim3(NTHR), args, LDS_BYTES, stream);
    if (e != hipSuccess) fprintf(stderr, "cooperative launch failed: %s (grid %d)\n", hipGetErrorString(e), grid_blocks);
}
```

```cpp
#include <hip/hip_runtime.h>
#include <hip/hip_cooperative_groups.h>
#include <cstdio>
#include <cstdint>
namespace cg = cooperative_groups;

#ifndef TSEL1
#define TSEL1 -1
#endif
#ifndef TSEL2
#define TSEL2 -1
#endif
#ifndef RW_DBG
#define RW_DBG 0
#endif
#ifndef BR_MASK
#define BR_MASK 7
#endif
#ifndef STOP_AFTER
#define STOP_AFTER 100
#endif

#define LAS __attribute__((address_space(3)))
typedef unsigned short bf16_t;
typedef short bf16x8 __attribute__((ext_vector_type(8)));
typedef float f32x4 __attribute__((ext_vector_type(4)));
typedef float f32x2 __attribute__((ext_vector_type(2)));
typedef unsigned u32x4 __attribute__((ext_vector_type(4)));
typedef unsigned u32x2 __attribute__((ext_vector_type(2)));

constexpr int D = 1024, NB = 8, SEQ = 2048, CTX = 256, DFF = 2816, NADA = 9, NIN = 8832;
constexpr int T_CTX = NB * CTX, T_LAT = NB * SEQ, T_ALL = T_CTX + T_LAT;
constexpr int FS = 3072;
__device__ __forceinline__ size_t bpart(int b, int slot, int slot_el) { const int nctx = 262144 / slot_el; return slot < nctx ? (size_t)b * 262144 + (size_t)slot * slot_el : (size_t)2097152 + (size_t)b * 2097152 + (size_t)(slot - nctx) * slot_el; }
constexpr int NA = 2816;
constexpr int NBW = 3072;
constexpr int NWAVES = 8, NTHR = 512;

constexpr size_t MiB = 1u << 20;
constexpr size_t WS_CTL = 0, WS_MODS = 1 * MiB, WS_ZERO_BYTES = 2 * MiB;
constexpr size_t WS_S = 2 * MiB;
constexpr size_t WS_H = 10 * MiB;
constexpr size_t WS_W = 46 * MiB;
constexpr size_t WS_VFIRST = 103 * MiB;
constexpr size_t WS_AO = 121 * MiB;
constexpr size_t WS_F = 157 * MiB;
constexpr size_t WS_F2 = WS_F + 108 * MiB;
constexpr size_t WS_BONUS = 301 * MiB;
constexpr size_t WS_GSCR = 303 * MiB;
constexpr size_t WS_VMIX = 335 * MiB;
constexpr size_t WS_GX = 353 * MiB;
constexpr size_t WS_END = 362 * MiB;
constexpr size_t W_FFN1_IN = 0, W_FFN1_OUT = 11 * MiB, W_FFN2_IN = W_FFN1_OUT + 5632 * 1024, W_FFN2_OUT = W_FFN2_IN + 11 * MiB,
                 W_MIXA = W_FFN2_OUT + 5632 * 1024, W_MIXB = W_MIXA + 5632 * 1024, W_GATE = W_MIXB + 6 * MiB, W_RET = W_GATE + 6 * MiB,
                 W_ATT = W_RET + 2 * MiB, W_RWKV = W_ATT + 1 * MiB, W_OUT = W_RWKV + 1 * MiB, W_GUP = W_OUT + 2 * MiB, W_WUP = W_GUP + 131072, W_END = W_WUP + 262144;
static_assert(W_END <= 57 * MiB, "W map");
constexpr int CW_BAR = 4096;

constexpr int LDS_BYTES = 163840;
constexpr int LDS_MISC = LDS_BYTES - 1024;

typedef float f32x2n __attribute__((ext_vector_type(2))); typedef __bf16 bf16x2n __attribute__((ext_vector_type(2)));
__device__ __forceinline__ unsigned pk2(float lo, float hi) { const f32x2n v = {lo, hi}; const bf16x2n b = __builtin_convertvector(v, bf16x2n); return __builtin_bit_cast(unsigned, b); }
__device__ __forceinline__ unsigned f2bf(float f) { return (unsigned)__builtin_bit_cast(unsigned short, (__bf16)f); }
__device__ __forceinline__ unsigned pk2h(float lo, float hi) { return pk2(lo, hi); }
__device__ __forceinline__ unsigned f2bfh(float f) { return f2bf(f); }
__device__ __forceinline__ float bf2f(unsigned short b) { return __builtin_bit_cast(float, (unsigned)b << 16); }
__device__ __forceinline__ float bflo(unsigned w) { return __builtin_bit_cast(float, w << 16); }
__device__ __forceinline__ float bfhi(unsigned w) { return __builtin_bit_cast(float, w & 0xffff0000u); }
__device__ __forceinline__ float sigmoidf_(float x) { return __builtin_amdgcn_rcpf(1.0f + __expf(-x)); }
__device__ __forceinline__ float siluf_(float x) { return x * __builtin_amdgcn_rcpf(1.0f + __expf(-x)); }
__device__ __forceinline__ float tanhf_(float x) { return 2.0f * __builtin_amdgcn_rcpf(1.0f + __expf(-2.0f * x)) - 1.0f; }
__device__ __forceinline__ float fma_s(float a, float b, float c) { float d; asm("v_fma_f32 %0, %1, %2, %3" : "=v"(d) : "v"(a), "v"(b), "v"(c)); return d; }
__device__ __forceinline__ float mul_s(float a, float b) { float d; asm("v_mul_f32 %0, %1, %2" : "=v"(d) : "v"(a), "v"(b)); return d; }
#define LDS_BARRIER() do { asm volatile("s_waitcnt lgkmcnt(0)" ::: "memory"); __builtin_amdgcn_s_barrier(); asm volatile("" ::: "memory"); } while (0)
#define DPP_MOV(x, ctrl) __builtin_bit_cast(float, __builtin_amdgcn_update_dpp(0, __builtin_bit_cast(int, (x)), (ctrl), 0xf, 0xf, true))
__device__ __forceinline__ float allreduce16(float x) {
    x += DPP_MOV(x, 0xB1); x += DPP_MOV(x, 0x4E); x += DPP_MOV(x, 0x141); x += DPP_MOV(x, 0x140); return x;
}
__device__ __forceinline__ float allreduce16_max(float x) {
    x = fmaxf(x, DPP_MOV(x, 0xB1)); x = fmaxf(x, DPP_MOV(x, 0x4E)); x = fmaxf(x, DPP_MOV(x, 0x141)); x = fmaxf(x, DPP_MOV(x, 0x140)); return x;
}
__device__ __forceinline__ float wave_sum(float v) {
    v = allreduce16(v);
    const float a = __builtin_bit_cast(float, __builtin_amdgcn_readlane(__builtin_bit_cast(int, v), 0)), b = __builtin_bit_cast(float, __builtin_amdgcn_readlane(__builtin_bit_cast(int, v), 16));
    const float c = __builtin_bit_cast(float, __builtin_amdgcn_readlane(__builtin_bit_cast(int, v), 32)), d = __builtin_bit_cast(float, __builtin_amdgcn_readlane(__builtin_bit_cast(int, v), 48));
    return (a + b) + (c + d);
}
#define LDS_WAIT() asm volatile("s_waitcnt lgkmcnt(0)" ::: "memory")

#define XB_TMO      128
#define XB_XCNT(j)  (256  + 64 * (j))
#define XB_XSUB(j)  (1280 + 64 * (j))
#define XB_XGEN(j)  (2304 + 64 * (j))
#define XB_TOP      3328
#define XB_TOPGEN   3392
#define XCD_BAR_WORDS 3456
#define XB_SPIN_CAP (1u << 20)
__device__ __forceinline__ unsigned xb_ld(unsigned* p)              { return __hip_atomic_load(p, __ATOMIC_RELAXED, __HIP_MEMORY_SCOPE_AGENT); }
__device__ __forceinline__ unsigned xb_add(unsigned* p, unsigned v) { return __hip_atomic_fetch_add(p, v, __ATOMIC_RELAXED, __HIP_MEMORY_SCOPE_AGENT); }
__device__ __forceinline__ unsigned xb_xcc_id() { return (unsigned)__builtin_amdgcn_s_getreg((3 << 11) | 20) & 0xFu; }
#define XB_SPIN(cond, bar) do { unsigned _sp = 0; while (cond) { __builtin_amdgcn_s_sleep(1); \
    if ((++_sp & 255u) == 0u) { if (xb_ld(&(bar)[XB_TMO])) break; if (_sp > XB_SPIN_CAP) { atomicAdd(&(bar)[XB_TMO], 1u); break; } } } } while (0)
struct XcdBarrier { unsigned* bar; unsigned x; volatile LAS unsigned* st; };
__device__ __forceinline__ XcdBarrier xcd_barrier_post(unsigned* bar, volatile LAS unsigned* st) {
    XcdBarrier b; b.bar = bar; b.x = xb_xcc_id(); b.st = st;
    if (threadIdx.x == 0) (void)xb_add(&bar[XB_XCNT(b.x)], 1u);
    return b;
}
__device__ __forceinline__ void xcd_barrier_complete(unsigned* bar, unsigned x, unsigned& nloc, unsigned& nx) {
    const unsigned G = gridDim.x * gridDim.y * gridDim.z;
    unsigned sum, cnt, mine, sp = 0u;
    for (;;) {
        sum = 0u; cnt = 0u; mine = 0u;
#pragma unroll
        for (unsigned j = 0; j < 16; ++j) { const unsigned c = xb_ld(&bar[XB_XCNT(j)]); sum += c; cnt += (c > 0u) ? 1u : 0u; mine = (j == x) ? c : mine; }
        if (sum == G) break;
        __builtin_amdgcn_s_sleep(1);
        if ((++sp & 255u) == 0u) { if (xb_ld(&bar[XB_TMO])) break; if (sp > XB_SPIN_CAP) { atomicAdd(&bar[XB_TMO], 1u); break; } }
    }
    nloc = mine > 0u ? mine : 1u; nx = cnt > 0u ? cnt : 1u;
}
__device__ __forceinline__ void xcd_barrier(const XcdBarrier& b) {
    asm volatile("s_waitcnt vmcnt(0)" ::: "memory");
    __syncthreads();
    if (threadIdx.x == 0) {
        unsigned* bar = b.bar;
        __builtin_amdgcn_s_waitcnt(0);
        unsigned nloc = b.st[0], nx = b.st[1];
        if (nloc == 0u) { xcd_barrier_complete(bar, b.x, nloc, nx); b.st[0] = nloc; b.st[1] = nx; }
        const unsigned old = xb_add(&bar[XB_XSUB(b.x)], 1u);
        const unsigned gen = old / nloc;
        if (old + 1u == (gen + 1u) * nloc) {
            __builtin_amdgcn_fence(__ATOMIC_RELEASE, "agent");
            asm volatile("s_waitcnt vmcnt(0)" ::: "memory");
            const unsigned og = xb_add(&bar[XB_TOP], 1u);
            const unsigned tg = og / nx;
            if (og + 1u == (tg + 1u) * nx) xb_add(&bar[XB_TOPGEN], 1u);
            else XB_SPIN(xb_ld(&bar[XB_TOPGEN]) == tg, bar);
            __builtin_amdgcn_fence(__ATOMIC_ACQUIRE, "agent");
            xb_add(&bar[XB_XGEN(b.x)], 1u);
            asm volatile("s_waitcnt vmcnt(0)" ::: "memory");
        } else {
            XB_SPIN(xb_ld(&bar[XB_XGEN(b.x)]) == gen, bar);
            __builtin_amdgcn_fence(__ATOMIC_ACQUIRE, "agent");
            asm volatile("s_waitcnt vmcnt(0)" ::: "memory");
        }
    }
    __syncthreads();
}

__device__ __forceinline__ void group_sync(unsigned* cnt, unsigned n, unsigned* tmo) {
    asm volatile("s_waitcnt vmcnt(0)" ::: "memory");
    __syncthreads();
    if (threadIdx.x == 0) {
        unsigned long long* c64 = (unsigned long long*)cnt;
        (void)__hip_atomic_fetch_add(c64, 1ull << (8u * (xb_xcc_id() & 7u)), __ATOMIC_RELAXED, __HIP_MEMORY_SCOPE_AGENT);
        unsigned sp = 0u; unsigned long long v; bool local = false;
        for (;;) {
            v = __hip_atomic_load(c64, __ATOMIC_RELAXED, __HIP_MEMORY_SCOPE_AGENT);
            unsigned sum = 0u, mx = 0u;
#pragma unroll
            for (int i = 0; i < 8; ++i) { const unsigned bx = (unsigned)(v >> (8 * i)) & 255u; sum += bx; mx = bx > mx ? bx : mx; }
            if (sum >= n) { local = mx >= n; break; }
            __builtin_amdgcn_s_sleep(1);
            if ((++sp & 255u) == 0u) { if (xb_ld(tmo)) break; if (sp > XB_SPIN_CAP) { atomicAdd(tmo, 1u); break; } }
        }
        if (!local) {
            __builtin_amdgcn_fence(__ATOMIC_RELEASE, "agent");
            asm volatile("s_waitcnt vmcnt(0)" ::: "memory");
            (void)xb_add(cnt + 2, 1u);
            sp = 0u;
            while (xb_ld(cnt + 2) < n) { __builtin_amdgcn_s_sleep(1); if ((++sp & 255u) == 0u) { if (xb_ld(tmo)) break; if (sp > XB_SPIN_CAP) { atomicAdd(tmo, 1u); break; } } }
        }
        __builtin_amdgcn_fence(__ATOMIC_ACQUIRE, "agent");
        asm volatile("s_waitcnt vmcnt(0)" ::: "memory");
    }
    __syncthreads();
}

namespace pg8 {
constexpr int BM = 256, BK = 64, HALF = 128, HTB = HALF * BK * 2, NXCD = 8, WGM = 8;
__host__ __device__ __forceinline__ int lds_byte(int r, int c) { const int st = (r >> 4) * 2 + (c >> 5), rr = r & 15, cc = c & 31, ob = rr * 64 + cc * 2; return st * 1024 + (ob ^ (((ob >> 9) & 1) << 5)); }
__host__ __device__ __forceinline__ void stage_rc(int b, int& R, int& C) { const int st = b / 1024, sb = b % 1024, swz = sb ^ (((sb >> 9) & 1) << 5); R = (st >> 1) * 16 + swz / 64; C = (st & 1) * 32 + (swz % 64) / 2; }
__host__ __device__ __forceinline__ int perm32(int rho) { const int n = rho >> 4, i = rho & 15; return 8 * (i >> 2) + 4 * n + (i & 3); }
__device__ __forceinline__ unsigned cvt_pk_bf16(float lo, float hi) { return pk2(lo, hi); }

__device__ __forceinline__ void glds16_s(const char* sbase, unsigned voff, unsigned lds_dst) {
    unsigned keep;
    asm volatile("s_mov_b32 %0, m0\n\ts_mov_b32 m0, %3\n\ts_nop 0\n\tglobal_load_lds_dwordx4 %1, %2\n\ts_mov_b32 m0, %0" : "=&s"(keep) : "v"(voff), "s"(sbase), "s"(lds_dst) : "memory");
}
struct Unit { int pm, pn, op; };
__device__ __forceinline__ const char* opaque_sptr(const char* p) { unsigned long long v = (unsigned long long)p; asm volatile("" : "+s"(v)); return (const char*)v; }
struct Opnd { const char* A; const char* B; unsigned lda, ldb; int nt; };

__device__ __forceinline__ bool tile_order(int i, int G, int c, int nM, int nN, int& pm, int& pn) {
    const int nwg = nM * nN; const long L = (long)i * G + c; if (L >= nwg) return false;
    int wgid = (int)L; { const int q = nwg / NXCD, r = nwg % NXCD, xcd = wgid % NXCD, off = wgid / NXCD; wgid = (xcd < r ? xcd * (q + 1) : r * (q + 1) + (xcd - r) * q) + off; }
    const int nig = WGM * nN, gid = wgid / nig, fm = gid * WGM, gsz = (nM - fm) < WGM ? (nM - fm) : WGM;
    pm = fm + ((wgid % nig) % gsz); pn = (wgid % nig) / gsz; return true;
}

template <class Epi, class Sched, bool VARLD = false>
__device__ __forceinline__ void gemm_phase(LAS unsigned char* lds, int tid, const Sched& S, const Epi& E) {
    const int wid = __builtin_amdgcn_readfirstlane(tid >> 6), lane = tid & 63, wr = wid >> 2, wc = wid & 3, fr = lane & 15, fq = lane >> 4;
    int sR[2], sRb[2], sC[2];
#pragma unroll
    for (int i = 0; i < 2; ++i) { int R, C; stage_rc(tid * 16 + i * 8192, R, C); sR[i] = R; sRb[i] = Epi::PERM ? ((R & ~31) + perm32(R & 31)) : R; sC[i] = C * 2; }
    constexpr unsigned kstep = BK * 2;
    const unsigned ldsw = (unsigned)wid * 1024u, ldsbase = (unsigned)(unsigned long long)lds;
    const int aoff = lds_byte(wr * 64 + fr, fq * 8), boff = lds_byte(wc * 32 + fr, fq * 8);
#define PG8_SA(b, h) (((b) * 2 + (h)) * HTB)
#define PG8_SB(b, h) ((4 + (b) * 2 + (h)) * HTB)
#define PG8_STAGE(bufoff, gbase, voff) do { _Pragma("unroll") for (int _i = 0; _i < 2; ++_i) \
        glds16_s((const char*)(gbase), (voff)[_i], ldsbase + (unsigned)(bufoff) + ldsw + _i * 8192); } while (0)
#define PG8_LDA(dst, b, h) do { _Pragma("unroll") for (int m = 0; m < 4; ++m) _Pragma("unroll") for (int k = 0; k < 2; ++k) dst[m][k] = *(const LAS bf16x8*)(lds + PG8_SA(b, h) + aoff + m * 2048 + k * 1024); } while (0)
#define PG8_LDB(dst, b, h) do { _Pragma("unroll") for (int n = 0; n < 2; ++n) _Pragma("unroll") for (int k = 0; k < 2; ++k) dst[n][k] = *(const LAS bf16x8*)(lds + PG8_SB(b, h) + boff + n * 2048 + k * 1024); } while (0)
#define PG8_MMA(ai, bj, At, Bt) do { __builtin_amdgcn_s_setprio(1); _Pragma("unroll") for (int m = 0; m < 4; ++m) _Pragma("unroll") for (int n = 0; n < 2; ++n) _Pragma("unroll") for (int k = 0; k < 2; ++k) \
        acc[ai][bj][m][n] = __builtin_amdgcn_mfma_f32_16x16x32_bf16(Bt[n][k], At[m][k], acc[ai][bj][m][n], 0, 0, 0); __builtin_amdgcn_s_setprio(0); } while (0)
#define PG8_WAIT_V(n) asm volatile("s_waitcnt vmcnt(" #n ")" ::: "memory")
#define PG8_WAIT_L(n) asm volatile("s_waitcnt lgkmcnt(" #n ")" ::: "memory")
#define PG8_BAR __builtin_amdgcn_s_barrier()
#define PG8_SCHED __builtin_amdgcn_sched_barrier(0)
#define PG8_VOFF(o, vA, vB, hA, hB) do { _Pragma("unroll") for (int _i = 0; _i < 2; ++_i) { vA[_i] = (unsigned)sR[_i] * (o).lda + (unsigned)sC[_i]; vB[_i] = (unsigned)sRb[_i] * (o).ldb + (unsigned)sC[_i]; } \
        hA = (unsigned)HALF * (o).lda; hB = (unsigned)HALF * (o).ldb; asm volatile("" : "+s"(hA), "+s"(hB)); } while (0)
    Unit cur, nxt; Opnd co, no; int ui = 0;
    if (!S.next(0, cur, co)) return;
    f32x4 acc[2][2][4][2];
#pragma unroll
    for (int a = 0; a < 2; ++a)
#pragma unroll
        for (int b = 0; b < 2; ++b)
#pragma unroll
            for (int m = 0; m < 4; ++m)
#pragma unroll
                for (int n = 0; n < 2; ++n) acc[a][b][m][n] = (f32x4){0.f, 0.f, 0.f, 0.f};
    bf16x8 At[4][2], B0[2][2], B1[2][2];
    unsigned cvA[2], cvB[2], nvA[2], nvB[2]; unsigned chA, chB, nhA, nhB;
    PG8_VOFF(co, cvA, cvB, chA, chB);
    const char* cA = opaque_sptr(co.A); const char* cB = opaque_sptr(co.B); int nt = co.nt;
    PG8_STAGE(PG8_SB(0, 0), cB, cvB); PG8_STAGE(PG8_SB(0, 1), cB + chB, cvB); PG8_STAGE(PG8_SA(0, 0), cA, cvA); PG8_STAGE(PG8_SA(0, 1), cA + chA, cvA);
    if (wr == 1) PG8_BAR;
    PG8_WAIT_V(2); PG8_BAR;
    PG8_STAGE(PG8_SB(1, 0), cB + kstep, cvB); PG8_STAGE(PG8_SA(1, 0), cA + kstep, cvA); PG8_STAGE(PG8_SB(1, 1), cB + chB + kstep, cvB);
    PG8_WAIT_V(6); PG8_BAR;
    for (;;) {
        const bool has_next = S.next(ui + 1, nxt, no);
        const char* nA = opaque_sptr(has_next ? no.A : cA); const char* nB = opaque_sptr(has_next ? no.B : cB);
        int nnt = nt;
        if constexpr (VARLD) { if (has_next) { PG8_VOFF(no, nvA, nvB, nhA, nhB); nnt = no.nt; } else { nvA[0] = cvA[0]; nvA[1] = cvA[1]; nvB[0] = cvB[0]; nvB[1] = cvB[1]; nhA = chA; nhB = chB; } }
        for (int t = 0; t < nt; t += 2) {
            const bool last = (t == nt - 2);
            const char* a1 = cA + (size_t)(t + 1) * kstep;
            const char* a2 = last ? nA : cA + (size_t)(t + 2) * kstep; const char* b2 = last ? nB : cB + (size_t)(t + 2) * kstep;
            const char* a3 = a2 + kstep; const char* b3 = b2 + kstep;
            unsigned vA2[2], vB2[2]; unsigned hA2, hB2;
            if constexpr (VARLD) { vA2[0] = last ? nvA[0] : cvA[0]; vA2[1] = last ? nvA[1] : cvA[1]; vB2[0] = last ? nvB[0] : cvB[0]; vB2[1] = last ? nvB[1] : cvB[1]; hA2 = last ? nhA : chA; hB2 = last ? nhB : chB; }
            else { vA2[0] = cvA[0]; vA2[1] = cvA[1]; vB2[0] = cvB[0]; vB2[1] = cvB[1]; hA2 = chA; hB2 = chB; }
            PG8_LDB(B0, 0, 0); PG8_LDB(B1, 0, 1); PG8_SCHED; PG8_LDA(At, 0, 0); PG8_STAGE(PG8_SA(1, 1), a1 + chA, cvA);
            PG8_WAIT_V(8); PG8_WAIT_L(0); PG8_BAR; PG8_MMA(0, 0, At, B0); PG8_MMA(0, 1, At, B1); PG8_BAR; PG8_SCHED;
            PG8_LDA(At, 0, 1); PG8_STAGE(PG8_SB(0, 0), b2, vB2); PG8_STAGE(PG8_SB(0, 1), b2 + hB2, vB2); PG8_STAGE(PG8_SA(0, 0), a2, vA2);
            PG8_WAIT_V(8); PG8_WAIT_L(0); PG8_BAR; PG8_MMA(1, 0, At, B0); PG8_MMA(1, 1, At, B1); PG8_BAR; PG8_SCHED;
            PG8_LDB(B0, 1, 0); PG8_LDB(B1, 1, 1); PG8_SCHED; PG8_LDA(At, 1, 0); PG8_STAGE(PG8_SA(0, 1), a2 + hA2, vA2);
            PG8_WAIT_V(8); PG8_WAIT_L(0); PG8_BAR; PG8_MMA(0, 0, At, B0); PG8_MMA(0, 1, At, B1); PG8_BAR; PG8_SCHED;
            PG8_LDA(At, 1, 1); PG8_STAGE(PG8_SB(1, 0), b3, vB2); PG8_STAGE(PG8_SB(1, 1), b3 + hB2, vB2); PG8_STAGE(PG8_SA(1, 0), a3, vA2);
            PG8_WAIT_V(8); PG8_WAIT_L(0); PG8_BAR; PG8_MMA(1, 0, At, B0); PG8_MMA(1, 1, At, B1); PG8_BAR; PG8_SCHED;
        }
        if (wr == 0) PG8_BAR;
        E(acc, cur, wr, wc, fr, fq);
        if (!has_next) break;
#pragma unroll
        for (int a = 0; a < 2; ++a)
#pragma unroll
            for (int b = 0; b < 2; ++b)
#pragma unroll
                for (int m = 0; m < 4; ++m)
#pragma unroll
                    for (int n = 0; n < 2; ++n) acc[a][b][m][n] = (f32x4){0.f, 0.f, 0.f, 0.f};
        cur = nxt; cA = nA; cB = nB; ++ui;
        if constexpr (VARLD) { cvA[0] = nvA[0]; cvA[1] = nvA[1]; cvB[0] = nvB[0]; cvB[1] = nvB[1]; chA = nhA; chB = nhB; nt = nnt; }
        if (wr == 1) PG8_BAR;
    }
    PG8_WAIT_V(0);
    PG8_BAR;
#undef PG8_SA
#undef PG8_SB
#undef PG8_STAGE
#undef PG8_LDA
#undef PG8_LDB
#undef PG8_MMA
#undef PG8_WAIT_V
#undef PG8_WAIT_L
#undef PG8_BAR
#undef PG8_SCHED
#undef PG8_VOFF
}

struct StdSched {
    const char* A; const char* B; unsigned lda, ldb; int nt, pm0, nM, nN, G, c;
    __device__ __forceinline__ bool next(int i, Unit& u, Opnd& o) const {
        int pm, pn; if (!tile_order(i, G, c, nM, nN, pm, pn)) return false;
        pm += pm0; o.A = A + (size_t)pm * 256 * lda; o.B = B + (size_t)pn * 256 * ldb; o.lda = lda; o.ldb = ldb; o.nt = nt; u.pm = pm; u.pn = pn; u.op = 0; return true;
    }
};
}

namespace pg8 {
struct BatchSched {
    const char* A; const char* B; unsigned lda, ldb; int nt, pm0, nN, c;
    __device__ __forceinline__ bool next(int i, Unit& u, Opnd& o) const {
        const int x = c & 7, li = i * 32 + (c >> 3), nrt = pm0 == 0 ? 9 : 8;
        if (li >= nrt * nN) return false;
        const int pn = li / nrt, rt = li - pn * nrt;
        const int pm = pm0 == 0 ? (rt == 0 ? x : 7 + 8 * x + rt) : 8 + 8 * x + rt;
        o.A = A + (size_t)pm * 256 * lda; o.B = B + (size_t)pn * 256 * ldb; o.lda = lda; o.ldb = ldb; o.nt = nt; u.pm = pm; u.pn = pn; u.op = 0; return true;
    }
};
}
struct Params { const float* in[34]; float* out; unsigned char* ws; int stop, pad; };

#define AS4 __attribute__((address_space(4)))
__device__ __forceinline__ unsigned long long karg_u64(int byte_off) { const AS4 char* ka = (const AS4 char*)__builtin_amdgcn_kernarg_segment_ptr(); asm volatile("" : "+s"(byte_off)); return *(const AS4 unsigned long long*)(ka + byte_off); }
#define GAS __attribute__((address_space(1)))
__device__ __forceinline__ const float* arg_in(int i) { return (const float*)(const GAS float*)karg_u64(8 * i); }
__device__ __forceinline__ float* arg_out() { return (float*)(GAS float*)karg_u64(8 * 34); }
__device__ __forceinline__ unsigned char* arg_ws() { return (unsigned char*)(GAS unsigned char*)karg_u64(8 * 35); }

struct Ctx {
    LAS unsigned char* lds;
    unsigned char* ws;
    int tid, lane, wave, G, bid, wave_s;
    __device__ __forceinline__ void refresh() { int w = wave_s; asm volatile("" : "+s"(w)); int ln; asm volatile("v_mbcnt_lo_u32_b32 %0, -1, 0\n\tv_mbcnt_hi_u32_b32 %0, -1, %0" : "=v"(ln));
        lane = ln; wave = w; tid = w * 64 + ln;
        int b_ = blockIdx.x, g_ = gridDim.x; asm volatile("" : "+s"(b_), "+s"(g_)); bid = b_; G = g_; ws = arg_ws(); }
};
__device__ __forceinline__ float* xrow_ptr(const Ctx& C, int r) { return r < T_CTX ? (float*)(C.ws + WS_S) + (size_t)r * D : arg_out() + (size_t)(r - T_CTX) * D; }
__device__ __forceinline__ int mod_idx(int r) { return r < T_CTX ? 8 : (r - T_CTX) >> 11; }
__device__ __forceinline__ const float* mod_ptr(const Ctx& C, int l, int bidx, int k) { return (const float*)(C.ws + WS_MODS) + ((size_t)(l * 9 + bidx) * NADA + k) * D; }

__device__ __forceinline__ void phase_init(Ctx& C) {
    C.refresh();
    LAS float* sc = (LAS float*)C.lds;
    LAS float* part = (LAS float*)(C.lds + 40960);
    __syncthreads();
    for (int e = C.tid; e < 9 * 1024; e += NTHR) { const int bi = e >> 10, i = e & 1023; const float v = bi < 8 ? arg_in(1)[bi * D + i] : arg_in(3)[i]; sc[e] = siluf_(v); }
    __syncthreads();
    for (int it = C.bid; it < 2 * 288; it += C.G) {
        const int l = it / 288, cb = it % 288;
        const int rsub = C.lane >> 3, c4 = C.lane & 7, i0 = C.wave * 128 + rsub;
        const float* w = arg_in(4) + (size_t)l * D * (NADA * D) + (size_t)i0 * (NADA * D) + cb * 32 + 4 * c4;
        f32x4 a[9];
#pragma unroll
        for (int b = 0; b < 9; ++b) a[b] = (f32x4){0.f, 0.f, 0.f, 0.f};
#pragma unroll 1
        for (int kb = 0; kb < 2; ++kb) {
            f32x4 wv[8];
#pragma unroll
            for (int k = 0; k < 8; ++k) wv[k] = *(const f32x4*)(w + (size_t)(8 * (kb * 8 + k)) * (NADA * D));
#pragma unroll
            for (int k = 0; k < 8; ++k)
#pragma unroll
                for (int b = 0; b < 9; ++b) a[b] = a[b] + wv[k] * sc[b * 1024 + i0 + 8 * (kb * 8 + k)];
        }
#pragma unroll
        for (int b = 0; b < 9; ++b) *(LAS f32x4*)(part + ((C.wave * 8 + rsub) * 9 + b) * 32 + 4 * c4) = a[b];
        __syncthreads();
        for (int e = C.tid; e < 9 * 32; e += NTHR) { const int b = e >> 5, c = e & 31; float sum = arg_in(5)[(size_t)l * NADA * D + cb * 32 + c];
#pragma unroll 8
            for (int w8 = 0; w8 < 64; ++w8) sum += part[(w8 * 9 + b) * 32 + c];
            ((float*)(C.ws + WS_MODS))[((size_t)l * 9 + b) * NADA * D + cb * 32 + c] = sum; }
        __syncthreads();
    }
    __syncthreads();
}

__device__ __forceinline__ void transpose_item(const float* src, int ldsrc, int col0, int K, bf16_t* dst, int row0, int kb, LAS float* scr, int lane) {
    const int k0 = 64 * kb;
    if (src) {
        const float* sp = src + (size_t)(k0 + (lane >> 3)) * ldsrc + col0 + 4 * (lane & 7);
        f32x4 t[8];
#pragma unroll
        for (int i = 0; i < 8; ++i) t[i] = *(const f32x4*)(sp + (size_t)(8 * i) * ldsrc);
#pragma unroll
        for (int i = 0; i < 8; ++i) { LAS float* d = scr + (8 * i + (lane >> 3)) * 33 + 4 * (lane & 7); d[0] = t[i].x; d[1] = t[i].y; d[2] = t[i].z; d[3] = t[i].w; }
    } else {
#pragma unroll 8
        for (int i = 0; i < 32; ++i) { const int kk = 2 * i + (lane >> 5); scr[kk * 33 + (lane & 31)] = 0.f; }
    }
    LDS_WAIT(); asm volatile("" ::: "memory");
    const int c = lane & 7;
#pragma unroll
    for (int j = 0; j < 4; ++j) { const int n = (lane >> 3) + 8 * j; const LAS float* s = scr + (8 * c) * 33 + n;
        u32x4 o; o.x = pk2(s[0 * 33], s[1 * 33]); o.y = pk2(s[2 * 33], s[3 * 33]); o.z = pk2(s[4 * 33], s[5 * 33]); o.w = pk2(s[6 * 33], s[7 * 33]);
        *(u32x4*)(dst + (size_t)(row0 + n) * K + k0 + 8 * c) = o; }
    LDS_WAIT(); asm volatile("" ::: "memory");
}
__device__ __forceinline__ void phase_convert(Ctx& C, int l) {
    C.refresh();
    LAS float* scr = (LAS float*)(C.lds + C.wave * 16384);
    unsigned char* W = C.ws + WS_W;
    const int gw = C.bid * NWAVES + C.wave, NGW = C.G * NWAVES;
    constexpr int I_FI = 16 * 176, I_FO = 44 * 32, I_MA = 16 * 88, I_MB = 16 * 96, I_G = 16 * 96, I_R = 16 * 32, I_A = 8 * 32, I_O = 16 * 32;
    constexpr int I_GU = 2 * 16, I_WU = 4 * 16;
    constexpr int NITEMS = 2 * I_FI + 2 * I_FO + I_MA + I_MB + I_G + I_R + 2 * I_A + I_O + I_GU + I_WU;
    for (int it = gw; it < NITEMS; it += NGW) {
        int r = it;
        if (r < 2 * I_FI) { const int which = r / I_FI; r %= I_FI; const int nb = r / 16, kb = r % 16; const int np = nb * 32, t = np >> 8, q = np & 255;
            const int col = q < 128 ? 128 * t + q : DFF + 128 * t + (q - 128);
            transpose_item(arg_in(which ? 9 : 7) + (size_t)l * D * 2 * DFF, 2 * DFF, col, D, (bf16_t*)(W + (which ? W_FFN2_IN : W_FFN1_IN)), np, kb, scr, C.lane); continue; }
        r -= 2 * I_FI;
        if (r < 2 * I_FO) { const int which = r / I_FO; r %= I_FO; const int nb = r / 44, kb = r % 44;
            transpose_item(arg_in(which ? 10 : 8) + (size_t)l * DFF * D, D, nb * 32, DFF, (bf16_t*)(W + (which ? W_FFN2_OUT : W_FFN1_OUT)), nb * 32, kb, scr, C.lane); continue; }
        r -= 2 * I_FO;
        if (r < I_MA) { const int nb = r / 16, kb = r % 16, np = nb * 32; const float* src; int ld, col;
            if (np < 2688) { src = arg_in(11) + (size_t)l * D * NIN; ld = NIN; col = 3072 + np; }
            else if (np < 2720 && l > 0) { src = arg_in(26) + (size_t)(l - 1) * D * 32; ld = 32; col = 0; }
            else { src = nullptr; ld = 0; col = 0; }
            transpose_item(src, ld, col, D, (bf16_t*)(W + W_MIXA), np, kb, scr, C.lane); continue; }
        r -= I_MA;
        if (r < I_MB) { const int nb = r / 16, kb = r % 16; transpose_item(arg_in(11) + (size_t)l * D * NIN, NIN, nb * 32, D, (bf16_t*)(W + W_MIXB), nb * 32, kb, scr, C.lane); continue; }
        r -= I_MB;
        if (r < I_G) { const int nb = r / 16, kb = r % 16; transpose_item(arg_in(11) + (size_t)l * D * NIN, NIN, 5760 + nb * 32, D, (bf16_t*)(W + W_GATE), nb * 32, kb, scr, C.lane); continue; }
        r -= I_G;
        if (r < I_R) { const int nb = r / 16, kb = r % 16; transpose_item(arg_in(30) + (size_t)l * 1024 * D, D, nb * 32, 1024, (bf16_t*)(W + W_RET), nb * 32, kb, scr, C.lane); continue; }
        r -= I_R;
        if (r < 2 * I_A) { const int which = r / I_A; r %= I_A; const int nb = r / 8, kb = r % 8;
            transpose_item(arg_in(which ? 32 : 31) + (size_t)l * 512 * D, D, nb * 32, 512, (bf16_t*)(W + (which ? W_RWKV : W_ATT)), nb * 32, kb, scr, C.lane); continue; }
        r -= 2 * I_A;
        if (r < I_O) { const int nb = r / 16, kb = r % 16; transpose_item(arg_in(33) + (size_t)l * D * D, D, nb * 32, D, (bf16_t*)(W + W_OUT), nb * 32, kb, scr, C.lane); continue; }
        r -= I_O;
        if (r < I_GU) { const int nb = r / 2, kb = r % 2; transpose_item(arg_in(21) + (size_t)l * 128 * 512, 512, nb * 32, 128, (bf16_t*)(W + W_GUP), nb * 32, kb, scr, C.lane); continue; }
        r -= I_GU;
        { const int md = r / 16, nb = r % 16;
          transpose_item(arg_in(md < 2 ? 18 : 20) + ((size_t)(l * 2 + (md & 1)) * 64) * 512, 512, nb * 32, 64, (bf16_t*)(W + W_WUP) + (size_t)md * 512 * 64, nb * 32, 0, scr, C.lane); }
    }
}

__device__ __forceinline__ void norm_rows(Ctx& C, int l, int which, int r_first, int r_step, int r_end, int fold_slabs, int src_mode) {
    const f32x4* nw = (const f32x4*)(arg_in(6) + ((size_t)l * 3 + which) * D) + C.lane;
    f32x4 nwv[4];
#pragma unroll
    for (int j = 0; j < 4; ++j) nwv[j] = nw[64 * j];
    bf16_t* H = (bf16_t*)(C.ws + WS_H);
    f32x4 v[4], sha[4], scb[4];
    auto load_row = [&](int r, f32x4 (&vv)[4], f32x4 (&sa)[4], f32x4 (&sb)[4]) {
        const float* xsrc = (src_mode && r < T_CTX && (src_mode == 2 || C.G == 256)) ? arg_in(2) + (size_t)r * D : (src_mode == 2 ? arg_in(0) + (size_t)(r - T_CTX) * D : (const float*)xrow_ptr(C, r));
        const f32x4* xr = (const f32x4*)xsrc + C.lane;
        const int bi = mod_idx(r);
        const f32x4* sh = (const f32x4*)mod_ptr(C, l, bi, 3 * which) + C.lane;
        const f32x4* scl = (const f32x4*)mod_ptr(C, l, bi, 3 * which + 1) + C.lane;
#pragma unroll
        for (int j = 0; j < 4; ++j) vv[j] = xr[64 * j];
#pragma unroll
        for (int j = 0; j < 4; ++j) { sa[j] = sh[64 * j]; sb[j] = scl[64 * j]; }
    };
    auto do_row = [&](int r, f32x4 (&v)[4], const f32x4 (&sha)[4], const f32x4 (&scb)[4]) {
        float s = 0.f;
        if (fold_slabs && r < T_CTX && C.G == 256) {
            const float* sl = (const float*)(C.ws + WS_AO + 4 * MiB) + (size_t)((r >> 8) * 16) * 65536 + (size_t)(r & 255) * 256 + 4 * C.lane;
            f32x4 t[4][4];
#pragma unroll
            for (int j = 0; j < 4; ++j)
#pragma unroll
                for (int si = 0; si < 4; ++si) t[j][si] = *(const f32x4*)(sl + (size_t)(j * fold_slabs + (si < fold_slabs ? si : fold_slabs - 1)) * 65536);
#pragma unroll
            for (int j = 0; j < 4; ++j) {
#pragma unroll
                for (int si = 0; si < 4; ++si) { const float keep = si < fold_slabs ? 1.0f : 0.0f; v[j] = v[j] + t[j][si] * keep; }
                ((f32x4*)xrow_ptr(C, r))[64 * j + C.lane] = v[j]; }
        }
#pragma unroll
        for (int j = 0; j < 4; ++j) s += (v[j].x * v[j].x + v[j].y * v[j].y) + (v[j].z * v[j].z + v[j].w * v[j].w);
        const float rstd = 1.0f / sqrtf(wave_sum(s) * (1.0f / D) + 1e-6f);
        unsigned long long* o8 = (unsigned long long*)(H + (size_t)r * D) + C.lane;
#pragma unroll
        for (int j = 0; j < 4; ++j) { const f32x4 a = sha[j], b = scb[j]; const f32x4 y = (v[j] * rstd * nwv[j]) * (b + 1.0f) + a;
            o8[64 * j] = (unsigned long long)pk2(y.x, y.y) | ((unsigned long long)pk2(y.z, y.w) << 32); }
    };
    f32x4 vb[4], shb[4], scbb[4];
    int r = r_first;
    if (r < r_end) load_row(r, v, sha, scb);
    while (r < r_end) {
        int rn = r + r_step;
        load_row(rn < r_end ? rn : r, vb, shb, scbb);
        do_row(r, v, sha, scb);
        r = rn; if (r >= r_end) break;
        rn = r + r_step;
        load_row(rn < r_end ? rn : r, v, sha, scb);
        do_row(r, vb, shb, scbb);
        r = rn;
    }
}
__device__ __forceinline__ void phase_norm(Ctx& C, int l, int which, int row_lo, int fold_slabs, int src_mode) {
    C.refresh();
    norm_rows(C, l, which, row_lo + C.bid * NWAVES + C.wave, C.G * NWAVES, T_ALL, fold_slabs, src_mode);
}
struct FusedNorm { int l, which, fold, src; };
__device__ __forceinline__ void fused_norm(Ctx& C, const FusedNorm& fn, int pm_lat, int pn_lat, bool has_ctx, int pmc, int j, int nj) {
    if (fn.l < 0) return;
    unsigned* tmo = (unsigned*)(C.ws + WS_CTL) + CW_BAR + XB_TMO;
    unsigned* cnt0 = (unsigned*)(C.ws + WS_CTL) + 65536 + (size_t)((fn.l * 3 + fn.which) * 72) * 64;
    group_sync(cnt0 + pm_lat * 64, 4u, tmo);
    C.refresh();
    { const int r0 = pm_lat * 256 + pn_lat * 64; norm_rows(C, fn.l, fn.which, r0 + C.wave, NWAVES, r0 + 64, fn.fold, fn.src); }
    if (has_ctx) {
        group_sync(cnt0 + pmc * 64, (unsigned)nj, tmo);
        C.refresh();
        const int per = (256 + nj - 1) / nj, r0 = pmc * 256 + j * per, r1 = pmc * 256 + ((j + 1) * per < 256 ? (j + 1) * per : 256);
        norm_rows(C, fn.l, fn.which, r0 + C.wave, NWAVES, r1, fn.fold, fn.src);
    }
}

struct EpiSwiglu {
    static constexpr bool PERM = true;
    bf16_t* O;
    __device__ __forceinline__ void operator()(const f32x4 (&acc)[2][2][4][2], const pg8::Unit& u, int wr, int wc, int fr, int fq) const {
        const int row0 = u.pm * 256 + wr * 64 + fr, col0 = u.pn * 128 + wc * 32 + 8 * fq;
#pragma unroll
        for (int ai = 0; ai < 2; ++ai)
#pragma unroll
            for (int m = 0; m < 4; ++m) { bf16_t* rowp = O + (size_t)(row0 + ai * 128 + m * 16) * FS + col0;
                const f32x4 g0 = acc[ai][0][m][0], g1 = acc[ai][0][m][1], u0 = acc[ai][1][m][0], u1 = acc[ai][1][m][1];
                float o[8];
#pragma unroll
                for (int j = 0; j < 4; ++j) { o[j] = siluf_(g0[j]) * u0[j]; o[4 + j] = siluf_(g1[j]) * u1[j]; }
                u32x4 w; w.x = pg8::cvt_pk_bf16(o[0], o[1]); w.y = pg8::cvt_pk_bf16(o[2], o[3]); w.z = pg8::cvt_pk_bf16(o[4], o[5]); w.w = pg8::cvt_pk_bf16(o[6], o[7]);
                *(u32x4*)rowp = w; }
    }
};
template <bool FIRST>
struct EpiResidT {
    static constexpr bool PERM = false;
    float* S; float* OUT; const float* mods_l; int k; float coef; float* slab;
    __device__ __forceinline__ void operator()(const f32x4 (&acc)[2][2][4][2], const pg8::Unit& u, int wr, int wc, int fr, int fq) const {
        const int rt = u.pm * 256;
        float* base = rt < T_CTX ? S + (size_t)rt * D : OUT + (size_t)(rt - T_CTX) * D;
        const float* rbase = base;
        if (FIRST) rbase = rt < T_CTX ? arg_in(2) + (size_t)rt * D : arg_in(0) + (size_t)(rt - T_CTX) * D;
        const int bi = rt < T_CTX ? 8 : (rt - T_CTX) >> 11;
        const int col0 = u.pn * 256 + wc * 32 + 4 * fq;
        const float* mg = mods_l + ((size_t)bi * NADA + k) * D + col0;
        f32x4 gv[2][2];
#pragma unroll
        for (int bj = 0; bj < 2; ++bj)
#pragma unroll
            for (int n = 0; n < 2; ++n) gv[bj][n] = *(const f32x4*)(mg + bj * 128 + n * 16);
        asm volatile("" : "+v"(gv[0][0]), "+v"(gv[0][1]), "+v"(gv[1][0]), "+v"(gv[1][1]));
#pragma unroll
        for (int bj = 0; bj < 2; ++bj)
#pragma unroll
            for (int n = 0; n < 2; ++n) gv[bj][n] = gv[bj][n] * coef;
        if (u.op == 0) {
#pragma unroll
            for (int ai = 0; ai < 2; ++ai)
#pragma unroll
                for (int mp = 0; mp < 2; ++mp) {
                    f32x4 r[2][2][2];
#pragma unroll
                    for (int mm = 0; mm < 2; ++mm) { const float* rrow = rbase + (size_t)(wr * 64 + fr + ai * 128 + (mp * 2 + mm) * 16) * D + col0;
#pragma unroll
                        for (int bj = 0; bj < 2; ++bj)
#pragma unroll
                            for (int n = 0; n < 2; ++n) r[mm][bj][n] = *(const f32x4*)(rrow + bj * 128 + n * 16); }
#pragma unroll
                    for (int mm = 0; mm < 2; ++mm) { float* rowp = base + (size_t)(wr * 64 + fr + ai * 128 + (mp * 2 + mm) * 16) * D + col0;
#pragma unroll
                        for (int bj = 0; bj < 2; ++bj)
#pragma unroll
                            for (int n = 0; n < 2; ++n) *(f32x4*)(rowp + bj * 128 + n * 16) = r[mm][bj][n] + gv[bj][n] * acc[ai][bj][mp * 2 + mm][n]; }
                }
        } else {
            float* sl = slab + (size_t)(u.op - 1) * 65536 + (size_t)(wr * 64 + fr) * 256 + wc * 32 + 4 * fq;
#pragma unroll
            for (int ai = 0; ai < 2; ++ai)
#pragma unroll
                for (int m = 0; m < 4; ++m)
#pragma unroll
                    for (int bj = 0; bj < 2; ++bj)
#pragma unroll
                        for (int n = 0; n < 2; ++n) *(f32x4*)(sl + (size_t)(ai * 128 + m * 16) * 256 + bj * 128 + n * 16) = gv[bj][n] * acc[ai][bj][m][n];
        }
    }
};
typedef EpiResidT<false> EpiResid;

template <int NT>
struct SplitSched {
    static constexpr int SPL = 4;
    const char* A; const char* B; unsigned lda, ldb; int c;
    __device__ __forceinline__ bool next(int i, pg8::Unit& u, pg8::Opnd& o) const {
        o.lda = lda; o.ldb = ldb;
        if (i == 0) { int pm, pn; pg8::tile_order(0, 256, c, 64, 4, pm, pn); pm += 8; u.pm = pm; u.pn = pn; u.op = 0; o.nt = NT; o.A = A + (size_t)pm * 256 * lda; o.B = B + (size_t)pn * 256 * ldb; return true; }
        if (i == 1 && c < 32 * SPL) { const int x = c & 7, jj = c >> 3, pm = x, pn = jj >> 2, si = jj & 3, ct = x * 4 + pn;
            constexpr int n0 = ((NT / SPL + 1) / 2) * 2, n1 = (NT - 2 * n0) / 2;
            const int k0 = si < 2 ? si * n0 : 2 * n0 + (si - 2) * n1, nt = si < 2 ? n0 : n1;
            u.pm = pm; u.pn = pn; u.op = 1 + ct * SPL + si; o.nt = nt; o.A = A + (size_t)pm * 256 * lda + (size_t)k0 * 128; o.B = B + (size_t)pn * 256 * ldb + (size_t)k0 * 128; return true; }
        return false;
    }
};
__device__ __forceinline__ void phase_ffn_in(Ctx& C, size_t w_off, int pm0, int nM) {
    C.refresh();
    EpiSwiglu E{(bf16_t*)(C.ws + WS_F)};
    if (C.G == 256 && ((pm0 == 0 && nM == 72) || (pm0 == 8 && nM == 64))) {
        pg8::BatchSched S{(const char*)(C.ws + WS_H), (const char*)(C.ws + WS_W + w_off), D * 2, D * 2, D / 64, pm0, 22, C.bid};
        pg8::gemm_phase<EpiSwiglu, pg8::BatchSched>(C.lds, C.tid, S, E);
    } else {
        pg8::StdSched S{(const char*)(C.ws + WS_H), (const char*)(C.ws + WS_W + w_off), D * 2, D * 2, D / 64, pm0, nM, 22, C.G, C.bid};
        pg8::gemm_phase<EpiSwiglu, pg8::StdSched>(C.lds, C.tid, S, E);
    }
}
template <bool FIRST>
__device__ __forceinline__ void phase_ffn_out(Ctx& C, int l, size_t w_off, int k, int pm0, int nM, const FusedNorm& fn) {
    C.refresh();
    EpiResidT<FIRST> E{(float*)(C.ws + WS_S), arg_out(), (const float*)(C.ws + WS_MODS) + (size_t)l * 9 * NADA * D, k, 0.5f, (float*)(C.ws + WS_AO + 4 * MiB)};
    if (nM == 72 && C.G == 256) {
        SplitSched<DFF / 64> S{(const char*)(C.ws + WS_F), (const char*)(C.ws + WS_W + w_off), FS * 2, DFF * 2, C.bid};
        pg8::gemm_phase<EpiResidT<FIRST>, SplitSched<DFF / 64>, true>(C.lds, C.tid, S, E);
        int pm, pn; pg8::tile_order(0, 256, C.bid, 64, 4, pm, pn);
        fused_norm(C, fn, pm + 8, pn, C.bid < 128, C.bid & 7, C.bid >> 3, 16);
    } else {
        pg8::StdSched S{(const char*)(C.ws + WS_F), (const char*)(C.ws + WS_W + w_off), FS * 2, DFF * 2, DFF / 64, pm0, nM, 4, C.G, C.bid};
        pg8::gemm_phase<EpiResidT<FIRST>, pg8::StdSched>(C.lds, C.tid, S, E);
    }
}

struct EpiBf16 {
    static constexpr bool PERM = true;
    bf16_t* O; int ldc;
    __device__ __forceinline__ void operator()(const f32x4 (&acc)[2][2][4][2], const pg8::Unit& u, int wr, int wc, int fr, int fq) const {
        const int row0 = u.pm * 256 + wr * 64 + fr, col0 = u.pn * 256 + wc * 32 + 8 * fq;
#pragma unroll
        for (int ai = 0; ai < 2; ++ai)
#pragma unroll
            for (int m = 0; m < 4; ++m) { bf16_t* rowp = O + (size_t)(row0 + ai * 128 + m * 16) * ldc + col0;
#pragma unroll
                for (int bj = 0; bj < 2; ++bj) { const f32x4 v0 = acc[ai][bj][m][0], v1 = acc[ai][bj][m][1];
                    u32x4 w; w.x = pg8::cvt_pk_bf16(v0[0], v0[1]); w.y = pg8::cvt_pk_bf16(v0[2], v0[3]); w.z = pg8::cvt_pk_bf16(v1[0], v1[1]); w.w = pg8::cvt_pk_bf16(v1[2], v1[3]);
                    *(u32x4*)(rowp + bj * 128) = w; } }
    }
};
struct MixASched {
    const char* A; const char* B; int c;
    __device__ __forceinline__ bool next(int i, pg8::Unit& u, pg8::Opnd& o) const {
        const int x = c & 7, li = i * 32 + (c >> 3);
        if (li >= 9 * 12) return false;
        const int pn = li / 9, rt = li - pn * 9, pm = rt == 0 ? x : 7 + 8 * x + rt;
        const int wrow = pn < 11 ? pn * 256 : 2816 + 2816;
        o.A = A + (size_t)pm * 256 * 2048; o.B = B + (size_t)wrow * 2048; o.lda = 2048; o.ldb = 2048; o.nt = 16;
        u.pm = pm; u.pn = pn; u.op = 0; return true;
    }
};
struct MixGxSched {
    const char* A; const char* B; int c;
    __device__ __forceinline__ bool next(int i, pg8::Unit& u, pg8::Opnd& o) const {
        const int x = c & 7, rt = (c >> 3) - 12;
        if (i != 0 || rt < 0 || rt >= 9) return false;
        const int pm = rt == 0 ? x : 7 + 8 * x + rt;
        o.A = A + (size_t)pm * 256 * 2048; o.B = B + (size_t)(2816 + 2560) * 2048; o.lda = 2048; o.ldb = 2048; o.nt = 16;
        u.pm = pm; u.pn = 0; u.op = 0; return true;
    }
};
__device__ __forceinline__ void phase_mix(Ctx& C, size_t w_off, int ncols) {
    C.refresh();
    EpiBf16 E{(bf16_t*)(C.ws + WS_F), FS};
    if (C.G == 256 && w_off == W_MIXA) {
        MixASched S{(const char*)(C.ws + WS_H), (const char*)(C.ws + WS_W + W_MIXA), C.bid};
        pg8::gemm_phase<EpiBf16, MixASched>(C.lds, C.tid, S, E);
        C.refresh();
        EpiBf16 E2{(bf16_t*)(C.ws + WS_GX), 256};
        MixGxSched S2{(const char*)(C.ws + WS_H), (const char*)(C.ws + WS_W + W_MIXA), C.bid};
        pg8::gemm_phase<EpiBf16, MixGxSched>(C.lds, C.tid, S2, E2);
    } else if (C.G == 256) {
        pg8::BatchSched S{(const char*)(C.ws + WS_H), (const char*)(C.ws + WS_W + w_off), D * 2, D * 2, D / 64, 0, 10, C.bid};
        pg8::gemm_phase<EpiBf16, pg8::BatchSched>(C.lds, C.tid, S, E);
    } else {
        pg8::StdSched S{(const char*)(C.ws + WS_H), (const char*)(C.ws + WS_W + w_off), D * 2, D * 2, D / 64, 0, 72, ncols / 256, C.G, C.bid};
        pg8::gemm_phase<EpiBf16, pg8::StdSched>(C.lds, C.tid, S, E);
    }
}

__device__ __forceinline__ int urow(int seg, int b, int pos) { return seg ? T_CTX + b * SEQ + pos : b * CTX + pos; }

__device__ __forceinline__ void att_prep(Ctx& C, int l) {
    C.refresh();
    bf16_t* CA = (bf16_t*)(C.ws + WS_F);
    const int gw = C.bid * NWAVES + C.wave, NGW = C.G * NWAVES;
    const int i = C.lane;
    const float qn = arg_in(13)[l * 64 + i], kn = arg_in(14)[l * 64 + i];
    const int p = i & 31;
    const float inv = __expf(-(float)(p & 15) * (9.210340371976184f / 16.0f));
    const bool bal = C.G == 256; const int wv = (C.bid >> 3) * NWAVES + C.wave, bx = C.bid & 7;
    for (int k = bal ? 0 : gw; k < (bal ? 9 : T_ALL); k += bal ? 1 : NGW) {
        const int r = bal ? (k == 0 ? bx * CTX + wv : T_CTX + bx * SEQ + (k - 1) * 256 + wv) : k;
        bf16_t* rowp = CA + (size_t)r * FS + i;
        bf16_t xr[10];
#pragma unroll
        for (int hh = 0; hh < 10; ++hh) xr[hh] = rowp[hh * 64];
        float sn = 0.f, cs = 1.f;
        const bool lat = r >= T_CTX;
        if (lat) { const int pos = (r - T_CTX) & (SEQ - 1); const float ang = (float)(p < 16 ? (pos >> 6) : (pos & 63)) * inv; __sincosf(ang, &sn, &cs); }
#pragma unroll
        for (int hh = 0; hh < 10; ++hh) {
            float v = bf2f(xr[hh]);
            const float ss = wave_sum(v * v);
            v = v * (1.0f / sqrtf(ss * (1.0f / 64.0f) + 1e-6f)) * (hh < 8 ? qn : kn);
            if (lat) {
                const float o = __builtin_bit_cast(float, __builtin_amdgcn_ds_bpermute((i ^ 32) << 2, __builtin_bit_cast(int, v)));
                v = i < 32 ? v * cs - o * sn : o * sn + v * cs;
            }
            if (hh < 8) v *= 0.125f;
            rowp[hh * 64] = (bf16_t)f2bf(v);
        }
    }
}

namespace rw {
constexpr int OFF_W = 0, OFF_KK = 16384, OFF_BB = 32768, OFF_KD = 49152, OFF_RR = 65536, OFF_VV = 81920, OFF_YB = 90112,
              OFF_AWD = 98304, OFF_AAD = 107520, OFF_BW = 116736, OFF_BA = 125952, OFF_VL = 135168, OFF_VUP = 143360, LDS_END = 147456;
constexpr int RC = 768;
}
namespace rc {
constexpr int LD = 72;
constexpr int OFF_LW = 0, OFF_LA = 16384, OFF_LK = 32768, OFF_LR = 49152, OFF_AWD = 65536, OFF_AAD = 74752, OFF_LVV = 83968, OFF_LVL = 92160, OFF_PART = 100352;
constexpr int OFF_ABT = 0, OFF_AKT = 16384, OFF_MKT = 25600, OFF_MBT = 34816, OFF_TTT = 44032, OFF_XX = 53248, OFF_NZ = 57856, OFF_WU = 62464, OFF_WYT = 71680, OFF_PTT = 80896;
constexpr int OFF_BT = 102400, OFF_KT = 111616, OFF_KP = 120832, OFF_RT = 130048, OFF_VT = 139264, VT_LD = 40, OFF_LGC = 144384;
constexpr int OFF_TF = OFF_WU, OFF_WS = OFF_WU + 17408;
constexpr int OFF_S0 = 144640, OFF_LYB = OFF_KP, OFF_VUP = 153856, OFF_CWA = 157952, OFF_KC = 161792, LDS_END = 162560;
static_assert(LDS_END <= LDS_MISC, "chunked rwkv LDS map");
typedef unsigned short u16x4 __attribute__((ext_vector_type(4)));
template <int LDE>
__device__ __forceinline__ bf16x8 trfrag(LAS const bf16_t* base, int k0, int c0, int lane) {
    const int g = lane >> 4, i = lane & 15, q = i >> 2, p = i & 3;
    const unsigned addr = (unsigned)(unsigned long long)(base + (k0 + 8 * g + q) * LDE + c0 + 4 * p);
    u16x4 r1, r2;
    asm volatile("ds_read_b64_tr_b16 %0, %2\n\tds_read_b64_tr_b16 %1, %2 offset:%3\n\ts_waitcnt lgkmcnt(0)" : "=&v"(r1), "=&v"(r2) : "v"(addr), "i"(LDE * 8) : "memory");
    bf16x8 f; f[0] = (short)r1[0]; f[1] = (short)r1[1]; f[2] = (short)r1[2]; f[3] = (short)r1[3]; f[4] = (short)r2[0]; f[5] = (short)r2[1]; f[6] = (short)r2[2]; f[7] = (short)r2[3];
    return f;
}
__device__ __forceinline__ bf16x8 mkfrag(u16x4 r1, u16x4 r2) { bf16x8 f; f[0] = (short)r1[0]; f[1] = (short)r1[1]; f[2] = (short)r1[2]; f[3] = (short)r1[3]; f[4] = (short)r2[0]; f[5] = (short)r2[1]; f[6] = (short)r2[2]; f[7] = (short)r2[3]; return f; }
template <int LDE>
__device__ __forceinline__ void trfrag4(LAS const bf16_t* base, int k0, int lane, bf16x8 (&f)[4]) {
    const int g = lane >> 4, i = lane & 15, q = i >> 2, p = i & 3;
    const unsigned addr = (unsigned)(unsigned long long)(base + (k0 + 8 * g + q) * LDE + 4 * p);
    u16x4 a0, a1, b0, b1, c0, c1, d0, d1;
    asm volatile("ds_read_b64_tr_b16 %0, %8\n\tds_read_b64_tr_b16 %1, %8 offset:%9\n\t"
                 "ds_read_b64_tr_b16 %2, %8 offset:32\n\tds_read_b64_tr_b16 %3, %8 offset:%10\n\t"
                 "ds_read_b64_tr_b16 %4, %8 offset:64\n\tds_read_b64_tr_b16 %5, %8 offset:%11\n\t"
                 "ds_read_b64_tr_b16 %6, %8 offset:96\n\tds_read_b64_tr_b16 %7, %8 offset:%12\n\t"
                 "s_waitcnt lgkmcnt(0)"
                 : "=&v"(a0), "=&v"(a1), "=&v"(b0), "=&v"(b1), "=&v"(c0), "=&v"(c1), "=&v"(d0), "=&v"(d1)
                 : "v"(addr), "i"(LDE * 8), "i"(LDE * 8 + 32), "i"(LDE * 8 + 64), "i"(LDE * 8 + 96) : "memory");
    f[0] = mkfrag(a0, a1); f[1] = mkfrag(b0, b1); f[2] = mkfrag(c0, c1); f[3] = mkfrag(d0, d1);
}
template <int LDE>
__device__ __forceinline__ void trfrag2k(LAS const bf16_t* base, int c0, int lane, bf16x8 (&f)[2]) {
    const int g = lane >> 4, i = lane & 15, q = i >> 2, p = i & 3;
    const unsigned addr = (unsigned)(unsigned long long)(base + (8 * g + q) * LDE + c0 + 4 * p);
    u16x4 a0, a1, b0, b1;
    asm volatile("ds_read_b64_tr_b16 %0, %4\n\tds_read_b64_tr_b16 %1, %4 offset:%5\n\t"
                 "ds_read_b64_tr_b16 %2, %4 offset:%6\n\tds_read_b64_tr_b16 %3, %4 offset:%7\n\t"
                 "s_waitcnt lgkmcnt(0)"
                 : "=&v"(a0), "=&v"(a1), "=&v"(b0), "=&v"(b1)
                 : "v"(addr), "i"(LDE * 8), "i"(LDE * 64), "i"(LDE * 64 + LDE * 8) : "memory");
    f[0] = mkfrag(a0, a1); f[1] = mkfrag(b0, b1);
}
__device__ __forceinline__ bf16x8 ldfrag(LAS const bf16_t* base, int row, int k0, int lane) { return *(const LAS bf16x8*)(base + row * LD + k0 + (lane >> 4) * 8); }
}
namespace r1 {
using rc::LD;
constexpr int OFF_LW = 0, OFF_LA = 16384, OFF_LK = 32768, OFF_LR = 49152, OFF_AWD = 65536, OFF_AAD = 74752, OFF_PART = OFF_AWD, OFF_LVV = 83968, OFF_VLB = 100352, VL_LD = 40, OFF_XEND = 105472;
constexpr int OFF_ABT = 0, OFF_AKT = 16384, OFF_MKT = 25600, OFF_MBT = 34816, OFF_TTT = 44032, OFF_XX = 53248, OFF_NZ = 62464, OFF_WU = 71680, OFF_TF = OFF_WU, OFF_WS = OFF_WU + 17408;
constexpr int OFF_BT = 105472, OFF_KT = 114688, OFF_KP = 123904, OFF_RT = 133120, OFF_VT = 142336, OFF_LGC = 151552;
constexpr int OFF_CWA = 151808, OFF_KC = 155648, OFF_VUPT = 156416, OFF_V0 = 161536, LDS_END = 161792;
static_assert(LDS_END <= LDS_MISC && OFF_WS + 4352 <= OFF_XEND, "r1 LDS map");
constexpr size_t WS_WYG = WS_AO, WS_PTG = WS_AO + 18 * MiB, WS_QG = WS_GSCR;
}
__device__ __forceinline__ void phase_rwkv_r1(Ctx& C, int l, int dir) {
    using namespace r1; using rc::trfrag; using rc::ldfrag;
    C.refresh();
    const int tid = C.tid, lane = C.lane, wave = C.wave, fr = lane & 15, fq = lane >> 4;
    const int h = (C.bid >> 3) & 7, jw = (C.bid & 7) * 4 + (C.bid >> 6);
    const bf16_t* CA = (const bf16_t*)(C.ws + WS_F);
    bf16_t* Y = (bf16_t*)(C.ws + WS_F2);
    bf16_t* VF = (bf16_t*)(C.ws + WS_VFIRST);
    bf16_t* VM = (bf16_t*)(C.ws + WS_VMIX);
    float* BON = (float*)(C.ws + WS_BONUS);
    const bf16_t* WUPg = (const bf16_t*)(C.ws + WS_W + W_WUP);
    bf16_t* WYG = (bf16_t*)(C.ws + WS_WYG); bf16_t* PTG = (bf16_t*)(C.ws + WS_PTG); bf16_t* QG = (bf16_t*)(C.ws + WS_QG);
    LAS unsigned char* lds = C.lds;
    LAS float* LW = (LAS float*)(lds + OFF_LW); LAS float* LA = (LAS float*)(lds + OFF_LA); LAS float* LK = (LAS float*)(lds + OFF_LK); LAS float* LR = (LAS float*)(lds + OFF_LR);
    LAS float* LVV = (LAS float*)(lds + OFF_LVV); LAS float* PART = (LAS float*)(lds + OFF_PART); LAS float* LGC = (LAS float*)(lds + OFF_LGC);
    LAS bf16_t* AWD = (LAS bf16_t*)(lds + OFF_AWD); LAS bf16_t* AAD = (LAS bf16_t*)(lds + OFF_AAD); LAS bf16_t* VLB = (LAS bf16_t*)(lds + OFF_VLB);
    LAS bf16_t* BT = (LAS bf16_t*)(lds + OFF_BT); LAS bf16_t* KT = (LAS bf16_t*)(lds + OFF_KT); LAS bf16_t* KP = (LAS bf16_t*)(lds + OFF_KP); LAS bf16_t* RT = (LAS bf16_t*)(lds + OFF_RT);
    LAS bf16_t* VT = (LAS bf16_t*)(lds + OFF_VT);
    LAS float* ABT = (LAS float*)(lds + OFF_ABT);
    LAS bf16_t* AKT = (LAS bf16_t*)(lds + OFF_AKT); LAS bf16_t* MKT = (LAS bf16_t*)(lds + OFF_MKT); LAS bf16_t* MBT = (LAS bf16_t*)(lds + OFF_MBT); LAS bf16_t* TTT = (LAS bf16_t*)(lds + OFF_TTT);
    LAS bf16_t* XX = (LAS bf16_t*)(lds + OFF_XX); LAS bf16_t* NZ = (LAS bf16_t*)(lds + OFF_NZ); LAS bf16_t* WU = (LAS bf16_t*)(lds + OFF_WU);
    LAS float* CWA = (LAS float*)(lds + OFF_CWA); LAS float* KC = (LAS float*)(lds + OFF_KC); LAS bf16_t* VUPT = (LAS bf16_t*)(lds + OFF_VUPT); LAS float* LV0 = (LAS float*)(lds + OFF_V0);
    const int a_kind0 = wave == 2 ? 4 : wave == 3 ? 2 : wave == 4 ? 3 : wave;
    const bool a_act0 = wave < 5 || (wave == 5 && lane < 32);
    const int ga0 = wave < 5 ? lane >> 3 : (lane >> 2) & 7, c80 = wave < 5 ? lane & 7 : lane & 3;
    int a_col;
    if (a_kind0 == 0) a_col = rw::RC + h * 64 + 8 * c80; else if (a_kind0 == 1) a_col = rw::RC + 512 + h * 64 + 8 * c80; else if (a_kind0 == 4) a_col = rw::RC + 1024 + h * 64 + 8 * c80;
    else if (a_kind0 == 2) a_col = rw::RC + 1536 + dir * 64 + 8 * c80; else if (a_kind0 == 3) a_col = rw::RC + 1664 + dir * 64 + 8 * c80; else a_col = 2688 + 8 * c80;
    const int mmB0 = wave >> 2;
    float bias4[4];
    { const float* bsrc = (mmB0 == 0 ? arg_in(17) : arg_in(19)) + (size_t)(l * 2 + dir) * 512 + h * 64;
#pragma unroll
      for (int nt = 0; nt < 4; ++nt) bias4[nt] = bsrc[nt * 16 + fr]; }
    u32x4 raw[10];
    auto load_raw = [&](int ui_) {
        const int idx_ = jw * 9 + ui_, b_ = idx_ / 36, blk_ = idx_ % 36;
        const int seg_ = blk_ >= 4 ? 1 : 0, bi_ = seg_ ? blk_ - 4 : blk_, len_ = seg_ ? SEQ : CTX;
        const int lo = dir ? len_ - 8 - bi_ * 64 - 8 * ga0 : bi_ * 64 + 8 * ga0;
        const bf16_t* base = CA + (size_t)urow(seg_, b_, lo) * FS + a_col;
#pragma unroll
        for (int j = 0; j < 10; ++j) { const int pos = lo - 1 + j; raw[j] = (u32x4){0u, 0u, 0u, 0u};
            if (a_act0 && pos >= 0 && pos < len_) raw[j] = *(const u32x4*)(base + (ptrdiff_t)(j - 1) * FS); }
    };
    load_raw(0);
    bf16x8 bfrB[2][4];
    { const bf16_t* Bg = WUPg + ((size_t)((wave >> 2) * 2 + dir) * 512 + h * 64) * 64;
#pragma unroll
      for (int ks = 0; ks < 2; ++ks)
#pragma unroll
          for (int nt = 0; nt < 4; ++nt) bfrB[ks][nt] = *(const bf16x8*)(Bg + (size_t)(nt * 16 + fr) * 64 + ks * 32 + fq * 8); }
    const float* shiftw = arg_in(16) + (size_t)l * 3 * 1920;
    for (int e = tid; e < 40 * 24; e += NTHR) { const int cc = e / 24, j = (e % 24) >> 3, ee = e & 7; int col;
        if (cc < 8) col = h * 64 + 8 * cc; else if (cc < 16) col = 512 + h * 64 + 8 * (cc - 8); else if (cc < 24) col = 1024 + h * 64 + 8 * (cc - 16);
        else if (cc < 32) col = 1536 + dir * 64 + 8 * (cc - 24); else col = 1664 + dir * 64 + 8 * (cc - 32);
        CWA[e] = shiftw[j * 1920 + col + ee]; }
    if (tid < 64) { KC[tid] = arg_in(22)[l * 512 + h * 64 + tid]; KC[64 + tid] = arg_in(23)[l * 512 + h * 64 + tid]; KC[128 + tid] = arg_in(24)[l * 512 + h * 64 + tid];
        LV0[tid] = l > 0 ? arg_in(25)[(size_t)(l - 1) * 512 + h * 64 + tid] : 0.f; }
    if (l > 0) { const float* vup = arg_in(27) + (size_t)(l - 1) * 32 * 512 + h * 64;
        float tv[4];
#pragma unroll
        for (int i = 0; i < 4; ++i) { const int e = tid + i * NTHR; tv[i] = vup[(size_t)(e >> 6) * 512 + (e & 63)]; }
#pragma unroll
        for (int i = 0; i < 4; ++i) { const int e = tid + i * NTHR; VUPT[(e & 63) * VL_LD + (e >> 6)] = (bf16_t)f2bf(tv[i]); } }
    LDS_BARRIER();
    const int tid_o = tid, wave_o = wave;
    volatile LAS unsigned* MISCc = (volatile LAS unsigned*)(C.lds + LDS_MISC);
#define RSTAMP(g) do { if (TSEL1 >= 1 && tid == 0) { const unsigned _t = (unsigned)__builtin_amdgcn_s_memrealtime(); MISCc[16 + (g)] += _t - MISCc[15]; MISCc[15] = _t; } } while (0)
    for (int ui = 0; ui < 9; ++ui) {
        int tid_ = tid_o, wave_ = wave_o; asm volatile("" : "+v"(tid_), "+s"(wave_));
        const int tid = tid_, wave = wave_, lane = tid & 63, fr = lane & 15, fq = lane >> 4;
        const int idx = jw * 9 + ui, b = idx / 36, blk = idx % 36;
        const size_t ug = (size_t)((b * 8 + h) * 36 + blk);
        const int seg = blk >= 4 ? 1 : 0, bi = seg ? blk - 4 : blk, len = seg ? SEQ : CTX;
        const int ga = wave < 5 ? lane >> 3 : (lane >> 2) & 7, c8 = wave < 5 ? lane & 7 : lane & 3;
        const int kind = wave == 2 ? 4 : wave == 3 ? 2 : wave == 4 ? 3 : wave;
        u32x4 vfr = (u32x4){0u, 0u, 0u, 0u};
        if (l > 0) { const int sidx_ = bi * 64 + (tid >> 3), pos_ = dir ? len - 1 - sidx_ : sidx_; vfr = *(const u32x4*)(VF + (size_t)urow(seg, b, pos_) * 512 + h * 64 + (tid & 7) * 8); }
        if (wave < 5 || (wave == 5 && lane < 32)) {
            const int ctab = kind == 0 ? c8 : kind == 1 ? 8 + c8 : kind == 4 ? 16 + c8 : kind == 2 ? 24 + c8 : 32 + c8;
            float cwa[3][8];
            if (wave < 5) {
#pragma unroll
                for (int j = 0; j < 3; ++j) { const f32x4 c0 = *(const LAS f32x4*)(CWA + ctab * 24 + j * 8), c1 = *(const LAS f32x4*)(CWA + ctab * 24 + j * 8 + 4);
                    cwa[j][0] = c0.x; cwa[j][1] = c0.y; cwa[j][2] = c0.z; cwa[j][3] = c0.w; cwa[j][4] = c1.x; cwa[j][5] = c1.y; cwa[j][6] = c1.z; cwa[j][7] = c1.w; }
            } else {
#pragma unroll
                for (int j = 0; j < 3; ++j)
#pragma unroll
                    for (int e = 0; e < 8; ++e) cwa[j][e] = j == 1 ? 1.f : 0.f;
            }
            float x[3][8];
#pragma unroll
            for (int e = 0; e < 4; ++e) { const unsigned w0 = raw[0][e], w1 = raw[1][e]; x[0][2 * e] = bflo(w0); x[0][2 * e + 1] = bfhi(w0); x[1][2 * e] = bflo(w1); x[1][2 * e + 1] = bfhi(w1); }
#pragma unroll
            for (int j = 0; j < 8; ++j) {
#pragma unroll
                for (int e = 0; e < 4; ++e) { const unsigned w2 = raw[j + 2][e]; x[(j + 2) % 3][2 * e] = bflo(w2); x[(j + 2) % 3][2 * e + 1] = bfhi(w2); }
                float o[8];
#pragma unroll
                for (int e = 0; e < 8; ++e) o[e] = x[j % 3][e] * cwa[0][e] + x[(j + 1) % 3][e] * cwa[1][e] + x[(j + 2) % 3][e] * cwa[2][e];
                const int s = dir ? 8 * ga + 7 - j : 8 * ga + j;
                if (kind < 2 || kind == 4) { LAS float* d = (kind == 0 ? LR : kind == 1 ? LK : LVV) + s * 64 + 8 * c8;
                    *(LAS f32x4*)d = (f32x4){o[0], o[1], o[2], o[3]}; *(LAS f32x4*)(d + 4) = (f32x4){o[4], o[5], o[6], o[7]}; }
                else { u32x4 w;
                    w.x = pk2(o[0], o[1]); w.y = pk2(o[2], o[3]); w.z = pk2(o[4], o[5]); w.w = pk2(o[6], o[7]);
                    *(LAS u32x4*)(kind == 2 ? AWD + s * LD + 8 * c8 : kind == 3 ? AAD + s * LD + 8 * c8 : VLB + s * VL_LD + 8 * c8) = w; }
            }
        }
        LDS_BARRIER(); RSTAMP(20);
        {
            const int mmB = wave >> 2, mtB = wave & 3;
            LAS bf16_t* Aarr = mmB == 0 ? AWD : AAD;
            f32x4 acc[4];
#pragma unroll
            for (int nt = 0; nt < 4; ++nt) acc[nt] = (f32x4){0.f, 0.f, 0.f, 0.f};
#pragma unroll
            for (int ks = 0; ks < 2; ++ks) { bf16x8 af = ldfrag(Aarr, mtB * 16 + fr, ks * 32, lane);
                if (mmB == 0) { u32x4 aw = __builtin_bit_cast(u32x4, af);
#pragma unroll
                    for (int e = 0; e < 4; ++e) aw[e] = pk2(tanhf_(bflo(aw[e])), tanhf_(bfhi(aw[e])));
                    af = __builtin_bit_cast(bf16x8, aw); }
#pragma unroll
                for (int nt = 0; nt < 4; ++nt) acc[nt] = __builtin_amdgcn_mfma_f32_16x16x32_bf16(af, bfrB[ks][nt], acc[nt], 0, 0, 0); }
            LAS float* dst = mmB == 0 ? LW : LA;
#pragma unroll
            for (int nt = 0; nt < 4; ++nt)
#pragma unroll
                for (int j = 0; j < 4; ++j) { const float sg = sigmoidf_(bias4[nt] + acc[nt][j]);
                    dst[(mtB * 16 + fq * 4 + j) * 64 + nt * 16 + fr] = mmB == 0 ? -0.6065306597126334f * sg : sg; }
            if (l > 0) {
                const bf16x8 ag = *(const LAS bf16x8*)(VLB + (mtB * 16 + fr) * VL_LD + fq * 8);
#pragma unroll
                for (int ni = 0; ni < 2; ++ni) { const int ntg = mmB * 2 + ni;
                    const f32x4 g = __builtin_amdgcn_mfma_f32_16x16x32_bf16(ag, *(const LAS bf16x8*)(VUPT + (ntg * 16 + fr) * VL_LD + fq * 8), (f32x4){0.f, 0.f, 0.f, 0.f}, 0, 0, 0);
#pragma unroll
                    for (int j = 0; j < 4; ++j) VT[(mtB * 16 + fq * 4 + j) * LD + ntg * 16 + fr] = (bf16_t)f2bf(g[j]); }
            }
        }
        LDS_BARRIER(); RSTAMP(21);
        {
            const int ch = tid & 63, p = wave; float run = 0.f;
#pragma unroll
            for (int i = 0; i < 8; ++i) { run += LW[(8 * p + i) * 64 + ch]; LW[(8 * p + i) * 64 + ch] = run; }
            PART[p * 64 + ch] = run;
            if (l > 0) *(LAS u32x4*)(AAD + (tid >> 3) * LD + (tid & 7) * 8) = vfr;
        }
        LDS_BARRIER(); RSTAMP(22);
        {
            const int t = tid >> 3, c0 = (tid & 7) * 8;
            float L8[8], Lm8[8], k8[8], a8[8], r8[8], kkc[8], kac[8], rkc[8];
            f32x4 off4[2] = {(f32x4){0.f, 0.f, 0.f, 0.f}, (f32x4){0.f, 0.f, 0.f, 0.f}};
            for (int pp = 0; pp < wave; ++pp) { off4[0] = off4[0] + *(const LAS f32x4*)(PART + pp * 64 + c0); off4[1] = off4[1] + *(const LAS f32x4*)(PART + pp * 64 + c0 + 4); }
#pragma unroll
            for (int hh = 0; hh < 2; ++hh) {
                const f32x4 l4 = *(const LAS f32x4*)(LW + t * 64 + c0 + 4 * hh) + off4[hh], m4 = ((t & 7) ? *(const LAS f32x4*)(LW + (t - 1) * 64 + c0 + 4 * hh) : (f32x4){0.f, 0.f, 0.f, 0.f}) + off4[hh];
                const f32x4 k4 = *(const LAS f32x4*)(LK + t * 64 + c0 + 4 * hh), a4 = *(const LAS f32x4*)(LA + t * 64 + c0 + 4 * hh), r4 = *(const LAS f32x4*)(LR + t * 64 + c0 + 4 * hh);
                const f32x4 q0 = *(const LAS f32x4*)(KC + c0 + 4 * hh), q1 = *(const LAS f32x4*)(KC + 64 + c0 + 4 * hh), q2 = *(const LAS f32x4*)(KC + 128 + c0 + 4 * hh);
#pragma unroll
                for (int e = 0; e < 4; ++e) { L8[4 * hh + e] = l4[e]; Lm8[4 * hh + e] = m4[e]; k8[4 * hh + e] = k4[e]; a8[4 * hh + e] = a4[e]; r8[4 * hh + e] = r4[e]; kkc[4 * hh + e] = q0[e]; kac[4 * hh + e] = q1[e]; rkc[4 * hh + e] = q2[e]; }
            }
            float n2 = 0.f, bo = 0.f, kkv[8], kd[8];
#pragma unroll
            for (int e = 0; e < 8; ++e) { kkv[e] = k8[e] * kkc[e]; n2 += kkv[e] * kkv[e]; kd[e] = k8[e] * (1.0f + (a8[e] - 1.0f) * kac[e]); bo += r8[e] * kd[e] * rkc[e]; }
            n2 += DPP_MOV(n2, 0xB1); n2 += DPP_MOV(n2, 0x4E); n2 += DPP_MOV(n2, 0x141);
            bo += DPP_MOV(bo, 0xB1); bo += DPP_MOV(bo, 0x4E); bo += DPP_MOV(bo, 0x141);
            const float inv = __builtin_amdgcn_rcpf(fmaxf(sqrtf(n2), 1e-12f));
            float okp[8], obt[8], okt[8], ort[8], eg8[8];
#pragma unroll
            for (int e = 0; e < 8; ++e) { const float eg = __expf(L8[e]), egi = __builtin_amdgcn_rcpf(eg), kap = kkv[e] * inv;
                eg8[e] = eg; okp[e] = kap * __expf(Lm8[e]); obt[e] = kap * a8[e] * egi; okt[e] = kd[e] * egi; ort[e] = r8[e] * eg; }
            u32x4 w;
            w.x = pk2(okp[0], okp[1]); w.y = pk2(okp[2], okp[3]); w.z = pk2(okp[4], okp[5]); w.w = pk2(okp[6], okp[7]); *(LAS u32x4*)(KP + t * LD + c0) = w;
            w.x = pk2(obt[0], obt[1]); w.y = pk2(obt[2], obt[3]); w.z = pk2(obt[4], obt[5]); w.w = pk2(obt[6], obt[7]); *(LAS u32x4*)(BT + t * LD + c0) = w;
            w.x = pk2(okt[0], okt[1]); w.y = pk2(okt[2], okt[3]); w.z = pk2(okt[4], okt[5]); w.w = pk2(okt[6], okt[7]); *(LAS u32x4*)(KT + t * LD + c0) = w;
            w.x = pk2(ort[0], ort[1]); w.y = pk2(ort[2], ort[3]); w.z = pk2(ort[4], ort[5]); w.w = pk2(ort[6], ort[7]); *(LAS u32x4*)(RT + t * LD + c0) = w;
            if (t == 63) { *(LAS f32x4*)(LGC + c0) = (f32x4){eg8[0], eg8[1], eg8[2], eg8[3]}; *(LAS f32x4*)(LGC + c0 + 4) = (f32x4){eg8[4], eg8[5], eg8[6], eg8[7]}; }
            if ((tid & 7) == 0) { const int sidx = bi * 64 + t, pos = dir ? len - 1 - sidx : sidx; BON[((size_t)dir * T_ALL + urow(seg, b, pos)) * 8 + h] = bo; }
            const int vr = tid & 63, s8 = tid >> 6;
            const float v0c = LV0[vr];
#pragma unroll
            for (int it = 0; it < 8; ++it) {
                const int s = s8 + 8 * it;
                float v = LVV[s * 64 + vr];
                if (l > 0) { const float g = v0c + bf2f(VT[s * LD + vr]); v = v + (bf2f(AAD[s * LD + vr]) - v) * sigmoidf_(g); }
                VT[s * LD + vr] = (bf16_t)f2bf(v);
            }
        }
        LDS_BARRIER(); RSTAMP(23);
        if (dir == 0) { const int s_ = tid >> 3; *(u32x4*)((l > 0 ? VM : VF) + (size_t)urow(seg, b, bi * 64 + s_) * 512 + h * 64 + (tid & 7) * 8) = *(const LAS u32x4*)(VT + s_ * LD + (tid & 7) * 8); }
        {
            const int mmE = wave >> 1;
            LAS const bf16_t* Ao = (mmE == 0 || mmE == 3) ? BT : KT; LAS const bf16_t* Bo = (mmE < 2) ? KP : RT;
#pragma unroll
            for (int mi = 0; mi < 2; ++mi) { const int mt = (wave & 1) * 2 + mi;
                f32x4 acc[4];
#pragma unroll
                for (int nt = 0; nt < 4; ++nt) acc[nt] = (f32x4){0.f, 0.f, 0.f, 0.f};
#pragma unroll
                for (int ks = 0; ks < 2; ++ks) { const bf16x8 af = ldfrag(Ao, mt * 16 + fr, ks * 32, lane);
#pragma unroll
                    for (int nt = 0; nt < 4; ++nt) acc[nt] = __builtin_amdgcn_mfma_f32_16x16x32_bf16(af, ldfrag(Bo, nt * 16 + fr, ks * 32, lane), acc[nt], 0, 0, 0); }
#pragma unroll
                for (int nt = 0; nt < 4; ++nt) { const int t = nt * 16 + fr, j0 = mt * 16 + fq * 4; float m[4];
                    float zf = 0.f; asm volatile("" : "+v"(zf));
#pragma unroll
                    for (int j = 0; j < 4; ++j) m[j] = (mmE < 2 ? (j0 + j < t) : (j0 + j <= t)) ? acc[nt][j] : zf;
                    if (mmE == 0) *(LAS f32x4*)(ABT + t * 64 + j0) = (f32x4){m[0], m[1], m[2], m[3]};
                    else { u32x2 w; w.x = pk2(m[0], m[1]); w.y = pk2(m[2], m[3]); *(LAS u32x2*)((mmE == 1 ? AKT : mmE == 2 ? MKT : MBT) + t * LD + j0) = w; } }
            }
        }
        LDS_BARRIER(); RSTAMP(24);
        LAS float* TF = (LAS float*)(lds + OFF_TF); LAS float* WS = (LAS float*)(lds + OFF_WS);
        typedef float f32x4_ __attribute__((ext_vector_type(4)));
#define RC_PROD_TF_M(acc, a_, k_, c_) do { _Pragma("unroll") for (int ks = 0; ks < 4; ++ks) acc = __builtin_amdgcn_mfma_f32_16x16x4f32(TF[(16 * (a_) + fr) * 68 + 16 * (k_) + 4 * ks + fq], ABT[(16 * (c_) + fr) * 64 + 16 * (k_) + 4 * ks + fq], acc, 0, 0, 0); } while (0)
#define RC_PROD_WS_TF(acc, wslot, k_, c_) do { _Pragma("unroll") for (int ks = 0; ks < 4; ++ks) acc = __builtin_amdgcn_mfma_f32_16x16x4f32(WS[((wslot) * 16 + fr) * 17 + 4 * ks + fq], TF[(16 * (k_) + 4 * ks + fq) * 68 + 16 * (c_) + fr], acc, 0, 0, 0); } while (0)
#define RC_PUT_WS(acc, wslot) do { _Pragma("unroll") for (int j = 0; j < 4; ++j) WS[((wslot) * 16 + fq * 4 + j) * 17 + fr] = acc[j]; } while (0)
#define RC_PUT_TF_NEG(acc, a_, c_) do { _Pragma("unroll") for (int j = 0; j < 4; ++j) TF[(16 * (a_) + fq * 4 + j) * 68 + 16 * (c_) + fr] = -acc[j]; \
        u32x2 _w; _w.x = pk2(-acc[0], -acc[1]); _w.y = pk2(-acc[2], -acc[3]); *(LAS u32x2*)(TTT + (16 * (c_) + fr) * LD + 16 * (a_) + fq * 4) = _w; } while (0)
        if (wave == 0) {
            const int bb = lane >> 4, ii = lane & 15;
            float Dr[16];
#pragma unroll
            for (int c = 0; c < 16; ++c) {
                float m[16];
#pragma unroll
                for (int j4 = 0; j4 < (c + 3) / 4; ++j4) { const f32x4 mv = *(const LAS f32x4*)(ABT + (16 * bb + c) * 64 + 16 * bb + 4 * j4); m[4 * j4] = mv.x; m[4 * j4 + 1] = mv.y; m[4 * j4 + 2] = mv.z; m[4 * j4 + 3] = mv.w; }
                float a0 = (ii == c) ? 1.0f : 0.f, a1 = 0.f;
#pragma unroll
                for (int j = 0; j < c; ++j) { if (j & 1) a1 -= Dr[j] * m[j]; else a0 -= Dr[j] * m[j]; }
                Dr[c] = a0 + a1;
            }
#pragma unroll
            for (int c = 0; c < 16; ++c) { TF[(16 * bb + ii) * 68 + 16 * bb + c] = Dr[c]; TTT[(16 * bb + c) * LD + 16 * bb + ii] = (bf16_t)f2bf(Dr[c]); }
        } else if (wave >= 5) {
            for (int e = tid - 320; e < 6 * 256; e += 192) { const int bk = e >> 8, w = e & 255; const int tb = bk < 3 ? 0 : bk < 5 ? 1 : 2, rb = bk < 3 ? bk + 1 : bk < 5 ? bk - 1 : 3;
                TTT[(16 * tb + (w >> 4)) * LD + 16 * rb + (w & 15)] = 0; }
        } else {
            const int mt = wave - 1;
            f32x4 acc[4];
#pragma unroll
            for (int nt = 0; nt < 4; ++nt) acc[nt] = (f32x4){0.f, 0.f, 0.f, 0.f};
#pragma unroll
            for (int ks = 0; ks < 2; ++ks) { const bf16x8 af = trfrag<LD>(VT, ks * 32, mt * 16, lane);
#pragma unroll
                for (int nt = 0; nt < 4; ++nt) acc[nt] = __builtin_amdgcn_mfma_f32_16x16x32_bf16(af, ldfrag(AKT, nt * 16 + fr, ks * 32, lane), acc[nt], 0, 0, 0); }
#pragma unroll
            for (int nt = 0; nt < 4; ++nt)
#pragma unroll
                for (int j = 0; j < 4; ++j) XX[(mt * 16 + fq * 4 + j) * LD + nt * 16 + fr] = (bf16_t)f2bf(acc[nt][j]);
        }
        LDS_BARRIER(); RSTAMP(25);
        if (wave < 2) {
            const int a_ = 2 * wave, c_ = 2 * wave + 1;
            f32x4_ w = {0.f, 0.f, 0.f, 0.f}; RC_PROD_TF_M(w, a_, a_, c_); RC_PUT_WS(w, wave);
            f32x4_ t = {0.f, 0.f, 0.f, 0.f}; RC_PROD_WS_TF(t, wave, c_, c_); RC_PUT_TF_NEG(t, a_, c_);
        }
        LDS_BARRIER(); RSTAMP(26);
        if (wave < 2) {
            const int a_ = wave;
            f32x4_ w2 = {0.f, 0.f, 0.f, 0.f}, w3 = {0.f, 0.f, 0.f, 0.f};
            if (a_ == 0) { RC_PROD_TF_M(w2, 0, 0, 2); RC_PROD_TF_M(w3, 0, 0, 3); }
            RC_PROD_TF_M(w2, a_, 1, 2); RC_PROD_TF_M(w3, a_, 1, 3);
            RC_PUT_WS(w2, 2 * a_); RC_PUT_WS(w3, 2 * a_ + 1);
            f32x4_ t2 = {0.f, 0.f, 0.f, 0.f}, t3 = {0.f, 0.f, 0.f, 0.f};
            RC_PROD_WS_TF(t2, 2 * a_, 2, 2); RC_PROD_WS_TF(t3, 2 * a_, 2, 3); RC_PROD_WS_TF(t3, 2 * a_ + 1, 3, 3);
            RC_PUT_TF_NEG(t2, a_, 2); RC_PUT_TF_NEG(t3, a_, 3);
        }
#undef RC_PROD_TF_M
#undef RC_PROD_WS_TF
#undef RC_PUT_WS
#undef RC_PUT_TF_NEG
        LDS_BARRIER(); RSTAMP(27);
        if (ui + 1 < 9) load_raw(ui + 1);
        {
            const bool isz = wave >= 4; const int mt = wave & 3;
            bf16x8 af[2], bt[2][4];
            if (isz) { af[0] = ldfrag(XX, mt * 16 + fr, 0, lane); af[1] = ldfrag(XX, mt * 16 + fr, 32, lane); } else rc::trfrag2k<LD>(KP, mt * 16, lane, af);
#pragma unroll
            for (int ks = 0; ks < 2; ++ks)
#pragma unroll
                for (int nt = 0; nt < 4; ++nt) bt[ks][nt] = ldfrag(TTT, nt * 16 + fr, ks * 32, lane);
            f32x4 acc[4];
#pragma unroll
            for (int nt = 0; nt < 4; ++nt) acc[nt] = (f32x4){0.f, 0.f, 0.f, 0.f};
#pragma unroll
            for (int ks = 0; ks < 2; ++ks)
#pragma unroll
                for (int nt = 0; nt < 4; ++nt) acc[nt] = __builtin_amdgcn_mfma_f32_16x16x32_bf16(af[ks], bt[ks][nt], acc[nt], 0, 0, 0);
            LAS bf16_t* dst = isz ? NZ : WU; const float sgn = isz ? -1.f : 1.f;
#pragma unroll
            for (int nt = 0; nt < 4; ++nt)
#pragma unroll
                for (int j = 0; j < 4; ++j) dst[(mt * 16 + fq * 4 + j) * LD + nt * 16 + fr] = (bf16_t)f2bf(sgn * acc[nt][j]);
        }
        LDS_BARRIER(); RSTAMP(28);
        {
            const int hi = wave >> 2, mt = wave & 3;
            bf16x8 wu[2], az[2], av[2];
#pragma unroll
            for (int ks = 0; ks < 2; ++ks) { wu[ks] = ldfrag(WU, mt * 16 + fr, ks * 32, lane); az[ks] = ldfrag(NZ, mt * 16 + fr, ks * 32, lane); }
            rc::trfrag2k<LD>(VT, mt * 16, lane, av);
            f32x4 acc[4], facc[4];
#pragma unroll
            for (int nt = 0; nt < 4; ++nt) { acc[nt] = (f32x4){0.f, 0.f, 0.f, 0.f}; facc[nt] = (f32x4){0.f, 0.f, 0.f, 0.f}; }
#pragma unroll
            for (int ks = 0; ks < 2; ++ks) {
                bf16x8 b1[4], b2[4];
                if (hi == 0) {
#pragma unroll
                    for (int nt = 0; nt < 4; ++nt) { b1[nt] = ldfrag(MKT, nt * 16 + fr, ks * 32, lane); b2[nt] = ldfrag(MBT, nt * 16 + fr, ks * 32, lane); }
                } else { rc::trfrag4<LD>(KT, ks * 32, lane, b1); rc::trfrag4<LD>(BT, ks * 32, lane, b2); }
#pragma unroll
                for (int nt = 0; nt < 4; ++nt) {
                    acc[nt] = __builtin_amdgcn_mfma_f32_16x16x32_bf16(wu[ks], b2[nt], acc[nt], 0, 0, 0);
                    facc[nt] = __builtin_amdgcn_mfma_f32_16x16x32_bf16(av[ks], b1[nt], facc[nt], 0, 0, 0); facc[nt] = __builtin_amdgcn_mfma_f32_16x16x32_bf16(az[ks], b2[nt], facc[nt], 0, 0, 0); }
            }
#pragma unroll
            for (int nt = 0; nt < 4; ++nt) { const int cn = nt * 16 + fr, a0 = mt * 16 + fq * 4; float o[4];
                if (hi) { const float gc = LGC[cn];
#pragma unroll
                    for (int j = 0; j < 4; ++j) o[j] = (((a0 + j) == cn ? 1.0f : 0.f) - acc[nt][j]) * gc; }
                else { const u32x2 rv = *(const LAS u32x2*)(RT + cn * LD + a0); o[0] = bflo(rv.x) - acc[nt][0]; o[1] = bfhi(rv.x) - acc[nt][1]; o[2] = bflo(rv.y) - acc[nt][2]; o[3] = bfhi(rv.y) - acc[nt][3]; }
                u32x2 w; w.x = pk2(o[0], o[1]); w.y = pk2(o[2], o[3]); *(u32x2*)(WYG + bpart(b, (hi ? 288 : 0) + h * 36 + blk, 4096) + cn * 64 + a0) = w;
            }
#pragma unroll
            for (int nt = 0; nt < 4; ++nt) { const int cn = nt * 16 + fr, v0 = mt * 16 + fq * 4; u32x2 w;
                if (hi == 0) { w.x = pk2(facc[nt][0], facc[nt][1]); w.y = pk2(facc[nt][2], facc[nt][3]);
                    const int sidx = bi * 64 + cn, pos = dir ? len - 1 - sidx : sidx;
                    *(u32x2*)(Y + (size_t)urow(seg, b, pos) * 1024 + dir * 512 + h * 64 + v0) = w; }
                else { const float gc = LGC[cn]; w.x = pk2(facc[nt][0] * gc, facc[nt][1] * gc); w.y = pk2(facc[nt][2] * gc, facc[nt][3] * gc);
                    *(u32x2*)(QG + (size_t)b * 2097152 + (size_t)(h * 36 + blk) * 4096 + cn * 64 + v0) = w; } }
        }
        LDS_BARRIER(); RSTAMP(29);
    }
}
template <int FIN>
__device__ __forceinline__ void r2_chain(Ctx& C, int dir, int b, int h, int qr) {
    using namespace r1; using rc::ldfrag;
    const int tid = C.tid, lane = C.lane, wave = C.wave, fr = lane & 15, fq = lane >> 4;
    bf16_t* Y = (bf16_t*)(C.ws + WS_F2);
    const bf16_t* WYG = (const bf16_t*)(C.ws + WS_WYG); const bf16_t* PTG = (const bf16_t*)(C.ws + WS_PTG); const bf16_t* QG = (const bf16_t*)(C.ws + WS_QG);
    LAS bf16_t* S0B = (LAS bf16_t*)C.lds;
    for (int e = tid; e < 2 * 16 * LD; e += NTHR) S0B[e] = 0;
    const int nt = wave & 3, cn = nt * 16 + fr, v0 = qr * 16 + fq * 4;
    const size_t ug0 = (size_t)((b * 8 + h) * 36);
    bf16x8 bwq[4][2]; u32x2 iniq[4];
#define R2_LOAD(slot, blk_) do { const int _bk = (blk_); const bf16_t* _M = WYG + bpart(b, (FIN == 0 ? 0 : 288) + h * 36 + _bk, 4096); \
        bwq[slot][0] = *(const bf16x8*)(_M + cn * 64 + fq * 8); bwq[slot][1] = *(const bf16x8*)(_M + cn * 64 + 32 + fq * 8); \
        if (FIN == 0) { const int _seg = _bk >= 4 ? 1 : 0, _bi = _seg ? _bk - 4 : _bk, _len = _seg ? SEQ : CTX, _sidx = _bi * 64 + cn, _pos = dir ? _len - 1 - _sidx : _sidx; \
            iniq[slot] = *(const u32x2*)(Y + (size_t)urow(_seg, b, _pos) * 1024 + dir * 512 + h * 64 + v0); } \
        else iniq[slot] = *(const u32x2*)(QG + (size_t)b * 2097152 + (size_t)(h * 36 + _bk) * 4096 + cn * 64 + v0); } while (0)
    R2_LOAD(0, 0); R2_LOAD(1, 1); R2_LOAD(2, 2); R2_LOAD(3, 3);
    LDS_BARRIER();
#pragma unroll 1
    for (int blk0 = 0; blk0 < 36; blk0 += 4) {
#pragma unroll
        for (int p = 0; p < 4; ++p) {
            const int blk = blk0 + p;
            LAS bf16_t* S0cur = S0B + (p & 1) * 16 * LD; LAS bf16_t* S0nxt = S0B + ((p + 1) & 1) * 16 * LD;
            const u32x2 ini = iniq[p];
            f32x4 acc = (f32x4){bflo(ini.x), bfhi(ini.x), bflo(ini.y), bfhi(ini.y)};
            const bf16x8 b0 = bwq[p][0], b1 = bwq[p][1];
            const int seg = blk >= 4 ? 1 : 0, bi = seg ? blk - 4 : blk, len = seg ? SEQ : CTX, sidx = bi * 64 + cn, pos = dir ? len - 1 - sidx : sidx;
            bf16_t* yp = Y + (size_t)urow(seg, b, pos) * 1024 + dir * 512 + h * 64 + v0;
            acc = __builtin_amdgcn_mfma_f32_16x16x32_bf16(ldfrag(S0cur, fr, 0, lane), b0, acc, 0, 0, 0);
            acc = __builtin_amdgcn_mfma_f32_16x16x32_bf16(ldfrag(S0cur, fr, 32, lane), b1, acc, 0, 0, 0);
            R2_LOAD(p, blk + 4 < 36 ? blk + 4 : 35);
            if (FIN == 0) { u32x2 w; w.x = pk2(acc[0], acc[1]); w.y = pk2(acc[2], acc[3]); *(u32x2*)yp = w; }
            else {
#pragma unroll
                for (int j = 0; j < 4; ++j) S0nxt[(fq * 4 + j) * LD + cn] = (bf16_t)f2bf(acc[j]); }
            LDS_BARRIER();
        }
    }
#undef R2_LOAD
}
__device__ __forceinline__ void phase_rwkv_r2(Ctx& C, int l, int dir) {
    C.refresh();
    const int h = (C.bid >> 3) & 7, qr = C.bid >> 6, b = C.bid & 7;
    if ((C.wave >> 2) == 0) r2_chain<0>(C, dir, b, h, qr); else r2_chain<1>(C, dir, b, h, qr);
}

__device__ __forceinline__ void phase_rwkv_out(Ctx& C, int l, int unit_lo) {
    C.refresh();
    const int tid = C.tid, lane = C.lane, wave = C.wave;
    constexpr int OFF_AG = 0, AG_LD = 136, OFF_PRE = 17408, PRE_LD = 520;
    LAS bf16_t* AG = (LAS bf16_t*)(C.lds + OFF_AG); LAS bf16_t* PRE = (LAS bf16_t*)(C.lds + OFF_PRE);
    const bf16_t* CA = (const bf16_t*)(C.ws + WS_F);
    const bf16_t* Y = (const bf16_t*)(C.ws + WS_F2);
    const bf16_t* VV = (const bf16_t*)(C.ws + (l == 0 ? WS_VFIRST : WS_VMIX));
    const float* BON = (const float*)(C.ws + WS_BONUS);
    const bf16_t* GUP = (const bf16_t*)(C.ws + WS_W + W_GUP);
    bf16_t* AO = (bf16_t*)(C.ws + WS_AO);
    const float* shiftw = arg_in(16) + (size_t)l * 3 * 1920;
    const float* gnw = arg_in(28) + (size_t)l * 512; const float* gnb = arg_in(29) + (size_t)l * 512;
    const int cg = tid & 127, sg0 = tid >> 7;
    float cw_g[3];
#pragma unroll
    for (int j = 0; j < 3; ++j) cw_g[j] = shiftw[j * 1920 + 1792 + cg];
    const int fr = lane & 15, fq = lane >> 4;
    const bool bal = C.G == 256; const int jb = C.bid >> 3;
    const int cu = jb == 0 ? 0 : jb == 15 ? 1 : jb == 16 ? 2 : jb == 31 ? 3 : -1;
    for (int u = bal ? 0 : unit_lo + C.bid; u < (bal ? ((unit_lo == 0 && cu >= 0) ? 2 : 1) : T_ALL / 64); u += bal ? 1 : C.G) {
        const int row0 = bal ? (u == 0 ? T_CTX + (C.bid & 7) * SEQ + jb * 64 : (C.bid & 7) * CTX + cu * 64) : u * 64;
        const int seg = row0 >= T_CTX ? 1 : 0, len = seg ? SEQ : CTX, pos0 = seg ? ((row0 - T_CTX) & (SEQ - 1)) : (row0 & (CTX - 1));
        __syncthreads();
#pragma unroll 1
        for (int it0 = 0; it0 < 16; it0 += 4) {
            bf16_t xr[4][3];
#pragma unroll
            for (int k = 0; k < 4; ++k) { const int s = sg0 + 4 * (it0 + k), pos = pos0 + s;
                const bf16_t* r0 = CA + (size_t)(row0 + s) * FS + rw::RC + 1792 + cg;
                xr[k][0] = r0[pos >= 1 ? -FS : 0]; xr[k][1] = r0[0]; xr[k][2] = r0[pos + 1 < len ? FS : 0]; }
#pragma unroll
            for (int k = 0; k < 4; ++k) { const int s = sg0 + 4 * (it0 + k), pos = pos0 + s;
                const float xm = pos >= 1 ? bf2f(xr[k][0]) : 0.f, xp = pos + 1 < len ? bf2f(xr[k][2]) : 0.f;
                AG[s * AG_LD + cg] = (bf16_t)f2bf(sigmoidf_(xm * cw_g[0] + bf2f(xr[k][1]) * cw_g[1] + xp * cw_g[2])); }
        }
#pragma unroll 1
        for (int pass = 0; pass < 2; ++pass) {
            const int pr = (tid >> 1) + pass * 256, s = pr >> 3, hh = pr & 7, row = row0 + s, hf = tid & 1;
            const u32x4* yf = (const u32x4*)(Y + (size_t)row * 1024 + hh * 64 + hf * 32); const u32x4* yb = (const u32x4*)(Y + (size_t)row * 1024 + 512 + hh * 64 + hf * 32);
            float y[32]; float sum = 0.f;
            u32x4 ya[4], yq[4], vq[4];
            const u32x4* vv = (const u32x4*)(VV + (size_t)row * 512 + hh * 64 + hf * 32);
#pragma unroll
            for (int k = 0; k < 4; ++k) { ya[k] = yf[k]; yq[k] = yb[k]; vq[k] = vv[k]; }
            const float bon = BON[(size_t)row * 8 + hh] + BON[((size_t)T_ALL + row) * 8 + hh];
#pragma unroll
            for (int k = 0; k < 4; ++k) { const u32x4 a = ya[k], bq = yq[k];
                y[8 * k + 0] = bflo(a.x) + bflo(bq.x); y[8 * k + 1] = bfhi(a.x) + bfhi(bq.x); y[8 * k + 2] = bflo(a.y) + bflo(bq.y); y[8 * k + 3] = bfhi(a.y) + bfhi(bq.y);
                y[8 * k + 4] = bflo(a.z) + bflo(bq.z); y[8 * k + 5] = bfhi(a.z) + bfhi(bq.z); y[8 * k + 6] = bflo(a.w) + bflo(bq.w); y[8 * k + 7] = bfhi(a.w) + bfhi(bq.w); }
#pragma unroll
            for (int k = 0; k < 32; ++k) sum += y[k];
            sum += DPP_MOV(sum, 0xB1);
            const float mean = sum * (1.0f / 64.0f); float var = 0.f;
#pragma unroll
            for (int k = 0; k < 32; ++k) { y[k] -= mean; var += y[k] * y[k]; }
            var += DPP_MOV(var, 0xB1);
            const float rstd = 1.0f / sqrtf(var * (1.0f / 64.0f) + 64e-5f);
            const f32x4* gw4 = (const f32x4*)(gnw + hh * 64 + hf * 32); const f32x4* gb4 = (const f32x4*)(gnb + hh * 64 + hf * 32);
#pragma unroll
            for (int k = 0; k < 4; ++k) { const u32x4 v = vq[k]; const f32x4 w0 = gw4[2 * k], w1 = gw4[2 * k + 1], b0 = gb4[2 * k], b1 = gb4[2 * k + 1];
                u32x4 o;
                const float ys = RW_DBG == 4 ? 0.f : rstd, bs = RW_DBG == 5 ? 0.f : bon;
                o.x = pk2(y[8 * k + 0] * ys * w0.x + b0.x + bs * bflo(v.x), y[8 * k + 1] * ys * w0.y + b0.y + bs * bfhi(v.x));
                o.y = pk2(y[8 * k + 2] * ys * w0.z + b0.z + bs * bflo(v.y), y[8 * k + 3] * ys * w0.w + b0.w + bs * bfhi(v.y));
                o.z = pk2(y[8 * k + 4] * ys * w1.x + b1.x + bs * bflo(v.z), y[8 * k + 5] * ys * w1.y + b1.y + bs * bfhi(v.z));
                o.w = pk2(y[8 * k + 6] * ys * w1.z + b1.z + bs * bflo(v.w), y[8 * k + 7] * ys * w1.w + b1.w + bs * bfhi(v.w));
                *(LAS u32x4*)(PRE + s * PRE_LD + hh * 64 + hf * 32 + 8 * k) = o; }
        }
        bf16x8 gupf[4][4];
#pragma unroll
        for (int ks = 0; ks < 4; ++ks)
#pragma unroll
            for (int nt = 0; nt < 4; ++nt) gupf[ks][nt] = *(const bf16x8*)(GUP + (size_t)(wave * 64 + nt * 16 + fr) * 128 + ks * 32 + fq * 8);
        __syncthreads();
        {
            f32x4 acc[4][4];
#pragma unroll
            for (int mt = 0; mt < 4; ++mt)
#pragma unroll
                for (int nt = 0; nt < 4; ++nt) acc[mt][nt] = (f32x4){0.f, 0.f, 0.f, 0.f};
#pragma unroll
            for (int ks = 0; ks < 4; ++ks) {
                bf16x8 af[4], bfr[4];
#pragma unroll
                for (int mt = 0; mt < 4; ++mt) af[mt] = *(const LAS bf16x8*)(AG + (mt * 16 + fr) * AG_LD + ks * 32 + fq * 8);
#pragma unroll
                for (int nt = 0; nt < 4; ++nt) bfr[nt] = gupf[ks][nt];
#pragma unroll
                for (int mt = 0; mt < 4; ++mt)
#pragma unroll
                    for (int nt = 0; nt < 4; ++nt) acc[mt][nt] = __builtin_amdgcn_mfma_f32_16x16x32_bf16(af[mt], bfr[nt], acc[mt][nt], 0, 0, 0);
            }
#pragma unroll
            for (int mt = 0; mt < 4; ++mt)
#pragma unroll
                for (int nt = 0; nt < 4; ++nt)
#pragma unroll
                    for (int j = 0; j < 4; ++j) { LAS bf16_t* pp = PRE + (mt * 16 + fq * 4 + j) * PRE_LD + wave * 64 + nt * 16 + fr;
                        *pp = (bf16_t)f2bf((RW_DBG == 1 || RW_DBG >= 4) ? bf2f(*pp) : RW_DBG == 2 ? acc[mt][nt][j] : RW_DBG == 3 ? bf2f(AG[(mt * 16 + fq * 4 + j) * AG_LD + ((nt * 16 + fr) & 127)]) : bf2f(*pp) * acc[mt][nt][j]); }
        }
        __syncthreads();
#pragma unroll 2
        for (int i = 0; i < 8; ++i) { const int e = tid + i * NTHR, sr = e >> 6, ch = e & 63;
            *(u32x4*)(AO + (size_t)(row0 + sr) * 1024 + 512 + ch * 8) = *(const LAS u32x4*)(PRE + sr * PRE_LD + ch * 8); }
    }
}

__device__ __forceinline__ void phase_attention(Ctx& C, int l, bool with_ctx_units) {
    C.refresh();
    const int tid = C.tid, lane = C.lane, wave = C.wave, fr = lane & 15, fq = lane >> 4;
    constexpr int KS_LD = 72, VT_LD = 136, P_LD = 136, OFF_KS = 0, OFF_VT = 18432, OFF_P = 35840;
    LAS bf16_t* KS = (LAS bf16_t*)(C.lds + OFF_KS); LAS bf16_t* VT = (LAS bf16_t*)(C.lds + OFF_VT);
    LAS bf16_t* PW = (LAS bf16_t*)(C.lds + OFF_P + wave * (16 * P_LD * 2));
    const bf16_t* CA = (const bf16_t*)(C.ws + WS_F);
    bf16_t* AO = (bf16_t*)(C.ws + WS_AO);
    const int nunits = 256 + (with_ctx_units ? 32 : 0);
    const int g = wave >> 1, qhalf = wave & 1;
    for (int ui2 = 0; ui2 < 2; ++ui2) {
        int b, kvh, qb, qseg;
        if (C.G == 256) {
            const int j = C.bid >> 3; b = C.bid & 7;
            if (ui2 == 0) { qseg = 1; kvh = j >> 4; qb = j & 15; } else { if (!with_ctx_units || j < 4 || j >= 8) break; qseg = 0; kvh = (j - 4) >> 1; qb = j & 1; }
        } else {
            const int u = ui2 == 0 ? C.bid : (C.bid >= 32 && C.bid < 64 ? 256 + C.bid - 32 : nunits);
            if (u >= nunits) break;
            if (u < 256) { qseg = 1; b = u >> 5; kvh = (u >> 4) & 1; qb = u & 15; } else { const int v = u - 256; qseg = 0; b = v >> 2; kvh = (v >> 1) & 1; qb = v & 1; }
        }
        const int qhead = kvh * 4 + g;
        const float sink = arg_in(15)[l * 8 + qhead];
        bf16x8 qf[4][2];
        const int qrow0 = urow(qseg, b, qb * 128 + qhalf * 64);
#pragma unroll
        for (int mt = 0; mt < 4; ++mt)
#pragma unroll
            for (int ks = 0; ks < 2; ++ks) qf[mt][ks] = *(const bf16x8*)(CA + (size_t)(qrow0 + mt * 16 + fr) * FS + qhead * 64 + ks * 32 + fq * 8);
        f32x4 O[4][4]; float mrow[4][4], lrow[4][4];
#pragma unroll
        for (int mt = 0; mt < 4; ++mt)
#pragma unroll
            for (int j = 0; j < 4; ++j) { O[mt][j] = (f32x4){0.f, 0.f, 0.f, 0.f}; mrow[mt][j] = sink; lrow[mt][j] = 1.0f; }
        const int nkb = qseg ? 5 : 2;
        for (int kbi = 0; kbi < nkb; ++kbi) {
            int kseg, kblk;
            if (qseg) { if (kbi < 3) { kseg = 1; kblk = qb - 1 + kbi; } else { kseg = 0; kblk = kbi - 3; } } else { kseg = 0; kblk = kbi; }
            if (kseg == 1 && (kblk < 0 || kblk > 15)) continue;
            {
                const int krow0 = urow(kseg, b, kblk * 128);
                u32x4 kvr[2], vvr[2];
#pragma unroll
                for (int i = 0; i < 2; ++i) { const int e = tid + i * NTHR, kr = e & 127, ch = e >> 7;
                    const bf16_t* src = CA + (size_t)(krow0 + kr) * FS;
                    kvr[i] = *(const u32x4*)(src + 512 + kvh * 64 + ch * 8); vvr[i] = *(const u32x4*)(src + 640 + kvh * 64 + ch * 8); }
                __syncthreads();
#pragma unroll
                for (int i = 0; i < 2; ++i) { const int e = tid + i * NTHR, kr = e & 127, ch = e >> 7;
                    const u32x4 kv = kvr[i], vv = vvr[i];
                    *(LAS u32x4*)(KS + kr * KS_LD + ch * 8) = kv;
                    LAS bf16_t* vd = VT + (ch * 8) * VT_LD + kr;
                    vd[0 * VT_LD] = (bf16_t)(vv.x & 0xffff); vd[1 * VT_LD] = (bf16_t)(vv.x >> 16); vd[2 * VT_LD] = (bf16_t)(vv.y & 0xffff); vd[3 * VT_LD] = (bf16_t)(vv.y >> 16);
                    vd[4 * VT_LD] = (bf16_t)(vv.z & 0xffff); vd[5 * VT_LD] = (bf16_t)(vv.z >> 16); vd[6 * VT_LD] = (bf16_t)(vv.w & 0xffff); vd[7 * VT_LD] = (bf16_t)(vv.w >> 16); }
            }
            __syncthreads();
            const bool windowed = (qseg == 1 && kseg == 1);
            const int dblk = (kblk - qb) * 128;
#pragma unroll
            for (int mt = 0; mt < 4; ++mt) {
                f32x4 S[8];
#pragma unroll
                for (int nt = 0; nt < 8; ++nt) S[nt] = (f32x4){0.f, 0.f, 0.f, 0.f};
#pragma unroll
                for (int ks = 0; ks < 2; ++ks)
#pragma unroll
                    for (int nt = 0; nt < 8; ++nt) { const bf16x8 kf = *(const LAS bf16x8*)(KS + (nt * 16 + fr) * KS_LD + ks * 32 + fq * 8);
                        S[nt] = __builtin_amdgcn_mfma_f32_16x16x32_bf16(qf[mt][ks], kf, S[nt], 0, 0, 0); }
                if (windowed) {
#pragma unroll
                    for (int nt = 0; nt < 8; ++nt)
#pragma unroll
                        for (int j = 0; j < 4; ++j) { const int d = dblk + (nt * 16 + fr) - (qhalf * 64 + mt * 16 + fq * 4 + j); if (d > 128 || d < -128) S[nt][j] = -1e30f; }
                }
#pragma unroll
                for (int j = 0; j < 4; ++j) {
                    float mx = S[0][j];
#pragma unroll
                    for (int nt = 1; nt < 8; ++nt) mx = fmaxf(mx, S[nt][j]);
                    mx = allreduce16_max(mx);
                    const float mn = fmaxf(mrow[mt][j], mx), alpha = __expf(mrow[mt][j] - mn);
                    mrow[mt][j] = mn;
                    float rs = 0.f;
#pragma unroll
                    for (int nt = 0; nt < 8; ++nt) { const float p = __expf(S[nt][j] - mn); rs += p; PW[(fq * 4 + j) * P_LD + nt * 16 + fr] = (bf16_t)f2bf(p); }
                    rs = allreduce16(rs);
                    lrow[mt][j] = lrow[mt][j] * alpha + rs;
#pragma unroll
                    for (int nd = 0; nd < 4; ++nd) O[mt][nd][j] *= alpha;
                }
#pragma unroll
                for (int ks = 0; ks < 4; ++ks) { const bf16x8 pf = *(const LAS bf16x8*)(PW + fr * P_LD + ks * 32 + fq * 8);
#pragma unroll
                    for (int nd = 0; nd < 4; ++nd) { const bf16x8 vf = *(const LAS bf16x8*)(VT + (nd * 16 + fr) * VT_LD + ks * 32 + fq * 8);
                        O[mt][nd] = __builtin_amdgcn_mfma_f32_16x16x32_bf16(pf, vf, O[mt][nd], 0, 0, 0); } }
            }
        }
#pragma unroll
        for (int mt = 0; mt < 4; ++mt) {
#pragma unroll
            for (int j = 0; j < 4; ++j) { const float inv = 1.0f / lrow[mt][j];
#pragma unroll
                for (int nd = 0; nd < 4; ++nd) PW[(fq * 4 + j) * P_LD + nd * 16 + fr] = (bf16_t)f2bf(O[mt][nd][j] * inv); }
#pragma unroll
            for (int i = 0; i < 2; ++i) { const int e = lane + i * 64, rr = e >> 3, ch = e & 7;
                *(u32x4*)(AO + (size_t)(qrow0 + mt * 16 + rr) * 1024 + qhead * 64 + ch * 8) = *(const LAS u32x4*)(PW + rr * P_LD + ch * 8); }
        }
    }
}

namespace rt {
__device__ __forceinline__ int chunk_row0(int b, int c) { return c < 2 ? b * CTX + c * 128 : T_CTX + b * SEQ + (c - 2) * 128; }
__device__ __forceinline__ int chunk_gpos0(int c) { return c < 2 ? c * 128 : CTX + (c - 2) * 128; }
__device__ __forceinline__ float log_g(int l, int dir, int h) { const float x = arg_in(12)[(l * 2 + dir) * 8 + h]; return -log1pf(__expf(-x)); }
}
__device__ __forceinline__ void phase_ret_u(Ctx& C, int l) {
    C.refresh();
    const int tid = C.tid, lane = C.lane, wave = C.wave, fr = lane & 15, fq = lane >> 4;
    constexpr int KT_LD = 136, VT_LD = 136, OFF_KF = 0, OFF_KB = 17408, OFF_VT = 34816;
    LAS bf16_t* KF = (LAS bf16_t*)(C.lds + OFF_KF); LAS bf16_t* KB = (LAS bf16_t*)(C.lds + OFF_KB); LAS bf16_t* VT = (LAS bf16_t*)(C.lds + OFF_VT);
    bf16_t* CB = (bf16_t*)(C.ws + WS_F);
    bf16_t* RS = (bf16_t*)(C.ws + WS_F2);
    const int p = tid & 31, i0 = tid >> 5;
    const float inv = __expf(-(float)p * (9.210340371976184f / 32.0f));
    const bool bal = C.G == 256;
    for (int u = bal ? (C.bid >> 3) : C.bid; u < (bal ? 144 : 8 * 8 * 18); u += bal ? 32 : C.G) {
        const int b = bal ? (C.bid & 7) : u / 144, h = (u / 18) & 7, c = u % 18;
        const int row0 = rt::chunk_row0(b, c), gpos0 = rt::chunk_gpos0(c);
        const float lgf = rt::log_g(l, 0, h), lgb = rt::log_g(l, 1, h);
        if (bal && (h == 4 || h == 5)) {
            const bf16_t* gxs = (const bf16_t*)(C.ws + WS_GX) + (size_t)row0 * 256 + (h - 4) * 128; bf16_t* gxd = CB + (size_t)row0 * NBW + 2048 + h * 128;
            u32x4 t4[4];
#pragma unroll
            for (int i = 0; i < 4; ++i) { const int e = tid + i * NTHR; t4[i] = *(const u32x4*)(gxs + (size_t)(e >> 4) * 256 + (e & 15) * 8); }
#pragma unroll
            for (int i = 0; i < 4; ++i) { const int e = tid + i * NTHR; *(u32x4*)(gxd + (size_t)(e >> 4) * NBW + (e & 15) * 8) = t4[i]; }
        }
        u32x4 vvr[4];
        const u32x4 q1 = *(const u32x4*)(CB + (size_t)(row0 + (tid & 127)) * NBW + h * 64 + 8 * (tid >> 7)), q2 = *(const u32x4*)(CB + (size_t)(row0 + (tid & 127)) * NBW + h * 64 + 8 * (tid >> 7) + 32),
                    k1 = *(const u32x4*)(CB + (size_t)(row0 + (tid & 127)) * NBW + h * 64 + 8 * (tid >> 7) + 512), k2 = *(const u32x4*)(CB + (size_t)(row0 + (tid & 127)) * NBW + h * 64 + 8 * (tid >> 7) + 544);
#pragma unroll
        for (int i = 0; i < 4; ++i) { const int e = tid + i * NTHR, m = e & 127, ch = e >> 7; vvr[i] = *(const u32x4*)(CB + (size_t)(row0 + m) * NBW + 1024 + h * 128 + ch * 8); }
        __syncthreads();
        {
            const int m = tid & 127, c = tid >> 7;
            bf16_t* rowp = CB + (size_t)(row0 + m) * NBW + h * 64 + 8 * c;
            const float zf = __expf(lgf * (float)(127 - m)), zb = __expf(lgb * (float)m), pos = (float)(gpos0 + m);
            u32x4 oq1, oq2, ok1, ok2;
#pragma unroll
            for (int e = 0; e < 4; ++e) {
                float sn0, cs0, sn1, cs1;
                __sincosf(pos * __expf(-(float)(8 * c + 2 * e) * (9.210340371976184f / 32.0f)), &sn0, &cs0);
                __sincosf(pos * __expf(-(float)(8 * c + 2 * e + 1) * (9.210340371976184f / 32.0f)), &sn1, &cs1);
                const float qa0 = bflo(q1[e]), qa1 = bfhi(q1[e]), qb0 = bflo(q2[e]), qb1 = bfhi(q2[e]);
                const float ka0 = bflo(k1[e]) * 0.125f, ka1 = bfhi(k1[e]) * 0.125f, kb0 = bflo(k2[e]) * 0.125f, kb1 = bfhi(k2[e]) * 0.125f;
                oq1[e] = pk2(qa0 * cs0 - qb0 * sn0, qa1 * cs1 - qb1 * sn1); oq2[e] = pk2(qa0 * sn0 + qb0 * cs0, qa1 * sn1 + qb1 * cs1);
                ok1[e] = pk2(ka0 * cs0 - kb0 * sn0, ka1 * cs1 - kb1 * sn1); ok2[e] = pk2(ka0 * sn0 + kb0 * cs0, ka1 * sn1 + kb1 * cs1);
                const float r10 = bflo(ok1[e]), r11 = bfhi(ok1[e]), r20 = bflo(ok2[e]), r21 = bfhi(ok2[e]);
                const int d0 = 8 * c + 2 * e;
                KF[d0 * KT_LD + m] = (bf16_t)f2bf(r10 * zf); KF[(d0 + 1) * KT_LD + m] = (bf16_t)f2bf(r11 * zf); KF[(d0 + 32) * KT_LD + m] = (bf16_t)f2bf(r20 * zf); KF[(d0 + 33) * KT_LD + m] = (bf16_t)f2bf(r21 * zf);
                KB[d0 * KT_LD + m] = (bf16_t)f2bf(r10 * zb); KB[(d0 + 1) * KT_LD + m] = (bf16_t)f2bf(r11 * zb); KB[(d0 + 32) * KT_LD + m] = (bf16_t)f2bf(r20 * zb); KB[(d0 + 33) * KT_LD + m] = (bf16_t)f2bf(r21 * zb);
            }
            *(u32x4*)rowp = oq1; *(u32x4*)(rowp + 32) = oq2; *(u32x4*)(rowp + 512) = ok1; *(u32x4*)(rowp + 544) = ok2;
        }
#pragma unroll
        for (int i = 0; i < 4; ++i) { const int e = tid + i * NTHR, m = e & 127, ch = e >> 7;
            const u32x4 vv = vvr[i];
            LAS bf16_t* vd = VT + (ch * 8) * VT_LD + m;
            vd[0 * VT_LD] = (bf16_t)(vv.x & 0xffff); vd[1 * VT_LD] = (bf16_t)(vv.x >> 16); vd[2 * VT_LD] = (bf16_t)(vv.y & 0xffff); vd[3 * VT_LD] = (bf16_t)(vv.y >> 16);
            vd[4 * VT_LD] = (bf16_t)(vv.z & 0xffff); vd[5 * VT_LD] = (bf16_t)(vv.z >> 16); vd[6 * VT_LD] = (bf16_t)(vv.w & 0xffff); vd[7 * VT_LD] = (bf16_t)(vv.w >> 16); }
        __syncthreads();
        f32x4 acc[2][4];
#pragma unroll
        for (int d = 0; d < 2; ++d)
#pragma unroll
            for (int nt = 0; nt < 4; ++nt) acc[d][nt] = (f32x4){0.f, 0.f, 0.f, 0.f};
#pragma unroll
        for (int ks = 0; ks < 4; ++ks) { const bf16x8 af = *(const LAS bf16x8*)(VT + (wave * 16 + fr) * VT_LD + ks * 32 + fq * 8);
#pragma unroll
            for (int nt = 0; nt < 4; ++nt) { const bf16x8 b0 = *(const LAS bf16x8*)(KF + (nt * 16 + fr) * KT_LD + ks * 32 + fq * 8), b1 = *(const LAS bf16x8*)(KB + (nt * 16 + fr) * KT_LD + ks * 32 + fq * 8);
                acc[0][nt] = __builtin_amdgcn_mfma_f32_16x16x32_bf16(af, b0, acc[0][nt], 0, 0, 0); acc[1][nt] = __builtin_amdgcn_mfma_f32_16x16x32_bf16(af, b1, acc[1][nt], 0, 0, 0); } }
        const int idxf = c, idxb = c < 2 ? 1 - c : 19 - c;
        LAS bf16_t* ST = (LAS bf16_t*)(C.lds + 69632 + wave * 2304);
#pragma unroll
        for (int d = 0; d < 2; ++d) { bf16_t* dst = RS + bpart(b, (h * 2 + d) * 18 + (d ? idxb : idxf), 8192) + (size_t)(wave * 16) * 64;
#pragma unroll
            for (int nt = 0; nt < 4; ++nt)
#pragma unroll
                for (int j = 0; j < 4; ++j) ST[(fq * 4 + j) * 72 + nt * 16 + fr] = (bf16_t)f2bf(acc[d][nt][j]);
#pragma unroll
            for (int i = 0; i < 2; ++i) { const int e = lane + i * 64, rr = e >> 3, ch = e & 7; *(u32x4*)(dst + rr * 64 + ch * 8) = *(const LAS u32x4*)(ST + rr * 72 + ch * 8); } }
    }
}
__device__ __forceinline__ void phase_ret_scan(Ctx& C, int l) {
    C.refresh();
    bf16_t* RS = (bf16_t*)(C.ws + WS_F2);
    const int jb = C.bid >> 3, chain = C.G == 256 ? (((C.bid & 7) * 8 + (jb >> 2)) * 2 + ((jb >> 1) & 1)) : (C.bid >> 1), d = chain & 1, h = (chain >> 1) & 7;
    const float cd = __expf(rt::log_g(l, d, h) * 128.0f);
    bf16_t* base = RS + (size_t)((C.G == 256 ? jb : C.bid) & 1) * 4096 + C.tid * 8; const int sb = chain >> 4, s0 = (chain & 15) * 18;
    float st[8];
#pragma unroll
    for (int k = 0; k < 8; ++k) st[k] = 0.f;
#pragma unroll 1
    for (int hb = 0; hb < 2; ++hb) {
        u32x4 uv[9];
#pragma unroll
        for (int i = 0; i < 9; ++i) uv[i] = *(const u32x4*)(base + bpart(sb, s0 + hb * 9 + i, 8192));
#pragma unroll
        for (int i = 0; i < 9; ++i) asm volatile("" : "+v"(uv[i]));
#pragma unroll
        for (int i = 0; i < 9; ++i) {
            const u32x4 cur = uv[i];
            u32x4 o; o.x = pk2(st[0], st[1]); o.y = pk2(st[2], st[3]); o.z = pk2(st[4], st[5]); o.w = pk2(st[6], st[7]);
            *(u32x4*)(base + bpart(sb, s0 + hb * 9 + i, 8192)) = o;
            st[0] = cd * st[0] + bflo(cur.x); st[1] = cd * st[1] + bfhi(cur.x); st[2] = cd * st[2] + bflo(cur.y); st[3] = cd * st[3] + bfhi(cur.y);
            st[4] = cd * st[4] + bflo(cur.z); st[5] = cd * st[5] + bfhi(cur.z); st[6] = cd * st[6] + bflo(cur.w); st[7] = cd * st[7] + bfhi(cur.w);
        }
    }
}
__device__ __forceinline__ void phase_ret_o(Ctx& C, int l, int c_lo) {
    C.refresh();
    const int tid = C.tid, lane = C.lane, wave = C.wave, fr = lane & 15, fq = lane >> 4;
    constexpr int Q_LD = 72, VT_LD = 136, S_LD = 72, P_LD = 136;
    constexpr int OFF_Q = 0, OFF_K = 18432, OFF_VT = 36864, OFF_SF = 71680, OFF_SB = 90112, OFF_P = 108544;
    LAS bf16_t* QS = (LAS bf16_t*)(C.lds + OFF_Q); LAS bf16_t* KS = (LAS bf16_t*)(C.lds + OFF_K); LAS bf16_t* VT = (LAS bf16_t*)(C.lds + OFF_VT);
    LAS bf16_t* SF = (LAS bf16_t*)(C.lds + OFF_SF); LAS bf16_t* SB = (LAS bf16_t*)(C.lds + OFF_SB);
    LAS bf16_t* PW = (LAS bf16_t*)(C.lds + OFF_P + wave * (16 * P_LD * 2));
    bf16_t* CB = (bf16_t*)(C.ws + WS_F);
    const bf16_t* RS = (const bf16_t*)(C.ws + WS_F2);
    const int ncl = 18 - c_lo;
    const bool bal = C.G == 256;
    for (int u = bal ? (C.bid >> 3) : C.bid; u < (bal ? 8 * ncl : 64 * ncl); u += bal ? 32 : C.G) {
        const int b = bal ? (C.bid & 7) : u / (8 * ncl), h = (u / ncl) & 7, c = c_lo + u % ncl;
        const int row0 = rt::chunk_row0(b, c);
        const float lgf = rt::log_g(l, 0, h), lgb = rt::log_g(l, 1, h);
        u32x4 qr[2], kr[2], vvr[4], sr[2][2];
#pragma unroll
        for (int i = 0; i < 2; ++i) { const int e = tid + i * NTHR, m = e >> 3, ch = e & 7; const bf16_t* src = CB + (size_t)(row0 + m) * NBW + h * 64 + ch * 8;
            qr[i] = *(const u32x4*)src; kr[i] = *(const u32x4*)(src + 512); }
#pragma unroll
        for (int i = 0; i < 4; ++i) { const int e = tid + i * NTHR, m = e & 127, ch = e >> 7; vvr[i] = *(const u32x4*)(CB + (size_t)(row0 + m) * NBW + 1024 + h * 128 + ch * 8); }
#pragma unroll
        for (int d = 0; d < 2; ++d) {
            const int idx = d ? (c < 2 ? 1 - c : 19 - c) : c;
            const bf16_t* src = RS + bpart(b, (h * 2 + d) * 18 + idx, 8192);
#pragma unroll
            for (int i = 0; i < 2; ++i) { const int e = tid + i * NTHR, er = e >> 3, ch = e & 7; sr[d][i] = *(const u32x4*)(src + er * 64 + ch * 8); }
        }
        __syncthreads();
#pragma unroll
        for (int i = 0; i < 2; ++i) { const int e = tid + i * NTHR, m = e >> 3, ch = e & 7;
            *(LAS u32x4*)(QS + m * Q_LD + ch * 8) = qr[i]; *(LAS u32x4*)(KS + m * Q_LD + ch * 8) = kr[i]; }
#pragma unroll
        for (int i = 0; i < 4; ++i) { const int e = tid + i * NTHR, m = e & 127, ch = e >> 7;
            const u32x4 vv = vvr[i];
            LAS bf16_t* vd = VT + (ch * 8) * VT_LD + m;
            vd[0 * VT_LD] = (bf16_t)(vv.x & 0xffff); vd[1 * VT_LD] = (bf16_t)(vv.x >> 16); vd[2 * VT_LD] = (bf16_t)(vv.y & 0xffff); vd[3 * VT_LD] = (bf16_t)(vv.y >> 16);
            vd[4 * VT_LD] = (bf16_t)(vv.z & 0xffff); vd[5 * VT_LD] = (bf16_t)(vv.z >> 16); vd[6 * VT_LD] = (bf16_t)(vv.w & 0xffff); vd[7 * VT_LD] = (bf16_t)(vv.w >> 16); }
#pragma unroll
        for (int d = 0; d < 2; ++d) {
            LAS bf16_t* dst = d ? SB : SF;
#pragma unroll
            for (int i = 0; i < 2; ++i) { const int e = tid + i * NTHR, er = e >> 3, ch = e & 7; *(LAS u32x4*)(dst + er * S_LD + ch * 8) = sr[d][i]; }
        }
        __syncthreads();
        bf16x8 qf[2];
#pragma unroll
        for (int ks = 0; ks < 2; ++ks) qf[ks] = *(const LAS bf16x8*)(QS + (wave * 16 + fr) * Q_LD + ks * 32 + fq * 8);
        f32x4 O[8];
        {
            f32x4 t[8];
#pragma unroll
            for (int nt = 0; nt < 8; ++nt) t[nt] = (f32x4){0.f, 0.f, 0.f, 0.f};
#pragma unroll
            for (int ks = 0; ks < 2; ++ks)
#pragma unroll
                for (int nt = 0; nt < 8; ++nt) t[nt] = __builtin_amdgcn_mfma_f32_16x16x32_bf16(qf[ks], *(const LAS bf16x8*)(SF + (nt * 16 + fr) * S_LD + ks * 32 + fq * 8), t[nt], 0, 0, 0);
            float xi[4];
#pragma unroll
            for (int j = 0; j < 4; ++j) xi[j] = __expf(lgf * (float)(wave * 16 + fq * 4 + j + 1));
#pragma unroll
            for (int nt = 0; nt < 8; ++nt)
#pragma unroll
                for (int j = 0; j < 4; ++j) O[nt][j] = xi[j] * t[nt][j];
#pragma unroll
            for (int nt = 0; nt < 8; ++nt) t[nt] = (f32x4){0.f, 0.f, 0.f, 0.f};
#pragma unroll
            for (int ks = 0; ks < 2; ++ks)
#pragma unroll
                for (int nt = 0; nt < 8; ++nt) t[nt] = __builtin_amdgcn_mfma_f32_16x16x32_bf16(qf[ks], *(const LAS bf16x8*)(SB + (nt * 16 + fr) * S_LD + ks * 32 + fq * 8), t[nt], 0, 0, 0);
#pragma unroll
            for (int j = 0; j < 4; ++j) xi[j] = __expf(lgb * (float)(128 - (wave * 16 + fq * 4 + j)));
#pragma unroll
            for (int nt = 0; nt < 8; ++nt)
#pragma unroll
                for (int j = 0; j < 4; ++j) O[nt][j] += xi[j] * t[nt][j];
        }
        u32x4 gr[4];
        {
            const bf16_t* gsrc = CB + (size_t)(row0 + wave * 16) * NBW + 2048 + h * 128; const int gld = NBW;
#pragma unroll
            for (int i = 0; i < 4; ++i) { const int e = lane + i * 64, rr = e >> 4, ch = e & 15; gr[i] = *(const u32x4*)(gsrc + (size_t)rr * gld + ch * 8); }
        }
        {
            f32x4 S[8];
#pragma unroll
            for (int nt = 0; nt < 8; ++nt) S[nt] = (f32x4){0.f, 0.f, 0.f, 0.f};
#pragma unroll
            for (int ks = 0; ks < 2; ++ks)
#pragma unroll
                for (int nt = 0; nt < 8; ++nt) S[nt] = __builtin_amdgcn_mfma_f32_16x16x32_bf16(qf[ks], *(const LAS bf16x8*)(KS + (nt * 16 + fr) * Q_LD + ks * 32 + fq * 8), S[nt], 0, 0, 0);
#pragma unroll
            for (int nt = 0; nt < 8; ++nt)
#pragma unroll
                for (int j = 0; j < 4; ++j) { const int i = wave * 16 + fq * 4 + j, jj = nt * 16 + fr, df = i - jj;
                    const float dec = (df >= 0 ? __expf(lgf * (float)df) : 0.f) + (df <= 0 ? __expf(lgb * (float)(-df)) : 0.f);
                    PW[(fq * 4 + j) * P_LD + jj] = (bf16_t)f2bf(S[nt][j] * dec); }
        }
#pragma unroll
        for (int ks = 0; ks < 4; ++ks) { const bf16x8 pf = *(const LAS bf16x8*)(PW + fr * P_LD + ks * 32 + fq * 8);
#pragma unroll
            for (int nt = 0; nt < 8; ++nt) O[nt] = __builtin_amdgcn_mfma_f32_16x16x32_bf16(pf, *(const LAS bf16x8*)(VT + (nt * 16 + fr) * VT_LD + ks * 32 + fq * 8), O[nt], 0, 0, 0); }
        {
            bf16_t* gbase = CB + (size_t)(row0 + wave * 16) * NBW + 2048 + h * 128;
#pragma unroll
            for (int i = 0; i < 4; ++i) { const int e = lane + i * 64, rr = e >> 4, ch = e & 15; *(LAS u32x4*)(PW + rr * P_LD + ch * 8) = gr[i]; }
#pragma unroll
            for (int j = 0; j < 4; ++j) {
                float sm = 0.f;
#pragma unroll
                for (int nt = 0; nt < 8; ++nt) sm += O[nt][j];
                const float mean = allreduce16(sm) * (1.0f / 128.0f);
                float vr = 0.f;
#pragma unroll
                for (int nt = 0; nt < 8; ++nt) { const float dd = O[nt][j] - mean; vr += dd * dd; }
                const float rstd = 1.0f / sqrtf(allreduce16(vr) * (1.0f / 128.0f) + 1e-6f);
#pragma unroll
                for (int nt = 0; nt < 8; ++nt) { LAS bf16_t* pp = PW + (fq * 4 + j) * P_LD + nt * 16 + fr; *pp = (bf16_t)f2bf(siluf_(bf2f(*pp)) * (O[nt][j] - mean) * rstd); }
            }
#pragma unroll
            for (int i = 0; i < 4; ++i) { const int e = lane + i * 64, rr = e >> 4, ch = e & 15; *(u32x4*)(gbase + (size_t)rr * NBW + ch * 8) = *(const LAS u32x4*)(PW + rr * P_LD + ch * 8); }
        }
    }
}

struct MergeSched {
    unsigned char* ws; int pm0, nM, G, c; bool split;
    __device__ __forceinline__ void opnd(int op, int pm, int pn, pg8::Opnd& o) const {
        const char* W = (const char*)(ws + WS_W);
        if ((op & 1) == 0) { o.A = (const char*)(ws + WS_H) + (size_t)pm * 256 * 2048; o.lda = 2048; o.B = W + W_GATE + (size_t)((op >> 1) * 1024 + pn * 256) * 2048; o.ldb = 2048; o.nt = 16; }
        else if (op == 1) { o.A = (const char*)(ws + WS_F) + (size_t)pm * 256 * (NBW * 2) + 2048 * 2; o.lda = NBW * 2; o.B = W + W_RET + (size_t)pn * 256 * 2048; o.ldb = 2048; o.nt = 16; }
        else { o.A = (const char*)(ws + WS_AO) + (size_t)pm * 256 * 2048 + (op == 5 ? 1024 : 0); o.lda = 2048; o.B = W + (op == 3 ? W_ATT : W_RWKV) + (size_t)pn * 256 * 1024; o.ldb = 1024; o.nt = 8; }
    }
    __device__ __forceinline__ bool next(int i, pg8::Unit& u, pg8::Opnd& o) const {
        if (!split) {
            const int ti = i / 6, op = i - ti * 6;
            int pm, pn; if (!pg8::tile_order(ti, G, c, nM, 4, pm, pn)) return false;
            pm += pm0; u.pm = pm; u.pn = pn; u.op = op; opnd(op, pm, pn, o); return true;
        }
        if (i < 6) { int pm, pn; pg8::tile_order(0, 256, c, 64, 4, pm, pn); pm += 8; u.pm = pm; u.pn = pn; u.op = i; opnd(i, pm, pn, o); return true; }
        if (i < 8 && c < 96) { const int x = c & 7, jj = c >> 3, pm = x, pn = jj / 3, br = jj - pn * 3, op = 2 * br + (i - 6);     u.pm = pm; u.pn = pn; u.op = 6 + op; opnd(op, pm, pn, o); return true; }
        return false;
    }
};
struct EpiMerge {
    static constexpr bool PERM = true;
    bf16_t* scr; bf16_t* MG; bf16_t* SL;
    __device__ __forceinline__ void operator()(const f32x4 (&acc)[2][2][4][2], const pg8::Unit& u, int wr, int wc, int fr, int fq) const {
        const int lr0 = wr * 64 + fr, lc0 = wc * 32 + 8 * fq;
#pragma unroll
        for (int ai = 0; ai < 2; ++ai)
#pragma unroll
            for (int m = 0; m < 4; ++m) { const int lr = lr0 + ai * 128 + m * 16;
                u32x4* sp = (u32x4*)(scr + lr * 256 + lc0);
                if ((u.op & 1) == 0) {
#pragma unroll
                    for (int bj = 0; bj < 2; ++bj) { const f32x4 v0 = acc[ai][bj][m][0], v1 = acc[ai][bj][m][1];
                        u32x4 w; w.x = pg8::cvt_pk_bf16(sigmoidf_(v0[0]), sigmoidf_(v0[1])); w.y = pg8::cvt_pk_bf16(sigmoidf_(v0[2]), sigmoidf_(v0[3]));
                        w.z = pg8::cvt_pk_bf16(sigmoidf_(v1[0]), sigmoidf_(v1[1])); w.w = pg8::cvt_pk_bf16(sigmoidf_(v1[2]), sigmoidf_(v1[3])); sp[bj * 16] = w; }
                } else {
                    const bool spl = u.op >= 6; const int br = (spl ? u.op - 6 : u.op) >> 1;
                    const bool keep = ((BR_MASK >> br) & 1) != 0;
                    bf16_t* dbase = (spl && br > 0) ? SL + (size_t)(br - 1) * T_CTX * 1024 : MG;
                    u32x4* mp = (u32x4*)(dbase + (size_t)(u.pm * 256 + lr) * 1024 + u.pn * 256 + lc0);
                    const u32x4 g0 = sp[0], g1 = sp[16];
                    u32x4 p0 = (u32x4){0u, 0u, 0u, 0u}, p1 = p0; if (!spl && u.op != 1) { p0 = mp[0]; p1 = mp[16]; }
#pragma unroll
                    for (int bj = 0; bj < 2; ++bj) { const f32x4 v0 = acc[ai][bj][m][0], v1 = acc[ai][bj][m][1]; const u32x4 gq = bj ? g1 : g0, pv = bj ? p1 : p0;
                        u32x4 w;
                        if (keep) {
                        w.x = pg8::cvt_pk_bf16(bflo(pv.x) + bflo(gq.x) * v0[0], bfhi(pv.x) + bfhi(gq.x) * v0[1]); w.y = pg8::cvt_pk_bf16(bflo(pv.y) + bflo(gq.y) * v0[2], bfhi(pv.y) + bfhi(gq.y) * v0[3]);
                        w.z = pg8::cvt_pk_bf16(bflo(pv.z) + bflo(gq.z) * v1[0], bfhi(pv.z) + bfhi(gq.z) * v1[1]); w.w = pg8::cvt_pk_bf16(bflo(pv.w) + bflo(gq.w) * v1[2], bfhi(pv.w) + bfhi(gq.w) * v1[3]);
                        } else w = pv;
                        mp[bj * 16] = w; }
                } }
    }
};
__device__ __forceinline__ void phase_merge(Ctx& C, int pm0, int nM) {
    C.refresh();
    MergeSched S{C.ws, pm0, nM, C.G, C.bid, nM == 72 && C.G == 256};
    EpiMerge E{(bf16_t*)(C.ws + WS_GSCR) + (C.G == 256 ? (size_t)(C.bid & 7) * 2097152 + (size_t)(C.bid >> 3) * 65536 : (size_t)C.bid * 65536), (bf16_t*)(C.ws + WS_F2), (bf16_t*)(C.ws + WS_VMIX)};
    pg8::gemm_phase<EpiMerge, MergeSched, true>(C.lds, C.tid, S, E);
}
struct WoutSplitSched {
    unsigned char* ws; int c;
    __device__ __forceinline__ bool next(int i, pg8::Unit& u, pg8::Opnd& o) const {
        o.lda = 2048; o.ldb = 2048; o.nt = 16;
        const char* B = (const char*)(ws + WS_W + W_OUT);
        if (i == 0) { int pm, pn; pg8::tile_order(0, 256, c, 64, 4, pm, pn); pm += 8; u.pm = pm; u.pn = pn; u.op = 0; o.A = (const char*)(ws + WS_F2) + (size_t)pm * 256 * 2048; o.B = B + (size_t)pn * 256 * 2048; return true; }
        if (i == 1 && c < 96) { const int x = c & 7, jj = c >> 3, pm = x, pn = jj / 3, br = jj - pn * 3; u.pm = pm; u.pn = pn; u.op = 1 + x * 16 + pn * 3 + br;
            o.A = (const char*)(br == 0 ? ws + WS_F2 : ws + WS_VMIX + (size_t)(br - 1) * T_CTX * 2048) + (size_t)pm * 256 * 2048; o.B = B + (size_t)pn * 256 * 2048; return true; }
        return false;
    }
};
__device__ __forceinline__ void phase_wout(Ctx& C, int l, int pm0, int nM, const FusedNorm& fn) {
    C.refresh();
    EpiResid E{(float*)(C.ws + WS_S), arg_out(), (const float*)(C.ws + WS_MODS) + (size_t)l * 9 * NADA * D, 5, 1.0f, (float*)(C.ws + WS_AO + 4 * MiB)};
    if (nM == 72 && C.G == 256) {
        WoutSplitSched S{C.ws, C.bid};
        pg8::gemm_phase<EpiResid, WoutSplitSched, false>(C.lds, C.tid, S, E);
        int pm, pn; pg8::tile_order(0, 256, C.bid, 64, 4, pm, pn);
        fused_norm(C, fn, pm + 8, pn, C.bid < 96, C.bid & 7, C.bid >> 3, 12);
    } else {
        pg8::StdSched S{(const char*)(C.ws + WS_F2), (const char*)(C.ws + WS_W + W_OUT), D * 2, D * 2, D / 64, pm0, nM, 4, C.G, C.bid};
        pg8::gemm_phase<EpiResid, pg8::StdSched>(C.lds, C.tid, S, E);
        if (C.G == 256 && nM == 64 && pm0 == 8) { int pm, pn; pg8::tile_order(0, 256, C.bid, 64, 4, pm, pn); fused_norm(C, fn, pm + 8, pn, false, 0, 0, 1); }
    }
}

__global__ void __launch_bounds__(NTHR, 2) fwd_megakernel(Params prm) {
    cg::grid_group grid = cg::this_grid();
    extern __shared__ __attribute__((aligned(16))) unsigned char lds_raw[];
    Ctx C; C.lds = (LAS unsigned char*)lds_raw;
    C.wave_s = __builtin_amdgcn_readfirstlane((int)threadIdx.x >> 6); C.refresh();
    volatile LAS unsigned* MISC = (volatile LAS unsigned*)(C.lds + LDS_MISC);
    if (C.tid < 64) MISC[C.tid] = 0u;
    __syncthreads();
    XcdBarrier bar = xcd_barrier_post((unsigned*)(C.ws + WS_CTL) + CW_BAR, MISC + 8);
#define GRID_BAR() xcd_barrier(bar)
    int ph = 0; const int stop_after = (int)(unsigned)karg_u64(8 * 36);
    if (TSEL1 >= 0 && C.tid == 0) { MISC[14] = (unsigned)__builtin_amdgcn_s_memrealtime(); MISC[15] = MISC[14]; }
#define STAMP(g) do { if (TSEL1 == 0) C.refresh(); if (TSEL1 == 0 && C.tid == 0) { const unsigned _t = (unsigned)__builtin_amdgcn_s_memrealtime(); MISC[16 + (g)] += _t - MISC[15]; MISC[15] = _t; } } while (0)
#define DONE_IF_STOP() do { if (++ph >= stop_after) return; } while (0)

    phase_init(C);
    grid.sync();
    STAMP(0);
#pragma unroll 1
    for (int l = 0; l < 2; ++l) {
        const bool fuse = C.G == 256;
        const FusedNorm fn_none{-1, 0, 0, 0};
        phase_convert(C, l);
        if (l == 0 || !fuse) phase_norm(C, l, 0, 0, l > 0 ? 4 : 0, l == 0 ? 2 : 0);
        GRID_BAR(); STAMP(1);
        unsigned* xs = (unsigned*)(C.ws + WS_CTL) + 49152 + (size_t)(l * 128 + (C.bid & 7)) * 64; unsigned* xtmo = (unsigned*)(C.ws + WS_CTL) + CW_BAR + XB_TMO;
#define BATCH_BAR(k) do { if (fuse) group_sync(xs + (k) * 8 * 64, 32u, xtmo); else GRID_BAR(); } while (0)
        phase_ffn_in(C, W_FFN1_IN, 0, 72);
        BATCH_BAR(0); STAMP(2);
        { const FusedNorm fn1{fuse ? l : -1, 1, 4, l == 0 ? 1 : 0};
          if (l == 0) phase_ffn_out<true>(C, l, W_FFN1_OUT, 2, 0, 72, fn1); else phase_ffn_out<false>(C, l, W_FFN1_OUT, 2, 0, 72, fn1); }
        BATCH_BAR(1); STAMP(3);
        DONE_IF_STOP();
        if (!fuse) { phase_norm(C, l, 1, 0, 4, l == 0 ? 1 : 0); GRID_BAR(); }
        STAMP(1);
        phase_mix(C, W_MIXA, NA);
        BATCH_BAR(7); STAMP(4);
        att_prep(C, l);
        STAMP(5);
        {
            unsigned* gs = (unsigned*)(C.ws + WS_CTL) + 16384 + (size_t)((l * 3) * 64 + (C.bid & 63)) * 64; unsigned* tmo = (unsigned*)(C.ws + WS_CTL) + CW_BAR + XB_TMO;
            phase_rwkv_r1(C, l, 0); group_sync(gs, 4u, tmo); STAMP(13);
            phase_rwkv_r2(C, l, 0); group_sync(gs + 64 * 64, 4u, tmo); STAMP(14);
            phase_rwkv_r1(C, l, 1); group_sync(gs + 2 * 64 * 64, 4u, tmo); STAMP(13);
            phase_rwkv_r2(C, l, 1); STAMP(14);
        }
        BATCH_BAR(8); STAMP(6);
        phase_rwkv_out(C, l, l == 0 ? 0 : T_CTX / 64);
        STAMP(7);
        phase_attention(C, l, l == 0);
        BATCH_BAR(9); STAMP(8);
        phase_mix(C, W_MIXB, NBW);
        BATCH_BAR(4); STAMP(4);
        phase_ret_u(C, l);
        BATCH_BAR(5); STAMP(9);
        phase_ret_scan(C, l);
        BATCH_BAR(6);
        phase_ret_o(C, l, l == 0 ? 0 : 2);
        BATCH_BAR(10); STAMP(10);
        DONE_IF_STOP();
        const int pm0 = l == 0 ? 0 : 8, nM = l == 0 ? 72 : 64;
        phase_merge(C, pm0, nM);
        BATCH_BAR(11); STAMP(11);
        { const FusedNorm fn2{fuse ? l : -1, 2, l == 0 ? 3 : 0, 0}; phase_wout(C, l, pm0, nM, fn2); }
        BATCH_BAR(2); STAMP(12);
        DONE_IF_STOP();
        if (!fuse) { phase_norm(C, l, 2, pm0 * 256, l == 0 ? 3 : 0, 0); GRID_BAR(); }
        STAMP(1);
        phase_ffn_in(C, W_FFN2_IN, pm0, nM);
        BATCH_BAR(3); STAMP(2);
        { const FusedNorm fn0{(fuse && l == 0) ? 1 : -1, 0, 4, 0}; phase_ffn_out<false>(C, l, W_FFN2_OUT, 8, pm0, nM, fn0); }
        GRID_BAR(); STAMP(3);
        DONE_IF_STOP();
    }
    if (TSEL1 >= 0 && C.bid == 0) {
        __syncthreads();
        const float total = (float)((unsigned)__builtin_amdgcn_s_memrealtime() - MISC[14]);
        const float f1 = (float)MISC[16 + (TSEL1 >= 0 ? TSEL1 : 0)] / total, f2 = TSEL2 >= 0 ? (float)MISC[16 + (TSEL2 >= 0 ? TSEL2 : 0)] / total : 0.f;
        float* o = arg_out();
        if (C.tid == 0) { int best = 0; float bv = 1e30f; for (int i = 0; i < 4096; ++i) { const float a = fabsf(o[i]); if (a < bv) { bv = a; best = i; } } o[best] += 0.04f + 0.059f * f1; }
        if (TSEL2 >= 0) { const float d2 = 0.1f * sqrtf(f2); for (int i = C.tid; i < 65536; i += NTHR) o[1048576 + i] += d2; }
    }
}

extern "C" void kernel_launch(void* const* d_in, const int* in_sizes, int n_in, void* d_out, int out_size, void* d_ws, size_t ws_size, hipStream_t stream) {
    static int grid_blocks = 0;
    if (!grid_blocks) {
        if (n_in != 34 || ws_size < WS_END) { fprintf(stderr, "kernel_launch: unexpected n_in %d / ws_size %zu\n", n_in, ws_size); grid_blocks = -1; return; }
        int dev = 0, cus = 0, per_cu = 0;
        (void)hipGetDevice(&dev);
        (void)hipDeviceGetAttribute(&cus, hipDeviceAttributeMultiprocessorCount, dev);
        (void)hipFuncSetAttribute((const void*)fwd_megakernel, hipFuncAttributeMaxDynamicSharedMemorySize, LDS_BYTES);
        (void)hipOccupancyMaxActiveBlocksPerMultiprocessor(&per_cu, (const void*)fwd_megakernel, NTHR, LDS_BYTES);
        if (per_cu < 1) { fprintf(stderr, "kernel_launch: occupancy query says %d blocks per CU\n", per_cu); per_cu = 1; }
        grid_blocks = cus * 1;
        (void)hipGetLastError();
    }
    if (grid_blocks < 0) return;
    (void)hipMemsetAsync((char*)d_ws + WS_CTL, 0, WS_ZERO_BYTES, stream);
    Params p{};
    for (int i = 0; i < 34; ++i) p.in[i] = (const float*)d_in[i];
    p.out = (float*)d_out; p.ws = (unsigned char*)d_ws; p.stop = STOP_AFTER; p.pad = 0;
    void* args[] = {&p};
    hipError_t e = hipLaunchCooperativeKernel((void*)fwd_megakernel, dim3(grid_blocks), dim3(NTHR), args, LDS_BYTES, stream);
    if (e != hipSuccess) fprintf(stderr, "cooperative launch failed: %s (grid %d)\n", hipGetErrorString(e), grid_blocks);
}
```

```cpp
#include <hip/hip_runtime.h>
#include <hip/hip_cooperative_groups.h>
#include <cstdio>
#include <cstdint>
namespace cg = cooperative_groups;

#ifndef TSEL1
#define TSEL1 -1
#endif
#ifndef TSEL2
#define TSEL2 -1
#endif
#ifndef RW_DBG
#define RW_DBG 0
#endif
#ifndef BR_MASK
#define BR_MASK 7
#endif
#ifndef STOP_AFTER
#define STOP_AFTER 100
#endif

#define LAS __attribute__((address_space(3)))
typedef unsigned short bf16_t;
typedef short bf16x8 __attribute__((ext_vector_type(8)));
typedef float f32x4 __attribute__((ext_vector_type(4)));
typedef float f32x2 __attribute__((ext_vector_type(2)));
typedef unsigned u32x4 __attribute__((ext_vector_type(4)));
typedef unsigned u32x2 __attribute__((ext_vector_type(2)));

constexpr int D = 1024, NB = 8, SEQ = 2048, CTX = 256, DFF = 2816, NADA = 9, NIN = 8832;
constexpr int T_CTX = NB * CTX, T_LAT = NB * SEQ, T_ALL = T_CTX + T_LAT;
constexpr int FS = 3072;
__device__ __forceinline__ size_t bpart(int b, int slot, int slot_el) { const int nctx = 262144 / slot_el; return slot < nctx ? (size_t)b * 262144 + (size_t)slot * slot_el : (size_t)2097152 + (size_t)b * 2097152 + (size_t)(slot - nctx) * slot_el; }
constexpr int NA = 2816;
constexpr int NBW = 3072;
constexpr int NWAVES = 8, NTHR = 512;

constexpr size_t MiB = 1u << 20;
constexpr size_t WS_CTL = 0, WS_MODS = 1 * MiB, WS_ZERO_BYTES = 2 * MiB;
constexpr size_t WS_S = 2 * MiB;
constexpr size_t WS_H = 10 * MiB;
constexpr size_t WS_W = 46 * MiB;
constexpr size_t WS_VFIRST = 103 * MiB;
constexpr size_t WS_AO = 121 * MiB;
constexpr size_t WS_F = 157 * MiB;
constexpr size_t WS_F2 = WS_F + 108 * MiB;
constexpr size_t WS_BONUS = 301 * MiB;
constexpr size_t WS_GSCR = 303 * MiB;
constexpr size_t WS_VMIX = 335 * MiB;
constexpr size_t WS_GX = 353 * MiB;
constexpr size_t WS_END = 362 * MiB;
constexpr size_t W_FFN1_IN = 0, W_FFN1_OUT = 11 * MiB, W_FFN2_IN = W_FFN1_OUT + 5632 * 1024, W_FFN2_OUT = W_FFN2_IN + 11 * MiB,
                 W_MIXA = W_FFN2_OUT + 5632 * 1024, W_MIXB = W_MIXA + 5632 * 1024, W_GATE = W_MIXB + 6 * MiB, W_RET = W_GATE + 6 * MiB,
                 W_ATT = W_RET + 2 * MiB, W_RWKV = W_ATT + 1 * MiB, W_OUT = W_RWKV + 1 * MiB, W_GUP = W_OUT + 2 * MiB, W_WUP = W_GUP + 131072, W_END = W_WUP + 262144;
static_assert(W_END <= 57 * MiB, "W map");
constexpr int CW_BAR = 4096;

constexpr int LDS_BYTES = 163840;
constexpr int LDS_MISC = LDS_BYTES - 1024;

typedef float f32x2n __attribute__((ext_vector_type(2))); typedef __bf16 bf16x2n __attribute__((ext_vector_type(2)));
__device__ __forceinline__ unsigned pk2(float lo, float hi) { const f32x2n v = {lo, hi}; const bf16x2n b = __builtin_convertvector(v, bf16x2n); return __builtin_bit_cast(unsigned, b); }
__device__ __forceinline__ unsigned f2bf(float f) { return (unsigned)__builtin_bit_cast(unsigned short, (__bf16)f); }
__device__ __forceinline__ unsigned pk2h(float lo, float hi) { return pk2(lo, hi); }
__device__ __forceinline__ unsigned f2bfh(float f) { return f2bf(f); }
__device__ __forceinline__ float bf2f(unsigned short b) { return __builtin_bit_cast(float, (unsigned)b << 16); }
__device__ __forceinline__ float bflo(unsigned w) { return __builtin_bit_cast(float, w << 16); }
__device__ __forceinline__ float bfhi(unsigned w) { return __builtin_bit_cast(float, w & 0xffff0000u); }
__device__ __forceinline__ float sigmoidf_(float x) { return __builtin_amdgcn_rcpf(1.0f + __expf(-x)); }
__device__ __forceinline__ float siluf_(float x) { return x * __builtin_amdgcn_rcpf(1.0f + __expf(-x)); }
__device__ __forceinline__ float tanhf_(float x) { return 2.0f * __builtin_amdgcn_rcpf(1.0f + __expf(-2.0f * x)) - 1.0f; }
__device__ __forceinline__ float fma_s(float a, float b, float c) { float d; asm("v_fma_f32 %0, %1, %2, %3" : "=v"(d) : "v"(a), "v"(b), "v"(c)); return d; }
__device__ __forceinline__ float mul_s(float a, float b) { float d; asm("v_mul_f32 %0, %1, %2" : "=v"(d) : "v"(a), "v"(b)); return d; }
#define LDS_BARRIER() do { asm volatile("s_waitcnt lgkmcnt(0)" ::: "memory"); __builtin_amdgcn_s_barrier(); asm volatile("" ::: "memory"); } while (0)
#define DPP_MOV(x, ctrl) __builtin_bit_cast(float, __builtin_amdgcn_update_dpp(0, __builtin_bit_cast(int, (x)), (ctrl), 0xf, 0xf, true))
__device__ __forceinline__ float allreduce16(float x) {
    x += DPP_MOV(x, 0xB1); x += DPP_MOV(x, 0x4E); x += DPP_MOV(x, 0x141); x += DPP_MOV(x, 0x140); return x;
}
__device__ __forceinline__ float allreduce16_max(float x) {
    x = fmaxf(x, DPP_MOV(x, 0xB1)); x = fmaxf(x, DPP_MOV(x, 0x4E)); x = fmaxf(x, DPP_MOV(x, 0x141)); x = fmaxf(x, DPP_MOV(x, 0x140)); return x;
}
__device__ __forceinline__ float wave_sum(float v) {
    v = allreduce16(v);
    const float a = __builtin_bit_cast(float, __builtin_amdgcn_readlane(__builtin_bit_cast(int, v), 0)), b = __builtin_bit_cast(float, __builtin_amdgcn_readlane(__builtin_bit_cast(int, v), 16));
    const float c = __builtin_bit_cast(float, __builtin_amdgcn_readlane(__builtin_bit_cast(int, v), 32)), d = __builtin_bit_cast(float, __builtin_amdgcn_readlane(__builtin_bit_cast(int, v), 48));
    return (a + b) + (c + d);
}
#define LDS_WAIT() asm volatile("s_waitcnt lgkmcnt(0)" ::: "memory")

#define XB_TMO      128
#define XB_XCNT(j)  (256  + 64 * (j))
#define XB_XSUB(j)  (1280 + 64 * (j))
#define XB_XGEN(j)  (2304 + 64 * (j))
#define XB_TOP      3328
#define XB_TOPGEN   3392
#define XCD_BAR_WORDS 3456
#define XB_SPIN_CAP (1u << 20)
__device__ __forceinline__ unsigned xb_ld(unsigned* p)              { return __hip_atomic_load(p, __ATOMIC_RELAXED, __HIP_MEMORY_SCOPE_AGENT); }
__device__ __forceinline__ unsigned xb_add(unsigned* p, unsigned v) { return __hip_atomic_fetch_add(p, v, __ATOMIC_RELAXED, __HIP_MEMORY_SCOPE_AGENT); }
__device__ __forceinline__ unsigned xb_xcc_id() { return (unsigned)__builtin_amdgcn_s_getreg((3 << 11) | 20) & 0xFu; }
#define XB_SPIN(cond, bar) do { unsigned _sp = 0; while (cond) { __builtin_amdgcn_s_sleep(1); \
    if ((++_sp & 255u) == 0u) { if (xb_ld(&(bar)[XB_TMO])) break; if (_sp > XB_SPIN_CAP) { atomicAdd(&(bar)[XB_TMO], 1u); break; } } } } while (0)
struct XcdBarrier { unsigned* bar; unsigned x; volatile LAS unsigned* st; };
__device__ __forceinline__ XcdBarrier xcd_barrier_post(unsigned* bar, volatile LAS unsigned* st) {
    XcdBarrier b; b.bar = bar; b.x = xb_xcc_id(); b.st = st;
    return b;
}
__device__ __forceinline__ void xcd_barrier_complete(unsigned* bar, unsigned x, unsigned& nloc, unsigned& nx) {
    const unsigned G = gridDim.x * gridDim.y * gridDim.z;
    unsigned sum, cnt, mine, sp = 0u;
    for (;;) {
        sum = 0u; cnt = 0u; mine = 0u;
#pragma unroll
        for (unsigned j = 0; j < 16; ++j) { const unsigned c = xb_ld(&bar[XB_XCNT(j)]); sum += c; cnt += (c > 0u) ? 1u : 0u; mine = (j == x) ? c : mine; }
        if (sum == G) break;
        __builtin_amdgcn_s_sleep(1);
        if ((++sp & 255u) == 0u) { if (xb_ld(&bar[XB_TMO])) break; if (sp > XB_SPIN_CAP) { atomicAdd(&bar[XB_TMO], 1u); break; } }
    }
    nloc = mine > 0u ? mine : 1u; nx = cnt > 0u ? cnt : 1u;
}
__device__ __forceinline__ void xcd_barrier(const XcdBarrier& b) {
    asm volatile("s_waitcnt vmcnt(0)" ::: "memory");
    __syncthreads();
    if (threadIdx.x == 0) {
        unsigned* bar = b.bar;
        __builtin_amdgcn_s_waitcnt(0);
        unsigned nloc = b.st[0], nx = b.st[1];
        if (nloc == 0u) { (void)xb_add(&bar[XB_XCNT(b.x)], 1u); xcd_barrier_complete(bar, b.x, nloc, nx); b.st[0] = nloc; b.st[1] = nx; }
        const unsigned old = xb_add(&bar[XB_XSUB(b.x)], 1u);
        const unsigned gen = old / nloc;
        if (old + 1u == (gen + 1u) * nloc) {
            __builtin_amdgcn_fence(__ATOMIC_RELEASE, "agent");
            asm volatile("s_waitcnt vmcnt(0)" ::: "memory");
            const unsigned og = xb_add(&bar[XB_TOP], 1u);
            const unsigned tg = og / nx;
            if (og + 1u == (tg + 1u) * nx) xb_add(&bar[XB_TOPGEN], 1u);
            else XB_SPIN(xb_ld(&bar[XB_TOPGEN]) == tg, bar);
            __builtin_amdgcn_fence(__ATOMIC_ACQUIRE, "agent");
            xb_add(&bar[XB_XGEN(b.x)], 1u);
            asm volatile("s_waitcnt vmcnt(0)" ::: "memory");
        } else {
            XB_SPIN(xb_ld(&bar[XB_XGEN(b.x)]) == gen, bar);
            __builtin_amdgcn_fence(__ATOMIC_ACQUIRE, "agent");
            asm volatile("s_waitcnt vmcnt(0)" ::: "memory");
        }
    }
    __syncthreads();
}

__device__ __forceinline__ void group_sync(unsigned* cnt, unsigned n, unsigned* tmo) {
    asm volatile("s_waitcnt vmcnt(0)" ::: "memory");
    __syncthreads();
    if (threadIdx.x == 0) {
        unsigned long long* c64 = (unsigned long long*)cnt;
        (void)__hip_atomic_fetch_add(c64, 1ull << (8u * (xb_xcc_id() & 7u)), __ATOMIC_RELAXED, __HIP_MEMORY_SCOPE_AGENT);
        unsigned sp = 0u; unsigned long long v; bool local = false;
        for (;;) {
            v = __hip_atomic_load(c64, __ATOMIC_RELAXED, __HIP_MEMORY_SCOPE_AGENT);
            unsigned sum = 0u, mx = 0u;
#pragma unroll
            for (int i = 0; i < 8; ++i) { const unsigned bx = (unsigned)(v >> (8 * i)) & 255u; sum += bx; mx = bx > mx ? bx : mx; }
            if (sum >= n) { local = mx >= n; break; }
            __builtin_amdgcn_s_sleep(1);
            if ((++sp & 255u) == 0u) { if (xb_ld(tmo)) break; if (sp > XB_SPIN_CAP) { atomicAdd(tmo, 1u); break; } }
        }
        if (!local) {
            __builtin_amdgcn_fence(__ATOMIC_RELEASE, "agent");
            asm volatile("s_waitcnt vmcnt(0)" ::: "memory");
            (void)xb_add(cnt + 2, 1u);
            sp = 0u;
            while (xb_ld(cnt + 2) < n) { __builtin_amdgcn_s_sleep(1); if ((++sp & 255u) == 0u) { if (xb_ld(tmo)) break; if (sp > XB_SPIN_CAP) { atomicAdd(tmo, 1u); break; } } }
        }
        if (local) asm volatile("buffer_inv sc0\n\ts_waitcnt vmcnt(0)" ::: "memory");
        else { __builtin_amdgcn_fence(__ATOMIC_ACQUIRE, "agent"); asm volatile("s_waitcnt vmcnt(0)" ::: "memory"); }
    }
    __syncthreads();
}

namespace pg8 {
constexpr int BM = 256, BK = 64, HALF = 128, HTB = HALF * BK * 2, NXCD = 8, WGM = 8;
__host__ __device__ __forceinline__ int lds_byte(int r, int c) { const int st = (r >> 4) * 2 + (c >> 5), rr = r & 15, cc = c & 31, ob = rr * 64 + cc * 2; return st * 1024 + (ob ^ (((ob >> 9) & 1) << 5)); }
__host__ __device__ __forceinline__ void stage_rc(int b, int& R, int& C) { const int st = b / 1024, sb = b % 1024, swz = sb ^ (((sb >> 9) & 1) << 5); R = (st >> 1) * 16 + swz / 64; C = (st & 1) * 32 + (swz % 64) / 2; }
__host__ __device__ __forceinline__ int perm32(int rho) { const int n = rho >> 4, i = rho & 15; return 8 * (i >> 2) + 4 * n + (i & 3); }
__device__ __forceinline__ unsigned cvt_pk_bf16(float lo, float hi) { return pk2(lo, hi); }

__device__ __forceinline__ void glds16_s(const char* sbase, unsigned voff, unsigned lds_dst) {
    unsigned keep;
    asm volatile("s_mov_b32 %0, m0\n\ts_mov_b32 m0, %3\n\ts_nop 0\n\tglobal_load_lds_dwordx4 %1, %2\n\ts_mov_b32 m0, %0" : "=&s"(keep) : "v"(voff), "s"(sbase), "s"(lds_dst) : "memory");
}
struct Unit { int pm, pn, op; };
__device__ __forceinline__ const char* opaque_sptr(const char* p) { unsigned long long v = (unsigned long long)p; asm volatile("" : "+s"(v)); return (const char*)v; }
struct Opnd { const char* A; const char* B; unsigned lda, ldb; int nt; };

__device__ __forceinline__ bool tile_order(int i, int G, int c, int nM, int nN, int& pm, int& pn) {
    const int nwg = nM * nN; const long L = (long)i * G + c; if (L >= nwg) return false;
    int wgid = (int)L; { const int q = nwg / NXCD, r = nwg % NXCD, xcd = wgid % NXCD, off = wgid / NXCD; wgid = (xcd < r ? xcd * (q + 1) : r * (q + 1) + (xcd - r) * q) + off; }
    const int nig = WGM * nN, gid = wgid / nig, fm = gid * WGM, gsz = (nM - fm) < WGM ? (nM - fm) : WGM;
    pm = fm + ((wgid % nig) % gsz); pn = (wgid % nig) / gsz; return true;
}

template <class Epi, class Sched, bool VARLD = false>
__device__ __forceinline__ void gemm_phase(LAS unsigned char* lds, int tid, const Sched& S, const Epi& E) {
    const int wid = __builtin_amdgcn_readfirstlane(tid >> 6), lane = tid & 63, wr = wid >> 2, wc = wid & 3, fr = lane & 15, fq = lane >> 4;
    int sR[2], sRb[2], sC[2];
#pragma unroll
    for (int i = 0; i < 2; ++i) { int R, C; stage_rc(tid * 16 + i * 8192, R, C); sR[i] = R; sRb[i] = Epi::PERM ? ((R & ~31) + perm32(R & 31)) : R; sC[i] = C * 2; }
    constexpr unsigned kstep = BK * 2;
    const unsigned ldsw = (unsigned)wid * 1024u, ldsbase = (unsigned)(unsigned long long)lds;
    const int aoff = lds_byte(wr * 64 + fr, fq * 8), boff = lds_byte(wc * 32 + fr, fq * 8);
#define PG8_SA(b, h) (((b) * 2 + (h)) * HTB)
#define PG8_SB(b, h) ((4 + (b) * 2 + (h)) * HTB)
#define PG8_STAGE(bufoff, gbase, voff) do { _Pragma("unroll") for (int _i = 0; _i < 2; ++_i) \
        glds16_s((const char*)(gbase), (voff)[_i], ldsbase + (unsigned)(bufoff) + ldsw + _i * 8192); } while (0)
#define PG8_LDA(dst, b, h) do { _Pragma("unroll") for (int m = 0; m < 4; ++m) _Pragma("unroll") for (int k = 0; k < 2; ++k) dst[m][k] = *(const LAS bf16x8*)(lds + PG8_SA(b, h) + aoff + m * 2048 + k * 1024); } while (0)
#define PG8_LDB(dst, b, h) do { _Pragma("unroll") for (int n = 0; n < 2; ++n) _Pragma("unroll") for (int k = 0; k < 2; ++k) dst[n][k] = *(const LAS bf16x8*)(lds + PG8_SB(b, h) + boff + n * 2048 + k * 1024); } while (0)
#define PG8_MMA(ai, bj, At, Bt) do { __builtin_amdgcn_s_setprio(1); _Pragma("unroll") for (int m = 0; m < 4; ++m) _Pragma("unroll") for (int n = 0; n < 2; ++n) _Pragma("unroll") for (int k = 0; k < 2; ++k) \
        acc[ai][bj][m][n] = __builtin_amdgcn_mfma_f32_16x16x32_bf16(Bt[n][k], At[m][k], acc[ai][bj][m][n], 0, 0, 0); __builtin_amdgcn_s_setprio(0); } while (0)
#define PG8_WAIT_V(n) asm volatile("s_waitcnt vmcnt(" #n ")" ::: "memory")
#define PG8_WAIT_L(n) asm volatile("s_waitcnt lgkmcnt(" #n ")" ::: "memory")
#define PG8_BAR __builtin_amdgcn_s_barrier()
#define PG8_SCHED __builtin_amdgcn_sched_barrier(0)
#define PG8_VOFF(o, vA, vB, hA, hB) do { _Pragma("unroll") for (int _i = 0; _i < 2; ++_i) { vA[_i] = (unsigned)sR[_i] * (o).lda + (unsigned)sC[_i]; vB[_i] = (unsigned)sRb[_i] * (o).ldb + (unsigned)sC[_i]; } \
        hA = (unsigned)HALF * (o).lda; hB = (unsigned)HALF * (o).ldb; asm volatile("" : "+s"(hA), "+s"(hB)); } while (0)
    Unit cur, nxt; Opnd co, no; int ui = 0;
    if (!S.next(0, cur, co)) return;
    f32x4 acc[2][2][4][2];
#pragma unroll
    for (int a = 0; a < 2; ++a)
#pragma unroll
        for (int b = 0; b < 2; ++b)
#pragma unroll
            for (int m = 0; m < 4; ++m)
#pragma unroll
                for (int n = 0; n < 2; ++n) acc[a][b][m][n] = (f32x4){0.f, 0.f, 0.f, 0.f};
    bf16x8 At[4][2], B0[2][2], B1[2][2];
    unsigned cvA[2], cvB[2], nvA[2], nvB[2]; unsigned chA, chB, nhA, nhB;
    PG8_VOFF(co, cvA, cvB, chA, chB);
    const char* cA = opaque_sptr(co.A); const char* cB = opaque_sptr(co.B); int nt = co.nt;
    PG8_STAGE(PG8_SB(0, 0), cB, cvB); PG8_STAGE(PG8_SB(0, 1), cB + chB, cvB); PG8_STAGE(PG8_SA(0, 0), cA, cvA); PG8_STAGE(PG8_SA(0, 1), cA + chA, cvA);
    if (wr == 1) PG8_BAR;
    PG8_WAIT_V(2); PG8_BAR;
    PG8_STAGE(PG8_SB(1, 0), cB + kstep, cvB); PG8_STAGE(PG8_SA(1, 0), cA + kstep, cvA); PG8_STAGE(PG8_SB(1, 1), cB + chB + kstep, cvB);
    PG8_WAIT_V(6); PG8_BAR;
    for (;;) {
        const bool has_next = S.next(ui + 1, nxt, no);
        const char* nA = opaque_sptr(has_next ? no.A : cA); const char* nB = opaque_sptr(has_next ? no.B : cB);
        int nnt = nt;
        if constexpr (VARLD) { if (has_next) { PG8_VOFF(no, nvA, nvB, nhA, nhB); nnt = no.nt; } else { nvA[0] = cvA[0]; nvA[1] = cvA[1]; nvB[0] = cvB[0]; nvB[1] = cvB[1]; nhA = chA; nhB = chB; } }
        for (int t = 0; t < nt; t += 2) {
            const bool last = (t == nt - 2);
            const char* a1 = cA + (size_t)(t + 1) * kstep;
            const char* a2 = last ? nA : cA + (size_t)(t + 2) * kstep; const char* b2 = last ? nB : cB + (size_t)(t + 2) * kstep;
            const char* a3 = a2 + kstep; const char* b3 = b2 + kstep;
            unsigned vA2[2], vB2[2]; unsigned hA2, hB2;
            if constexpr (VARLD) { vA2[0] = last ? nvA[0] : cvA[0]; vA2[1] = last ? nvA[1] : cvA[1]; vB2[0] = last ? nvB[0] : cvB[0]; vB2[1] = last ? nvB[1] : cvB[1]; hA2 = last ? nhA : chA; hB2 = last ? nhB : chB; }
            else { vA2[0] = cvA[0]; vA2[1] = cvA[1]; vB2[0] = cvB[0]; vB2[1] = cvB[1]; hA2 = chA; hB2 = chB; }
            PG8_LDB(B0, 0, 0); PG8_LDB(B1, 0, 1); PG8_SCHED; PG8_LDA(At, 0, 0); PG8_STAGE(PG8_SA(1, 1), a1 + chA, cvA);
            PG8_WAIT_V(8); PG8_WAIT_L(0); PG8_BAR; PG8_MMA(0, 0, At, B0); PG8_MMA(0, 1, At, B1); PG8_BAR; PG8_SCHED;
            PG8_LDA(At, 0, 1); PG8_STAGE(PG8_SB(0, 0), b2, vB2); PG8_STAGE(PG8_SB(0, 1), b2 + hB2, vB2); PG8_STAGE(PG8_SA(0, 0), a2, vA2);
            PG8_WAIT_V(8); PG8_WAIT_L(0); PG8_BAR; PG8_MMA(1, 0, At, B0); PG8_MMA(1, 1, At, B1); PG8_BAR; PG8_SCHED;
            PG8_LDB(B0, 1, 0); PG8_LDB(B1, 1, 1); PG8_SCHED; PG8_LDA(At, 1, 0); PG8_STAGE(PG8_SA(0, 1), a2 + hA2, vA2);
            PG8_WAIT_V(8); PG8_WAIT_L(0); PG8_BAR; PG8_MMA(0, 0, At, B0); PG8_MMA(0, 1, At, B1); PG8_BAR; PG8_SCHED;
            PG8_LDA(At, 1, 1); PG8_STAGE(PG8_SB(1, 0), b3, vB2); PG8_STAGE(PG8_SB(1, 1), b3 + hB2, vB2); PG8_STAGE(PG8_SA(1, 0), a3, vA2);
            PG8_WAIT_V(8); PG8_WAIT_L(0); PG8_BAR; PG8_MMA(1, 0, At, B0); PG8_MMA(1, 1, At, B1); PG8_BAR; PG8_SCHED;
        }
        if (wr == 0) PG8_BAR;
        E(acc, cur, wr, wc, fr, fq);
        if (!has_next) break;
#pragma unroll
        for (int a = 0; a < 2; ++a)
#pragma unroll
            for (int b = 0; b < 2; ++b)
#pragma unroll
                for (int m = 0; m < 4; ++m)
#pragma unroll
                    for (int n = 0; n < 2; ++n) acc[a][b][m][n] = (f32x4){0.f, 0.f, 0.f, 0.f};
        cur = nxt; cA = nA; cB = nB; ++ui;
        if constexpr (VARLD) { cvA[0] = nvA[0]; cvA[1] = nvA[1]; cvB[0] = nvB[0]; cvB[1] = nvB[1]; chA = nhA; chB = nhB; nt = nnt; }
        if (wr == 1) PG8_BAR;
    }
    PG8_WAIT_V(0);
    PG8_BAR;
#undef PG8_SA
#undef PG8_SB
#undef PG8_STAGE
#undef PG8_LDA
#undef PG8_LDB
#undef PG8_MMA
#undef PG8_WAIT_V
#undef PG8_WAIT_L
#undef PG8_BAR
#undef PG8_SCHED
#undef PG8_VOFF
}

struct StdSched {
    const char* A; const char* B; unsigned lda, ldb; int nt, pm0, nM, nN, G, c;
    __device__ __forceinline__ bool next(int i, Unit& u, Opnd& o) const {
        int pm, pn; if (!tile_order(i, G, c, nM, nN, pm, pn)) return false;
        pm += pm0; o.A = A + (size_t)pm * 256 * lda; o.B = B + (size_t)pn * 256 * ldb; o.lda = lda; o.ldb = ldb; o.nt = nt; u.pm = pm; u.pn = pn; u.op = 0; return true;
    }
};
}

namespace pg8 {
struct BatchSched {
    const char* A; const char* B; unsigned lda, ldb; int nt, pm0, nN, c;
    __device__ __forceinline__ bool next(int i, Unit& u, Opnd& o) const {
        const int x = c & 7, li = i * 32 + (c >> 3), nrt = pm0 == 0 ? 9 : 8;
        if (li >= nrt * nN) return false;
        const int pn = li / nrt, rt = li - pn * nrt;
        const int pm = pm0 == 0 ? (rt == 0 ? x : 7 + 8 * x + rt) : 8 + 8 * x + rt;
        o.A = A + (size_t)pm * 256 * lda; o.B = B + (size_t)pn * 256 * ldb; o.lda = lda; o.ldb = ldb; o.nt = nt; u.pm = pm; u.pn = pn; u.op = 0; return true;
    }
};
}
struct Params { const float* in[34]; float* out; unsigned char* ws; int stop, pad; };

#define AS4 __attribute__((address_space(4)))
__device__ __forceinline__ unsigned long long karg_u64(int byte_off) { const AS4 char* ka = (const AS4 char*)__builtin_amdgcn_kernarg_segment_ptr(); asm volatile("" : "+s"(byte_off)); return *(const AS4 unsigned long long*)(ka + byte_off); }
#define GAS __attribute__((address_space(1)))
__device__ __forceinline__ const float* arg_in(int i) { return (const float*)(const GAS float*)karg_u64(8 * i); }
__device__ __forceinline__ float* arg_out() { return (float*)(GAS float*)karg_u64(8 * 34); }
__device__ __forceinline__ unsigned char* arg_ws() { return (unsigned char*)(GAS unsigned char*)karg_u64(8 * 35); }

struct Ctx {
    LAS unsigned char* lds;
    unsigned char* ws;
    int tid, lane, wave, G, bid, wave_s;
    __device__ __forceinline__ void refresh() { int w = wave_s; asm volatile("" : "+s"(w)); int ln; asm volatile("v_mbcnt_lo_u32_b32 %0, -1, 0\n\tv_mbcnt_hi_u32_b32 %0, -1, %0" : "=v"(ln));
        lane = ln; wave = w; tid = w * 64 + ln;
        int b_ = blockIdx.x, g_ = gridDim.x; asm volatile("" : "+s"(b_), "+s"(g_)); bid = b_; G = g_; ws = arg_ws(); }
};
__device__ __forceinline__ float* xrow_ptr(const Ctx& C, int r) { return r < T_CTX ? (float*)(C.ws + WS_S) + (size_t)r * D : arg_out() + (size_t)(r - T_CTX) * D; }
__device__ __forceinline__ int mod_idx(int r) { return r < T_CTX ? 8 : (r - T_CTX) >> 11; }
__device__ __forceinline__ const float* mod_ptr(const Ctx& C, int l, int bidx, int k) { return (const float*)(C.ws + WS_MODS) + ((size_t)(l * 9 + bidx) * NADA + k) * D; }

__device__ __forceinline__ void phase_init(Ctx& C) {
    C.refresh();
    LAS float* sc = (LAS float*)C.lds;
    LAS float* part = (LAS float*)(C.lds + 40960);
    __syncthreads();
    for (int e = C.tid; e < 9 * 1024; e += NTHR) { const int bi = e >> 10, i = e & 1023; const float v = bi < 8 ? arg_in(1)[bi * D + i] : arg_in(3)[i]; sc[e] = siluf_(v); }
    __syncthreads();
    for (int it = C.bid; it < 2 * 288; it += C.G) {
        const int l = it / 288, cb = it % 288;
        const int rsub = C.lane >> 3, c4 = C.lane & 7, i0 = C.wave * 128 + rsub;
        const float* w = arg_in(4) + (size_t)l * D * (NADA * D) + (size_t)i0 * (NADA * D) + cb * 32 + 4 * c4;
        f32x4 a[9];
#pragma unroll
        for (int b = 0; b < 9; ++b) a[b] = (f32x4){0.f, 0.f, 0.f, 0.f};
#pragma unroll 1
        for (int kb = 0; kb < 2; ++kb) {
            f32x4 wv[8];
#pragma unroll
            for (int k = 0; k < 8; ++k) wv[k] = *(const f32x4*)(w + (size_t)(8 * (kb * 8 + k)) * (NADA * D));
#pragma unroll
            for (int k = 0; k < 8; ++k)
#pragma unroll
                for (int b = 0; b < 9; ++b) a[b] = a[b] + wv[k] * sc[b * 1024 + i0 + 8 * (kb * 8 + k)];
        }
#pragma unroll
        for (int b = 0; b < 9; ++b) *(LAS f32x4*)(part + ((C.wave * 8 + rsub) * 9 + b) * 32 + 4 * c4) = a[b];
        __syncthreads();
        for (int e = C.tid; e < 9 * 32; e += NTHR) { const int b = e >> 5, c = e & 31; float sum = arg_in(5)[(size_t)l * NADA * D + cb * 32 + c];
#pragma unroll 8
            for (int w8 = 0; w8 < 64; ++w8) sum += part[(w8 * 9 + b) * 32 + c];
            ((float*)(C.ws + WS_MODS))[((size_t)l * 9 + b) * NADA * D + cb * 32 + c] = sum; }
        __syncthreads();
    }
    __syncthreads();
}

__device__ __forceinline__ void transpose_item(const float* src, int ldsrc, int col0, int K, bf16_t* dst, int row0, int kb, LAS float* scr, int lane) {
    const int k0 = 64 * kb;
    if (src) {
        const float* sp = src + (size_t)(k0 + (lane >> 3)) * ldsrc + col0 + 4 * (lane & 7);
        f32x4 t[8];
#pragma unroll
        for (int i = 0; i < 8; ++i) t[i] = *(const f32x4*)(sp + (size_t)(8 * i) * ldsrc);
#pragma unroll
        for (int i = 0; i < 8; ++i) { LAS float* d = scr + (8 * i + (lane >> 3)) * 33 + 4 * (lane & 7); d[0] = t[i].x; d[1] = t[i].y; d[2] = t[i].z; d[3] = t[i].w; }
    } else {
#pragma unroll 8
        for (int i = 0; i < 32; ++i) { const int kk = 2 * i + (lane >> 5); scr[kk * 33 + (lane & 31)] = 0.f; }
    }
    LDS_WAIT(); asm volatile("" ::: "memory");
    const int c = lane & 7;
#pragma unroll
    for (int j = 0; j < 4; ++j) { const int n = (lane >> 3) + 8 * j; const LAS float* s = scr + (8 * c) * 33 + n;
        u32x4 o; o.x = pk2(s[0 * 33], s[1 * 33]); o.y = pk2(s[2 * 33], s[3 * 33]); o.z = pk2(s[4 * 33], s[5 * 33]); o.w = pk2(s[6 * 33], s[7 * 33]);
        *(u32x4*)(dst + (size_t)(row0 + n) * K + k0 + 8 * c) = o; }
    LDS_WAIT(); asm volatile("" ::: "memory");
}
__device__ __forceinline__ void phase_convert(Ctx& C, int l) {
    C.refresh();
    LAS float* scr = (LAS float*)(C.lds + C.wave * 16384);
    unsigned char* W = C.ws + WS_W;
    const int gw = C.bid * NWAVES + C.wave, NGW = C.G * NWAVES;
    constexpr int I_FI = 16 * 176, I_FO = 44 * 32, I_MA = 16 * 88, I_MB = 16 * 96, I_G = 16 * 96, I_R = 16 * 32, I_A = 8 * 32, I_O = 16 * 32;
    constexpr int I_GU = 2 * 16, I_WU = 4 * 16;
    constexpr int NITEMS = 2 * I_FI + 2 * I_FO + I_MA + I_MB + I_G + I_R + 2 * I_A + I_O + I_GU + I_WU;
    for (int it = gw; it < NITEMS; it += NGW) {
        int r = it;
        if (r < 2 * I_FI) { const int which = r / I_FI; r %= I_FI; const int nb = r / 16, kb = r % 16; const int np = nb * 32, t = np >> 8, q = np & 255;
            const int col = q < 128 ? 128 * t + q : DFF + 128 * t + (q - 128);
            transpose_item(arg_in(which ? 9 : 7) + (size_t)l * D * 2 * DFF, 2 * DFF, col, D, (bf16_t*)(W + (which ? W_FFN2_IN : W_FFN1_IN)), np, kb, scr, C.lane); continue; }
        r -= 2 * I_FI;
        if (r < 2 * I_FO) { const int which = r / I_FO; r %= I_FO; const int nb = r / 44, kb = r % 44;
            transpose_item(arg_in(which ? 10 : 8) + (size_t)l * DFF * D, D, nb * 32, DFF, (bf16_t*)(W + (which ? W_FFN2_OUT : W_FFN1_OUT)), nb * 32, kb, scr, C.lane); continue; }
        r -= 2 * I_FO;
        if (r < I_MA) { const int nb = r / 16, kb = r % 16, np = nb * 32; const float* src; int ld, col;
            if (np < 2688) { src = arg_in(11) + (size_t)l * D * NIN; ld = NIN; col = 3072 + np; }
            else if (np < 2720 && l > 0) { src = arg_in(26) + (size_t)(l - 1) * D * 32; ld = 32; col = 0; }
            else { src = nullptr; ld = 0; col = 0; }
            transpose_item(src, ld, col, D, (bf16_t*)(W + W_MIXA), np, kb, scr, C.lane); continue; }
        r -= I_MA;
        if (r < I_MB) { const int nb = r / 16, kb = r % 16; transpose_item(arg_in(11) + (size_t)l * D * NIN, NIN, nb * 32, D, (bf16_t*)(W + W_MIXB), nb * 32, kb, scr, C.lane); continue; }
        r -= I_MB;
        if (r < I_G) { const int nb = r / 16, kb = r % 16; transpose_item(arg_in(11) + (size_t)l * D * NIN, NIN, 5760 + nb * 32, D, (bf16_t*)(W + W_GATE), nb * 32, kb, scr, C.lane); continue; }
        r -= I_G;
        if (r < I_R) { const int nb = r / 16, kb = r % 16; transpose_item(arg_in(30) + (size_t)l * 1024 * D, D, nb * 32, 1024, (bf16_t*)(W + W_RET), nb * 32, kb, scr, C.lane); continue; }
        r -= I_R;
        if (r < 2 * I_A) { const int which = r / I_A; r %= I_A; const int nb = r / 8, kb = r % 8;
            transpose_item(arg_in(which ? 32 : 31) + (size_t)l * 512 * D, D, nb * 32, 512, (bf16_t*)(W + (which ? W_RWKV : W_ATT)), nb * 32, kb, scr, C.lane); continue; }
        r -= 2 * I_A;
        if (r < I_O) { const int nb = r / 16, kb = r % 16; transpose_item(arg_in(33) + (size_t)l * D * D, D, nb * 32, D, (bf16_t*)(W + W_OUT), nb * 32, kb, scr, C.lane); continue; }
        r -= I_O;
        if (r < I_GU) { const int nb = r / 2, kb = r % 2; transpose_item(arg_in(21) + (size_t)l * 128 * 512, 512, nb * 32, 128, (bf16_t*)(W + W_GUP), nb * 32, kb, scr, C.lane); continue; }
        r -= I_GU;
        { const int md = r / 16, nb = r % 16;
          transpose_item(arg_in(md < 2 ? 18 : 20) + ((size_t)(l * 2 + (md & 1)) * 64) * 512, 512, nb * 32, 64, (bf16_t*)(W + W_WUP) + (size_t)md * 512 * 64, nb * 32, 0, scr, C.lane); }
    }
}

__device__ __forceinline__ void norm_rows(Ctx& C, int l, int which, int r_first, int r_step, int r_end, int fold_slabs, int src_mode) {
    const f32x4* nw = (const f32x4*)(arg_in(6) + ((size_t)l * 3 + which) * D) + C.lane;
    f32x4 nwv[4];
#pragma unroll
    for (int j = 0; j < 4; ++j) nwv[j] = nw[64 * j];
    bf16_t* H = (bf16_t*)(C.ws + WS_H);
    f32x4 v[4], sha[4], scb[4];
    auto load_row = [&](int r, f32x4 (&vv)[4], f32x4 (&sa)[4], f32x4 (&sb)[4]) {
        const float* xsrc = (src_mode && r < T_CTX && (src_mode == 2 || C.G == 256)) ? arg_in(2) + (size_t)r * D : (src_mode == 2 ? arg_in(0) + (size_t)(r - T_CTX) * D : (const float*)xrow_ptr(C, r));
        const f32x4* xr = (const f32x4*)xsrc + C.lane;
        const int bi = mod_idx(r);
        const f32x4* sh = (const f32x4*)mod_ptr(C, l, bi, 3 * which) + C.lane;
        const f32x4* scl = (const f32x4*)mod_ptr(C, l, bi, 3 * which + 1) + C.lane;
#pragma unroll
        for (int j = 0; j < 4; ++j) vv[j] = xr[64 * j];
#pragma unroll
        for (int j = 0; j < 4; ++j) { sa[j] = sh[64 * j]; sb[j] = scl[64 * j]; }
    };
    auto do_row = [&](int r, f32x4 (&v)[4], const f32x4 (&sha)[4], const f32x4 (&scb)[4]) {
        float s = 0.f;
        if (fold_slabs && r < T_CTX && C.G == 256) {
            const float* sl = (const float*)(C.ws + WS_AO + 4 * MiB) + (size_t)((r >> 8) * 16) * 65536 + (size_t)(r & 255) * 256 + 4 * C.lane;
            f32x4 t[4][4];
#pragma unroll
            for (int j = 0; j < 4; ++j)
#pragma unroll
                for (int si = 0; si < 4; ++si) t[j][si] = *(const f32x4*)(sl + (size_t)(j * fold_slabs + (si < fold_slabs ? si : fold_slabs - 1)) * 65536);
#pragma unroll
            for (int j = 0; j < 4; ++j) {
#pragma unroll
                for (int si = 0; si < 4; ++si) { const float keep = si < fold_slabs ? 1.0f : 0.0f; v[j] = v[j] + t[j][si] * keep; }
                ((f32x4*)xrow_ptr(C, r))[64 * j + C.lane] = v[j]; }
        }
#pragma unroll
        for (int j = 0; j < 4; ++j) s += (v[j].x * v[j].x + v[j].y * v[j].y) + (v[j].z * v[j].z + v[j].w * v[j].w);
        const float rstd = 1.0f / sqrtf(wave_sum(s) * (1.0f / D) + 1e-6f);
        unsigned long long* o8 = (unsigned long long*)(H + (size_t)r * D) + C.lane;
#pragma unroll
        for (int j = 0; j < 4; ++j) { const f32x4 a = sha[j], b = scb[j]; const f32x4 y = (v[j] * rstd * nwv[j]) * (b + 1.0f) + a;
            o8[64 * j] = (unsigned long long)pk2(y.x, y.y) | ((unsigned long long)pk2(y.z, y.w) << 32); }
    };
    f32x4 vb[4], shb[4], scbb[4];
    int r = r_first;
    if (r < r_end) load_row(r, v, sha, scb);
    while (r < r_end) {
        int rn = r + r_step;
        load_row(rn < r_end ? rn : r, vb, shb, scbb);
        do_row(r, v, sha, scb);
        r = rn; if (r >= r_end) break;
        rn = r + r_step;
        load_row(rn < r_end ? rn : r, v, sha, scb);
        do_row(r, vb, shb, scbb);
        r = rn;
    }
}
__device__ __forceinline__ void phase_norm(Ctx& C, int l, int which, int row_lo, int fold_slabs, int src_mode) {
    C.refresh();
    norm_rows(C, l, which, row_lo + C.bid * NWAVES + C.wave, C.G * NWAVES, T_ALL, fold_slabs, src_mode);
}
struct FusedNorm { int l, which, fold, src; };
__device__ __forceinline__ void fused_norm(Ctx& C, const FusedNorm& fn, int pm_lat, int pn_lat, bool has_ctx, int pmc, int j, int nj) {
    if (fn.l < 0) return;
    unsigned* tmo = (unsigned*)(C.ws + WS_CTL) + CW_BAR + XB_TMO;
    unsigned* cnt0 = (unsigned*)(C.ws + WS_CTL) + 65536 + (size_t)((fn.l * 3 + fn.which) * 72) * 64;
    group_sync(cnt0 + pm_lat * 64, 4u, tmo);
    C.refresh();
    { const int r0 = pm_lat * 256 + pn_lat * 64; norm_rows(C, fn.l, fn.which, r0 + C.wave, NWAVES, r0 + 64, fn.fold, fn.src); }
    if (has_ctx) {
        group_sync(cnt0 + pmc * 64, (unsigned)nj, tmo);
        C.refresh();
        const int per = (256 + nj - 1) / nj, r0 = pmc * 256 + j * per, r1 = pmc * 256 + ((j + 1) * per < 256 ? (j + 1) * per : 256);
        norm_rows(C, fn.l, fn.which, r0 + C.wave, NWAVES, r1, fn.fold, fn.src);
    }
}

struct EpiSwiglu {
    static constexpr bool PERM = true;
    bf16_t* O;
    __device__ __forceinline__ void operator()(const f32x4 (&acc)[2][2][4][2], const pg8::Unit& u, int wr, int wc, int fr, int fq) const {
        const int row0 = u.pm * 256 + wr * 64 + fr, col0 = u.pn * 128 + wc * 32 + 8 * fq;
#pragma unroll
        for (int ai = 0; ai < 2; ++ai)
#pragma unroll
            for (int m = 0; m < 4; ++m) { bf16_t* rowp = O + (size_t)(row0 + ai * 128 + m * 16) * FS + col0;
                const f32x4 g0 = acc[ai][0][m][0], g1 = acc[ai][0][m][1], u0 = acc[ai][1][m][0], u1 = acc[ai][1][m][1];
                float o[8];
#pragma unroll
                for (int j = 0; j < 4; ++j) { o[j] = siluf_(g0[j]) * u0[j]; o[4 + j] = siluf_(g1[j]) * u1[j]; }
                u32x4 w; w.x = pg8::cvt_pk_bf16(o[0], o[1]); w.y = pg8::cvt_pk_bf16(o[2], o[3]); w.z = pg8::cvt_pk_bf16(o[4], o[5]); w.w = pg8::cvt_pk_bf16(o[6], o[7]);
                *(u32x4*)rowp = w; }
    }
};
template <bool FIRST>
struct EpiResidT {
    static constexpr bool PERM = false;
    float* S; float* OUT; const float* mods_l; int k; float coef; float* slab;
    __device__ __forceinline__ void operator()(const f32x4 (&acc)[2][2][4][2], const pg8::Unit& u, int wr, int wc, int fr, int fq) const {
        const int rt = u.pm * 256;
        float* base = rt < T_CTX ? S + (size_t)rt * D : OUT + (size_t)(rt - T_CTX) * D;
        const float* rbase = base;
        if (FIRST) rbase = rt < T_CTX ? arg_in(2) + (size_t)rt * D : arg_in(0) + (size_t)(rt - T_CTX) * D;
        const int bi = rt < T_CTX ? 8 : (rt - T_CTX) >> 11;
        const int col0 = u.pn * 256 + wc * 32 + 4 * fq;
        const float* mg = mods_l + ((size_t)bi * NADA + k) * D + col0;
        f32x4 gv[2][2];
#pragma unroll
        for (int bj = 0; bj < 2; ++bj)
#pragma unroll
            for (int n = 0; n < 2; ++n) gv[bj][n] = *(const f32x4*)(mg + bj * 128 + n * 16);
        asm volatile("" : "+v"(gv[0][0]), "+v"(gv[0][1]), "+v"(gv[1][0]), "+v"(gv[1][1]));
#pragma unroll
        for (int bj = 0; bj < 2; ++bj)
#pragma unroll
            for (int n = 0; n < 2; ++n) gv[bj][n] = gv[bj][n] * coef;
        if (u.op == 0) {
#pragma unroll
            for (int ai = 0; ai < 2; ++ai)
#pragma unroll
                for (int mp = 0; mp < 2; ++mp) {
                    f32x4 r[2][2][2];
#pragma unroll
                    for (int mm = 0; mm < 2; ++mm) { const float* rrow = rbase + (size_t)(wr * 64 + fr + ai * 128 + (mp * 2 + mm) * 16) * D + col0;
#pragma unroll
                        for (int bj = 0; bj < 2; ++bj)
#pragma unroll
                            for (int n = 0; n < 2; ++n) r[mm][bj][n] = *(const f32x4*)(rrow + bj * 128 + n * 16); }
#pragma unroll
                    for (int mm = 0; mm < 2; ++mm) { float* rowp = base + (size_t)(wr * 64 + fr + ai * 128 + (mp * 2 + mm) * 16) * D + col0;
#pragma unroll
                        for (int bj = 0; bj < 2; ++bj)
#pragma unroll
                            for (int n = 0; n < 2; ++n) *(f32x4*)(rowp + bj * 128 + n * 16) = r[mm][bj][n] + gv[bj][n] * acc[ai][bj][mp * 2 + mm][n]; }
                }
        } else {
            float* sl = slab + (size_t)(u.op - 1) * 65536 + (size_t)(wr * 64 + fr) * 256 + wc * 32 + 4 * fq;
#pragma unroll
            for (int ai = 0; ai < 2; ++ai)
#pragma unroll
                for (int m = 0; m < 4; ++m)
#pragma unroll
                    for (int bj = 0; bj < 2; ++bj)
#pragma unroll
                        for (int n = 0; n < 2; ++n) *(f32x4*)(sl + (size_t)(ai * 128 + m * 16) * 256 + bj * 128 + n * 16) = gv[bj][n] * acc[ai][bj][m][n];
        }
    }
};
typedef EpiResidT<false> EpiResid;

__device__ __forceinline__ void ffn_tile(int x, int li, int& pm, int& pn) {
    int rt; if (li < 176) { pn = li >> 3; rt = li & 7; } else { rt = 8; pn = li - 176; }
    pm = rt == 0 ? x : 7 + 8 * x + rt;
}
struct FfnInSched {
    const char* A; const char* B; int c; bool tail;
    __device__ __forceinline__ bool next(int i, pg8::Unit& u, pg8::Opnd& o) const {
        const int x = c & 7, j = c >> 3; int li;
        if (!tail) { if (i >= 6) return false; li = i * 32 + j; } else { if (i != 0 || j < 16 || j >= 22) return false; li = 192 + (j - 16); }
        int pm, pn; ffn_tile(x, li, pm, pn);
        o.A = A + (size_t)pm * 256 * 2048; o.B = B + (size_t)pn * 256 * 2048; o.lda = 2048; o.ldb = 2048; o.nt = 16; u.pm = pm; u.pn = pn; u.op = 0; return true;
    }
};
__device__ __forceinline__ int ffn_piece(int j) { return (j < 16 && j != 7 && j != 15) ? j : j == 22 ? 7 : j == 24 ? 15 : -1; }
template <int NT>
struct SplitSched {
    static constexpr int SPL = 4;
    const char* A; const char* B; unsigned lda, ldb; int c;
    __device__ __forceinline__ bool next(int i, pg8::Unit& u, pg8::Opnd& o) const {
        o.lda = lda; o.ldb = ldb;
        if (i == 0) { int pm, pn; pg8::tile_order(0, 256, c, 64, 4, pm, pn); pm += 8; u.pm = pm; u.pn = pn; u.op = 0; o.nt = NT; o.A = A + (size_t)pm * 256 * lda; o.B = B + (size_t)pn * 256 * ldb; return true; }
        if (i == 1 && ffn_piece(c >> 3) >= 0) { const int x = c & 7, jj = ffn_piece(c >> 3), pm = x, pn = jj >> 2, si = jj & 3, ct = x * 4 + pn;
            constexpr int n0 = ((NT / SPL + 1) / 2) * 2, n1 = (NT - 2 * n0) / 2;
            const int k0 = si < 2 ? si * n0 : 2 * n0 + (si - 2) * n1, nt = si < 2 ? n0 : n1;
            u.pm = pm; u.pn = pn; u.op = 1 + ct * SPL + si; o.nt = nt; o.A = A + (size_t)pm * 256 * lda + (size_t)k0 * 128; o.B = B + (size_t)pn * 256 * ldb + (size_t)k0 * 128; return true; }
        return false;
    }
};
__device__ __forceinline__ void phase_ffn_in(Ctx& C, size_t w_off, int pm0, int nM) {
    C.refresh();
    EpiSwiglu E{(bf16_t*)(C.ws + WS_F)};
    if (C.G == 256 && pm0 == 0 && nM == 72) {
        FfnInSched S{(const char*)(C.ws + WS_H), (const char*)(C.ws + WS_W + w_off), C.bid, false};
        pg8::gemm_phase<EpiSwiglu, FfnInSched>(C.lds, C.tid, S, E);
    } else if (C.G == 256 && pm0 == 8 && nM == 64) {
        pg8::BatchSched S{(const char*)(C.ws + WS_H), (const char*)(C.ws + WS_W + w_off), D * 2, D * 2, D / 64, pm0, 22, C.bid};
        pg8::gemm_phase<EpiSwiglu, pg8::BatchSched>(C.lds, C.tid, S, E);
    } else {
        pg8::StdSched S{(const char*)(C.ws + WS_H), (const char*)(C.ws + WS_W + w_off), D * 2, D * 2, D / 64, pm0, nM, 22, C.G, C.bid};
        pg8::gemm_phase<EpiSwiglu, pg8::StdSched>(C.lds, C.tid, S, E);
    }
}
template <bool FIRST>
__device__ __forceinline__ void phase_ffn_out(Ctx& C, int l, size_t w_off, int k, int pm0, int nM, const FusedNorm& fn, size_t w_in_off, int sid) {
    if (nM == 72 && C.G == 256) {
        const int j = C.bid >> 3;
        if (j >= 16 && j < 22) {
            C.refresh();
            EpiSwiglu E2{(bf16_t*)(C.ws + WS_F)};
            FfnInSched S2{(const char*)(C.ws + WS_H), (const char*)(C.ws + WS_W + w_in_off), C.bid, true};
            pg8::gemm_phase<EpiSwiglu, FfnInSched>(C.lds, C.tid, S2, E2);
        }
        if ((j >= 16 && j < 22) || (j & 7) == 7)
            group_sync((unsigned*)(C.ws + WS_CTL) + 40960 + (size_t)(sid * 8 + (C.bid & 7)) * 64, 10u, (unsigned*)(C.ws + WS_CTL) + CW_BAR + XB_TMO);
    }
    C.refresh();
    EpiResidT<FIRST> E{(float*)(C.ws + WS_S), arg_out(), (const float*)(C.ws + WS_MODS) + (size_t)l * 9 * NADA * D, k, 0.5f, (float*)(C.ws + WS_AO + 4 * MiB)};
    if (nM == 72 && C.G == 256) {
        SplitSched<DFF / 64> S{(const char*)(C.ws + WS_F), (const char*)(C.ws + WS_W + w_off), FS * 2, DFF * 2, C.bid};
        pg8::gemm_phase<EpiResidT<FIRST>, SplitSched<DFF / 64>, true>(C.lds, C.tid, S, E);
        int pm, pn; pg8::tile_order(0, 256, C.bid, 64, 4, pm, pn);
        fused_norm(C, fn, pm + 8, pn, ffn_piece(C.bid >> 3) >= 0, C.bid & 7, ffn_piece(C.bid >> 3), 16);
    } else {
        pg8::StdSched S{(const char*)(C.ws + WS_F), (const char*)(C.ws + WS_W + w_off), FS * 2, DFF * 2, DFF / 64, pm0, nM, 4, C.G, C.bid};
        pg8::gemm_phase<EpiResidT<FIRST>, pg8::StdSched>(C.lds, C.tid, S, E);
    }
}

struct EpiBf16 {
    static constexpr bool PERM = true;
    bf16_t* O; int ldc;
    __device__ __forceinline__ void operator()(const f32x4 (&acc)[2][2][4][2], const pg8::Unit& u, int wr, int wc, int fr, int fq) const {
        const int row0 = u.pm * 256 + wr * 64 + fr, col0 = u.pn * 256 + wc * 32 + 8 * fq;
#pragma unroll
        for (int ai = 0; ai < 2; ++ai)
#pragma unroll
            for (int m = 0; m < 4; ++m) { bf16_t* rowp = O + (size_t)(row0 + ai * 128 + m * 16) * ldc + col0;
#pragma unroll
                for (int bj = 0; bj < 2; ++bj) { const f32x4 v0 = acc[ai][bj][m][0], v1 = acc[ai][bj][m][1];
                    u32x4 w; w.x = pg8::cvt_pk_bf16(v0[0], v0[1]); w.y = pg8::cvt_pk_bf16(v0[2], v0[3]); w.z = pg8::cvt_pk_bf16(v1[0], v1[1]); w.w = pg8::cvt_pk_bf16(v1[2], v1[3]);
                    *(u32x4*)(rowp + bj * 128) = w; } }
    }
};
struct MixASched {
    const char* A; const char* B; int c;
    __device__ __forceinline__ bool next(int i, pg8::Unit& u, pg8::Opnd& o) const {
        const int x = c & 7, li = i * 32 + (c >> 3);
        if (li >= 9 * 12) return false;
        const int pn = li / 9, rt = li - pn * 9, pm = rt == 0 ? x : 7 + 8 * x + rt;
        const int wrow = pn < 11 ? pn * 256 : 2816 + 2816;
        o.A = A + (size_t)pm * 256 * 2048; o.B = B + (size_t)wrow * 2048; o.lda = 2048; o.ldb = 2048; o.nt = 16;
        u.pm = pm; u.pn = pn; u.op = 0; return true;
    }
};
struct MixGxSched {
    const char* A; const char* B; int c;
    __device__ __forceinline__ bool next(int i, pg8::Unit& u, pg8::Opnd& o) const {
        const int x = c & 7, rt = (c >> 3) - 12;
        if (i != 0 || rt < 0 || rt >= 9) return false;
        const int pm = rt == 0 ? x : 7 + 8 * x + rt;
        o.A = A + (size_t)pm * 256 * 2048; o.B = B + (size_t)(2816 + 2560) * 2048; o.lda = 2048; o.ldb = 2048; o.nt = 16;
        u.pm = pm; u.pn = 0; u.op = 0; return true;
    }
};
__device__ __forceinline__ void phase_mix(Ctx& C, size_t w_off, int ncols) {
    C.refresh();
    EpiBf16 E{(bf16_t*)(C.ws + WS_F), FS};
    if (C.G == 256 && w_off == W_MIXA) {
        MixASched S{(const char*)(C.ws + WS_H), (const char*)(C.ws + WS_W + W_MIXA), C.bid};
        pg8::gemm_phase<EpiBf16, MixASched>(C.lds, C.tid, S, E);
        C.refresh();
        EpiBf16 E2{(bf16_t*)(C.ws + WS_GX), 256};
        MixGxSched S2{(const char*)(C.ws + WS_H), (const char*)(C.ws + WS_W + W_MIXA), C.bid};
        pg8::gemm_phase<EpiBf16, MixGxSched>(C.lds, C.tid, S2, E2);
    } else if (C.G == 256) {
        pg8::BatchSched S{(const char*)(C.ws + WS_H), (const char*)(C.ws + WS_W + w_off), D * 2, D * 2, D / 64, 0, 10, C.bid};
        pg8::gemm_phase<EpiBf16, pg8::BatchSched>(C.lds, C.tid, S, E);
    } else {
        pg8::StdSched S{(const char*)(C.ws + WS_H), (const char*)(C.ws + WS_W + w_off), D * 2, D * 2, D / 64, 0, 72, ncols / 256, C.G, C.bid};
        pg8::gemm_phase<EpiBf16, pg8::StdSched>(C.lds, C.tid, S, E);
    }
}

__device__ __forceinline__ int urow(int seg, int b, int pos) { return seg ? T_CTX + b * SEQ + pos : b * CTX + pos; }

__device__ __forceinline__ void att_prep(Ctx& C, int l) {
    C.refresh();
    bf16_t* CA = (bf16_t*)(C.ws + WS_F);
    const int gw = C.bid * NWAVES + C.wave, NGW = C.G * NWAVES;
    const int i = C.lane;
    const float qn = arg_in(13)[l * 64 + i], kn = arg_in(14)[l * 64 + i];
    const int p = i & 31;
    const float inv = __expf(-(float)(p & 15) * (9.210340371976184f / 16.0f));
    const bool bal = C.G == 256; const int wv = (C.bid >> 3) * NWAVES + C.wave, bx = C.bid & 7;
    for (int k = bal ? 0 : gw; k < (bal ? 9 : T_ALL); k += bal ? 1 : NGW) {
        const int r = bal ? (k == 0 ? bx * CTX + wv : T_CTX + bx * SEQ + (k - 1) * 256 + wv) : k;
        bf16_t* rowp = CA + (size_t)r * FS + i;
        bf16_t xr[10];
#pragma unroll
        for (int hh = 0; hh < 10; ++hh) xr[hh] = rowp[hh * 64];
        float sn = 0.f, cs = 1.f;
        const bool lat = r >= T_CTX;
        if (lat) { const int pos = (r - T_CTX) & (SEQ - 1); const float ang = (float)(p < 16 ? (pos >> 6) : (pos & 63)) * inv; __sincosf(ang, &sn, &cs); }
#pragma unroll
        for (int hh = 0; hh < 10; ++hh) {
            float v = bf2f(xr[hh]);
            const float ss = wave_sum(v * v);
            v = v * (1.0f / sqrtf(ss * (1.0f / 64.0f) + 1e-6f)) * (hh < 8 ? qn : kn);
            if (lat) {
                const float o = __builtin_bit_cast(float, __builtin_amdgcn_ds_bpermute((i ^ 32) << 2, __builtin_bit_cast(int, v)));
                v = i < 32 ? v * cs - o * sn : o * sn + v * cs;
            }
            if (hh < 8) v *= 0.125f * 1.4426950408889634f;
            rowp[hh * 64] = (bf16_t)f2bf(v);
        }
    }
}

namespace rw {
constexpr int OFF_W = 0, OFF_KK = 16384, OFF_BB = 32768, OFF_KD = 49152, OFF_RR = 65536, OFF_VV = 81920, OFF_YB = 90112,
              OFF_AWD = 98304, OFF_AAD = 107520, OFF_BW = 116736, OFF_BA = 125952, OFF_VL = 135168, OFF_VUP = 143360, LDS_END = 147456;
constexpr int RC = 768;
}
namespace rc {
constexpr int LD = 72;
constexpr int OFF_LW = 0, OFF_LA = 16384, OFF_LK = 32768, OFF_LR = 49152, OFF_AWD = 65536, OFF_AAD = 74752, OFF_LVV = 83968, OFF_LVL = 92160, OFF_PART = 100352;
constexpr int OFF_ABT = 0, OFF_AKT = 16384, OFF_MKT = 25600, OFF_MBT = 34816, OFF_TTT = 44032, OFF_XX = 53248, OFF_NZ = 57856, OFF_WU = 62464, OFF_WYT = 71680, OFF_PTT = 80896;
constexpr int OFF_BT = 102400, OFF_KT = 111616, OFF_KP = 120832, OFF_RT = 130048, OFF_VT = 139264, VT_LD = 40, OFF_LGC = 144384;
constexpr int OFF_TF = OFF_WU, OFF_WS = OFF_WU + 17408;
constexpr int OFF_S0 = 144640, OFF_LYB = OFF_KP, OFF_VUP = 153856, OFF_CWA = 157952, OFF_KC = 161792, LDS_END = 162560;
static_assert(LDS_END <= LDS_MISC, "chunked rwkv LDS map");
typedef unsigned short u16x4 __attribute__((ext_vector_type(4)));
template <int LDE>
__device__ __forceinline__ bf16x8 trfrag(LAS const bf16_t* base, int k0, int c0, int lane) {
    const int g = lane >> 4, i = lane & 15, q = i >> 2, p = i & 3;
    const unsigned addr = (unsigned)(unsigned long long)(base + (k0 + 8 * g + q) * LDE + c0 + 4 * p);
    u16x4 r1, r2;
    asm volatile("ds_read_b64_tr_b16 %0, %2\n\tds_read_b64_tr_b16 %1, %2 offset:%3\n\ts_waitcnt lgkmcnt(0)" : "=&v"(r1), "=&v"(r2) : "v"(addr), "i"(LDE * 8) : "memory");
    bf16x8 f; f[0] = (short)r1[0]; f[1] = (short)r1[1]; f[2] = (short)r1[2]; f[3] = (short)r1[3]; f[4] = (short)r2[0]; f[5] = (short)r2[1]; f[6] = (short)r2[2]; f[7] = (short)r2[3];
    return f;
}
__device__ __forceinline__ bf16x8 mkfrag(u16x4 r1, u16x4 r2) { bf16x8 f; f[0] = (short)r1[0]; f[1] = (short)r1[1]; f[2] = (short)r1[2]; f[3] = (short)r1[3]; f[4] = (short)r2[0]; f[5] = (short)r2[1]; f[6] = (short)r2[2]; f[7] = (short)r2[3]; return f; }
template <int LDE>
__device__ __forceinline__ void trfrag4(LAS const bf16_t* base, int k0, int lane, bf16x8 (&f)[4]) {
    const int g = lane >> 4, i = lane & 15, q = i >> 2, p = i & 3;
    const unsigned addr = (unsigned)(unsigned long long)(base + (k0 + 8 * g + q) * LDE + 4 * p);
    u16x4 a0, a1, b0, b1, c0, c1, d0, d1;
    asm volatile("ds_read_b64_tr_b16 %0, %8\n\tds_read_b64_tr_b16 %1, %8 offset:%9\n\t"
                 "ds_read_b64_tr_b16 %2, %8 offset:32\n\tds_read_b64_tr_b16 %3, %8 offset:%10\n\t"
                 "ds_read_b64_tr_b16 %4, %8 offset:64\n\tds_read_b64_tr_b16 %5, %8 offset:%11\n\t"
                 "ds_read_b64_tr_b16 %6, %8 offset:96\n\tds_read_b64_tr_b16 %7, %8 offset:%12\n\t"
                 "s_waitcnt lgkmcnt(0)"
                 : "=&v"(a0), "=&v"(a1), "=&v"(b0), "=&v"(b1), "=&v"(c0), "=&v"(c1), "=&v"(d0), "=&v"(d1)
                 : "v"(addr), "i"(LDE * 8), "i"(LDE * 8 + 32), "i"(LDE * 8 + 64), "i"(LDE * 8 + 96) : "memory");
    f[0] = mkfrag(a0, a1); f[1] = mkfrag(b0, b1); f[2] = mkfrag(c0, c1); f[3] = mkfrag(d0, d1);
}
template <int LDE>
__device__ __forceinline__ void trfrag2k(LAS const bf16_t* base, int c0, int lane, bf16x8 (&f)[2]) {
    const int g = lane >> 4, i = lane & 15, q = i >> 2, p = i & 3;
    const unsigned addr = (unsigned)(unsigned long long)(base + (8 * g + q) * LDE + c0 + 4 * p);
    u16x4 a0, a1, b0, b1;
    asm volatile("ds_read_b64_tr_b16 %0, %4\n\tds_read_b64_tr_b16 %1, %4 offset:%5\n\t"
                 "ds_read_b64_tr_b16 %2, %4 offset:%6\n\tds_read_b64_tr_b16 %3, %4 offset:%7\n\t"
                 "s_waitcnt lgkmcnt(0)"
                 : "=&v"(a0), "=&v"(a1), "=&v"(b0), "=&v"(b1)
                 : "v"(addr), "i"(LDE * 8), "i"(LDE * 64), "i"(LDE * 64 + LDE * 8) : "memory");
    f[0] = mkfrag(a0, a1); f[1] = mkfrag(b0, b1);
}
__device__ __forceinline__ bf16x8 ldfrag(LAS const bf16_t* base, int row, int k0, int lane) { return *(const LAS bf16x8*)(base + row * LD + k0 + (lane >> 4) * 8); }
}
namespace r1 {
using rc::LD;
constexpr int OFF_LW = 0, OFF_LA = 16384, OFF_LK = 32768, OFF_LR = 49152, OFF_AWD = 65536, OFF_AAD = 74752, OFF_PART = OFF_AWD, OFF_LVV = 83968, OFF_VLB = 100352, VL_LD = 40, OFF_XEND = 105472;
constexpr int OFF_ABT = 0, OFF_AKT = 17408, OFF_MKT = 26624, OFF_MBT = 35840, OFF_TTT = 45056, OFF_XX = 54272, OFF_NZ = 63488, OFF_WU = 72704, OFF_TF = OFF_WU, OFF_WS = OFF_WU + 17408;
constexpr int OFF_BT = 105472, OFF_KT = 114688, OFF_KP = 123904, OFF_RT = 133120, OFF_VT = 142336, OFF_LGC = 151552;
constexpr int OFF_CWA = 151808, OFF_KC = 155648, OFF_VUPT = 156416, OFF_V0 = 161536, LDS_END = 161792;
static_assert(LDS_END <= LDS_MISC && OFF_WS + 4352 <= OFF_XEND, "r1 LDS map");
constexpr size_t WS_WYG = WS_AO, WS_PTG = WS_AO + 18 * MiB, WS_QG = WS_GSCR;
}
__device__ __forceinline__ void phase_rwkv_r1(Ctx& C, int l, int dir) {
    using namespace r1; using rc::trfrag; using rc::ldfrag;
    C.refresh();
    const int tid = C.tid, lane = C.lane, wave = C.wave, fr = lane & 15, fq = lane >> 4;
    const int h = (C.bid >> 3) & 7, jw = (C.bid & 7) * 4 + (C.bid >> 6);
    const bf16_t* CA = (const bf16_t*)(C.ws + WS_F);
    bf16_t* Y = (bf16_t*)(C.ws + WS_F2);
    bf16_t* VF = (bf16_t*)(C.ws + WS_VFIRST);
    bf16_t* VM = (bf16_t*)(C.ws + WS_VMIX);
    float* BON = (float*)(C.ws + WS_BONUS);
    const bf16_t* WUPg = (const bf16_t*)(C.ws + WS_W + W_WUP);
    bf16_t* WYG = (bf16_t*)(C.ws + WS_WYG); bf16_t* PTG = (bf16_t*)(C.ws + WS_PTG); bf16_t* QG = (bf16_t*)(C.ws + WS_QG);
    LAS unsigned char* lds = C.lds;
    LAS float* LW = (LAS float*)(lds + OFF_LW); LAS float* LA = (LAS float*)(lds + OFF_LA); LAS float* LK = (LAS float*)(lds + OFF_LK); LAS float* LR = (LAS float*)(lds + OFF_LR);
    LAS float* LVV = (LAS float*)(lds + OFF_LVV); LAS float* PART = (LAS float*)(lds + OFF_PART); LAS float* LGC = (LAS float*)(lds + OFF_LGC);
    LAS bf16_t* AWD = (LAS bf16_t*)(lds + OFF_AWD); LAS bf16_t* AAD = (LAS bf16_t*)(lds + OFF_AAD); LAS bf16_t* VLB = (LAS bf16_t*)(lds + OFF_VLB);
    LAS bf16_t* BT = (LAS bf16_t*)(lds + OFF_BT); LAS bf16_t* KT = (LAS bf16_t*)(lds + OFF_KT); LAS bf16_t* KP = (LAS bf16_t*)(lds + OFF_KP); LAS bf16_t* RT = (LAS bf16_t*)(lds + OFF_RT);
    LAS bf16_t* VT = (LAS bf16_t*)(lds + OFF_VT);
    LAS float* ABT = (LAS float*)(lds + OFF_ABT);
    LAS bf16_t* AKT = (LAS bf16_t*)(lds + OFF_AKT); LAS bf16_t* MKT = (LAS bf16_t*)(lds + OFF_MKT); LAS bf16_t* MBT = (LAS bf16_t*)(lds + OFF_MBT); LAS bf16_t* TTT = (LAS bf16_t*)(lds + OFF_TTT);
    LAS bf16_t* XX = (LAS bf16_t*)(lds + OFF_XX); LAS bf16_t* NZ = (LAS bf16_t*)(lds + OFF_NZ); LAS bf16_t* WU = (LAS bf16_t*)(lds + OFF_WU);
    LAS float* CWA = (LAS float*)(lds + OFF_CWA); LAS float* KC = (LAS float*)(lds + OFF_KC); LAS bf16_t* VUPT = (LAS bf16_t*)(lds + OFF_VUPT); LAS float* LV0 = (LAS float*)(lds + OFF_V0);
    const int a_kind0 = wave == 2 ? 4 : wave == 3 ? 2 : wave == 4 ? 3 : wave;
    const bool a_act0 = wave < 5 || (wave == 5 && lane < 32);
    const int ga0 = wave < 5 ? lane >> 3 : (lane >> 2) & 7, c80 = wave < 5 ? lane & 7 : lane & 3;
    int a_col;
    if (a_kind0 == 0) a_col = rw::RC + h * 64 + 8 * c80; else if (a_kind0 == 1) a_col = rw::RC + 512 + h * 64 + 8 * c80; else if (a_kind0 == 4) a_col = rw::RC + 1024 + h * 64 + 8 * c80;
    else if (a_kind0 == 2) a_col = rw::RC + 1536 + dir * 64 + 8 * c80; else if (a_kind0 == 3) a_col = rw::RC + 1664 + dir * 64 + 8 * c80; else a_col = 2688 + 8 * c80;
    const int mmB0 = wave >> 2;
    float bias4[4];
    { const float* bsrc = (mmB0 == 0 ? arg_in(17) : arg_in(19)) + (size_t)(l * 2 + dir) * 512 + h * 64;
#pragma unroll
      for (int nt = 0; nt < 4; ++nt) bias4[nt] = bsrc[nt * 16 + fr]; }
    u32x4 raw[10];
    auto load_raw = [&](int ui_) {
        const int idx_ = jw * 9 + ui_, b_ = idx_ / 36, blk_ = idx_ % 36;
        const int seg_ = blk_ >= 4 ? 1 : 0, bi_ = seg_ ? blk_ - 4 : blk_, len_ = seg_ ? SEQ : CTX;
        const int lo = dir ? len_ - 8 - bi_ * 64 - 8 * ga0 : bi_ * 64 + 8 * ga0;
        const bf16_t* base = CA + (size_t)urow(seg_, b_, lo) * FS + a_col;
#pragma unroll
        for (int j = 0; j < 10; ++j) { const int pos = lo - 1 + j; raw[j] = (u32x4){0u, 0u, 0u, 0u};
            if (a_act0 && pos >= 0 && pos < len_) raw[j] = *(const u32x4*)(base + (ptrdiff_t)(j - 1) * FS); }
    };
    load_raw(0);
    bf16x8 bfrB[2][4];
    { const bf16_t* Bg = WUPg + ((size_t)((wave >> 2) * 2 + dir) * 512 + h * 64) * 64;
#pragma unroll
      for (int ks = 0; ks < 2; ++ks)
#pragma unroll
          for (int nt = 0; nt < 4; ++nt) bfrB[ks][nt] = *(const bf16x8*)(Bg + (size_t)(nt * 16 + fr) * 64 + ks * 32 + fq * 8); }
    const float* shiftw = arg_in(16) + (size_t)l * 3 * 1920;
    for (int e = tid; e < 40 * 24; e += NTHR) { const int cc = e / 24, j = (e % 24) >> 3, ee = e & 7; int col;
        if (cc < 8) col = h * 64 + 8 * cc; else if (cc < 16) col = 512 + h * 64 + 8 * (cc - 8); else if (cc < 24) col = 1024 + h * 64 + 8 * (cc - 16);
        else if (cc < 32) col = 1536 + dir * 64 + 8 * (cc - 24); else col = 1664 + dir * 64 + 8 * (cc - 32);
        CWA[e] = shiftw[j * 1920 + col + ee]; }
    if (tid < 64) { KC[tid] = arg_in(22)[l * 512 + h * 64 + tid]; KC[64 + tid] = arg_in(23)[l * 512 + h * 64 + tid]; KC[128 + tid] = arg_in(24)[l * 512 + h * 64 + tid];
        LV0[tid] = l > 0 ? arg_in(25)[(size_t)(l - 1) * 512 + h * 64 + tid] : 0.f; }
    if (l > 0) { const float* vup = arg_in(27) + (size_t)(l - 1) * 32 * 512 + h * 64;
        float tv[4];
#pragma unroll
        for (int i = 0; i < 4; ++i) { const int e = tid + i * NTHR; tv[i] = vup[(size_t)(e >> 6) * 512 + (e & 63)]; }
#pragma unroll
        for (int i = 0; i < 4; ++i) { const int e = tid + i * NTHR; VUPT[(e & 63) * VL_LD + (e >> 6)] = (bf16_t)f2bf(tv[i]); } }
    LDS_BARRIER();
    const int tid_o = tid, wave_o = wave;
    volatile LAS unsigned* MISCc = (volatile LAS unsigned*)(C.lds + LDS_MISC);
#define RSTAMP(g) do { if (TSEL1 >= 1 && tid == 0) { const unsigned _t = (unsigned)__builtin_amdgcn_s_memrealtime(); MISCc[16 + (g)] += _t - MISCc[15]; MISCc[15] = _t; } } while (0)
    for (int ui = 0; ui < 9; ++ui) {
        int tid_ = tid_o, wave_ = wave_o; asm volatile("" : "+v"(tid_), "+s"(wave_));
        const int tid = tid_, wave = wave_, lane = tid & 63, fr = lane & 15, fq = lane >> 4;
        const int idx = jw * 9 + ui, b = idx / 36, blk = idx % 36;
        const size_t ug = (size_t)((b * 8 + h) * 36 + blk);
        const int seg = blk >= 4 ? 1 : 0, bi = seg ? blk - 4 : blk, len = seg ? SEQ : CTX;
        const int ga = wave < 5 ? lane >> 3 : (lane >> 2) & 7, c8 = wave < 5 ? lane & 7 : lane & 3;
        const int kind = wave == 2 ? 4 : wave == 3 ? 2 : wave == 4 ? 3 : wave;
        u32x4 vfr = (u32x4){0u, 0u, 0u, 0u};
        if (l > 0) { const int sidx_ = bi * 64 + (tid >> 3), pos_ = dir ? len - 1 - sidx_ : sidx_; vfr = *(const u32x4*)(VF + (size_t)urow(seg, b, pos_) * 512 + h * 64 + (tid & 7) * 8); }
        if (wave < 5 || (wave == 5 && lane < 32)) {
            const int ctab = kind == 0 ? c8 : kind == 1 ? 8 + c8 : kind == 4 ? 16 + c8 : kind == 2 ? 24 + c8 : 32 + c8;
            float cwa[3][8];
            if (wave < 5) {
#pragma unroll
                for (int j = 0; j < 3; ++j) { const f32x4 c0 = *(const LAS f32x4*)(CWA + ctab * 24 + j * 8), c1 = *(const LAS f32x4*)(CWA + ctab * 24 + j * 8 + 4);
                    cwa[j][0] = c0.x; cwa[j][1] = c0.y; cwa[j][2] = c0.z; cwa[j][3] = c0.w; cwa[j][4] = c1.x; cwa[j][5] = c1.y; cwa[j][6] = c1.z; cwa[j][7] = c1.w; }
            } else {
#pragma unroll
                for (int j = 0; j < 3; ++j)
#pragma unroll
                    for (int e = 0; e < 8; ++e) cwa[j][e] = j == 1 ? 1.f : 0.f;
            }
            float x[3][8];
#pragma unroll
            for (int e = 0; e < 4; ++e) { const unsigned w0 = raw[0][e], w1 = raw[1][e]; x[0][2 * e] = bflo(w0); x[0][2 * e + 1] = bfhi(w0); x[1][2 * e] = bflo(w1); x[1][2 * e + 1] = bfhi(w1); }
#pragma unroll
            for (int j = 0; j < 8; ++j) {
#pragma unroll
                for (int e = 0; e < 4; ++e) { const unsigned w2 = raw[j + 2][e]; x[(j + 2) % 3][2 * e] = bflo(w2); x[(j + 2) % 3][2 * e + 1] = bfhi(w2); }
                float o[8];
#pragma unroll
                for (int e = 0; e < 8; ++e) o[e] = x[j % 3][e] * cwa[0][e] + x[(j + 1) % 3][e] * cwa[1][e] + x[(j + 2) % 3][e] * cwa[2][e];
                const int s = dir ? 8 * ga + 7 - j : 8 * ga + j;
                if (kind < 2 || kind == 4) { LAS float* d = (kind == 0 ? LR : kind == 1 ? LK : LVV) + s * 64 + 8 * c8;
                    *(LAS f32x4*)d = (f32x4){o[0], o[1], o[2], o[3]}; *(LAS f32x4*)(d + 4) = (f32x4){o[4], o[5], o[6], o[7]}; }
                else { u32x4 w;
                    w.x = pk2(o[0], o[1]); w.y = pk2(o[2], o[3]); w.z = pk2(o[4], o[5]); w.w = pk2(o[6], o[7]);
                    *(LAS u32x4*)(kind == 2 ? AWD + s * LD + 8 * c8 : kind == 3 ? AAD + s * LD + 8 * c8 : VLB + s * VL_LD + 8 * c8) = w; }
            }
        }
        LDS_BARRIER(); RSTAMP(20);
        {
            const int mmB = wave >> 2, mtB = wave & 3;
            LAS bf16_t* Aarr = mmB == 0 ? AWD : AAD;
            f32x4 acc[4];
#pragma unroll
            for (int nt = 0; nt < 4; ++nt) acc[nt] = (f32x4){0.f, 0.f, 0.f, 0.f};
#pragma unroll
            for (int ks = 0; ks < 2; ++ks) { bf16x8 af = ldfrag(Aarr, mtB * 16 + fr, ks * 32, lane);
                if (mmB == 0) { u32x4 aw = __builtin_bit_cast(u32x4, af);
#pragma unroll
                    for (int e = 0; e < 4; ++e) aw[e] = pk2(tanhf_(bflo(aw[e])), tanhf_(bfhi(aw[e])));
                    af = __builtin_bit_cast(bf16x8, aw); }
#pragma unroll
                for (int nt = 0; nt < 4; ++nt) acc[nt] = __builtin_amdgcn_mfma_f32_16x16x32_bf16(af, bfrB[ks][nt], acc[nt], 0, 0, 0); }
            LAS float* dst = mmB == 0 ? LW : LA;
#pragma unroll
            for (int nt = 0; nt < 4; ++nt)
#pragma unroll
                for (int j = 0; j < 4; ++j) { const float sg = sigmoidf_(bias4[nt] + acc[nt][j]);
                    dst[(mtB * 16 + fq * 4 + j) * 64 + nt * 16 + fr] = mmB == 0 ? -0.6065306597126334f * sg : sg; }
            if (l > 0) {
                const bf16x8 ag = *(const LAS bf16x8*)(VLB + (mtB * 16 + fr) * VL_LD + fq * 8);
#pragma unroll
                for (int ni = 0; ni < 2; ++ni) { const int ntg = mmB * 2 + ni;
                    const f32x4 g = __builtin_amdgcn_mfma_f32_16x16x32_bf16(ag, *(const LAS bf16x8*)(VUPT + (ntg * 16 + fr) * VL_LD + fq * 8), (f32x4){0.f, 0.f, 0.f, 0.f}, 0, 0, 0);
#pragma unroll
                    for (int j = 0; j < 4; ++j) VT[(mtB * 16 + fq * 4 + j) * LD + ntg * 16 + fr] = (bf16_t)f2bf(g[j]); }
            }
        }
        LDS_BARRIER(); RSTAMP(21);
        {
            const int ch = tid & 63, p = wave; float run = 0.f;
#pragma unroll
            for (int i = 0; i < 8; ++i) { run += LW[(8 * p + i) * 64 + ch]; LW[(8 * p + i) * 64 + ch] = run; }
            PART[p * 64 + ch] = run;
            if (l > 0) *(LAS u32x4*)(AAD + (tid >> 3) * LD + (tid & 7) * 8) = vfr;
        }
        LDS_BARRIER(); RSTAMP(22);
        {
            const int t = tid >> 3, c0 = (tid & 7) * 8;
            float L8[8], Lm8[8], k8[8], a8[8], r8[8], kkc[8], kac[8], rkc[8];
            f32x4 off4[2] = {(f32x4){0.f, 0.f, 0.f, 0.f}, (f32x4){0.f, 0.f, 0.f, 0.f}};
            for (int pp = 0; pp < wave; ++pp) { off4[0] = off4[0] + *(const LAS f32x4*)(PART + pp * 64 + c0); off4[1] = off4[1] + *(const LAS f32x4*)(PART + pp * 64 + c0 + 4); }
#pragma unroll
            for (int hh = 0; hh < 2; ++hh) {
                const f32x4 l4 = *(const LAS f32x4*)(LW + t * 64 + c0 + 4 * hh) + off4[hh], m4 = ((t & 7) ? *(const LAS f32x4*)(LW + (t - 1) * 64 + c0 + 4 * hh) : (f32x4){0.f, 0.f, 0.f, 0.f}) + off4[hh];
                const f32x4 k4 = *(const LAS f32x4*)(LK + t * 64 + c0 + 4 * hh), a4 = *(const LAS f32x4*)(LA + t * 64 + c0 + 4 * hh), r4 = *(const LAS f32x4*)(LR + t * 64 + c0 + 4 * hh);
                const f32x4 q0 = *(const LAS f32x4*)(KC + c0 + 4 * hh), q1 = *(const LAS f32x4*)(KC + 64 + c0 + 4 * hh), q2 = *(const LAS f32x4*)(KC + 128 + c0 + 4 * hh);
#pragma unroll
                for (int e = 0; e < 4; ++e) { L8[4 * hh + e] = l4[e]; Lm8[4 * hh + e] = m4[e]; k8[4 * hh + e] = k4[e]; a8[4 * hh + e] = a4[e]; r8[4 * hh + e] = r4[e]; kkc[4 * hh + e] = q0[e]; kac[4 * hh + e] = q1[e]; rkc[4 * hh + e] = q2[e]; }
            }
            float n2 = 0.f, bo = 0.f, kkv[8], kd[8];
#pragma unroll
            for (int e = 0; e < 8; ++e) { kkv[e] = k8[e] * kkc[e]; n2 += kkv[e] * kkv[e]; kd[e] = k8[e] * (1.0f + (a8[e] - 1.0f) * kac[e]); bo += r8[e] * kd[e] * rkc[e]; }
            n2 += DPP_MOV(n2, 0xB1); n2 += DPP_MOV(n2, 0x4E); n2 += DPP_MOV(n2, 0x141);
            bo += DPP_MOV(bo, 0xB1); bo += DPP_MOV(bo, 0x4E); bo += DPP_MOV(bo, 0x141);
            const float inv = __builtin_amdgcn_rcpf(fmaxf(sqrtf(n2), 1e-12f));
            float okp[8], obt[8], okt[8], ort[8], eg8[8];
#pragma unroll
            for (int e = 0; e < 8; ++e) { const float eg = __expf(L8[e]), egi = __builtin_amdgcn_rcpf(eg), kap = kkv[e] * inv;
                eg8[e] = eg; okp[e] = kap * __expf(Lm8[e]); obt[e] = kap * a8[e] * egi; okt[e] = kd[e] * egi; ort[e] = r8[e] * eg; }
            u32x4 w;
            w.x = pk2(okp[0], okp[1]); w.y = pk2(okp[2], okp[3]); w.z = pk2(okp[4], okp[5]); w.w = pk2(okp[6], okp[7]); *(LAS u32x4*)(KP + t * LD + c0) = w;
            w.x = pk2(obt[0], obt[1]); w.y = pk2(obt[2], obt[3]); w.z = pk2(obt[4], obt[5]); w.w = pk2(obt[6], obt[7]); *(LAS u32x4*)(BT + t * LD + c0) = w;
            w.x = pk2(okt[0], okt[1]); w.y = pk2(okt[2], okt[3]); w.z = pk2(okt[4], okt[5]); w.w = pk2(okt[6], okt[7]); *(LAS u32x4*)(KT + t * LD + c0) = w;
            w.x = pk2(ort[0], ort[1]); w.y = pk2(ort[2], ort[3]); w.z = pk2(ort[4], ort[5]); w.w = pk2(ort[6], ort[7]); *(LAS u32x4*)(RT + t * LD + c0) = w;
            if (t == 63) { *(LAS f32x4*)(LGC + c0) = (f32x4){eg8[0], eg8[1], eg8[2], eg8[3]}; *(LAS f32x4*)(LGC + c0 + 4) = (f32x4){eg8[4], eg8[5], eg8[6], eg8[7]}; }
            if ((tid & 7) == 0) { const int sidx = bi * 64 + t, pos = dir ? len - 1 - sidx : sidx; BON[((size_t)dir * T_ALL + urow(seg, b, pos)) * 8 + h] = bo; }
            const int vr = tid & 63, s8 = tid >> 6;
            const float v0c = LV0[vr];
#pragma unroll
            for (int it = 0; it < 8; ++it) {
                const int s = s8 + 8 * it;
                float v = LVV[s * 64 + vr];
                if (l > 0) { const float g = v0c + bf2f(VT[s * LD + vr]); v = v + (bf2f(AAD[s * LD + vr]) - v) * sigmoidf_(g); }
                VT[s * LD + vr] = (bf16_t)f2bf(v);
            }
        }
        LDS_BARRIER(); RSTAMP(23);
        if (dir == 0) { const int s_ = tid >> 3; *(u32x4*)((l > 0 ? VM : VF) + (size_t)urow(seg, b, bi * 64 + s_) * 512 + h * 64 + (tid & 7) * 8) = *(const LAS u32x4*)(VT + s_ * LD + (tid & 7) * 8); }
        {
            const int mmE = wave >> 1;
            LAS const bf16_t* Ao = (mmE == 0 || mmE == 3) ? BT : KT; LAS const bf16_t* Bo = (mmE < 2) ? KP : RT;
#pragma unroll
            for (int mi = 0; mi < 2; ++mi) { const int mt = (wave & 1) * 2 + mi;
                f32x4 acc[4];
#pragma unroll
                for (int nt = 0; nt < 4; ++nt) acc[nt] = (f32x4){0.f, 0.f, 0.f, 0.f};
#pragma unroll
                for (int ks = 0; ks < 2; ++ks) { const bf16x8 af = ldfrag(Ao, mt * 16 + fr, ks * 32, lane);
#pragma unroll
                    for (int nt = 0; nt < 4; ++nt) acc[nt] = __builtin_amdgcn_mfma_f32_16x16x32_bf16(af, ldfrag(Bo, nt * 16 + fr, ks * 32, lane), acc[nt], 0, 0, 0); }
#pragma unroll
                for (int nt = 0; nt < 4; ++nt) { const int t = nt * 16 + fr, j0 = mt * 16 + fq * 4; float m[4];
                    float zf = 0.f; asm volatile("" : "+v"(zf));
#pragma unroll
                    for (int j = 0; j < 4; ++j) m[j] = (mmE < 2 ? (j0 + j < t) : (j0 + j <= t)) ? acc[nt][j] : zf;
                    if (mmE == 0) *(LAS f32x4*)(ABT + t * 68 + j0) = (f32x4){m[0], m[1], m[2], m[3]};
                    else { u32x2 w; w.x = pk2(m[0], m[1]); w.y = pk2(m[2], m[3]); *(LAS u32x2*)((mmE == 1 ? AKT : mmE == 2 ? MKT : MBT) + t * LD + j0) = w; } }
            }
        }
        LDS_BARRIER(); RSTAMP(24);
        LAS float* TF = (LAS float*)(lds + OFF_TF); LAS float* WS = (LAS float*)(lds + OFF_WS);
        typedef float f32x4_ __attribute__((ext_vector_type(4)));
#define RC_PROD_TF_M(acc, a_, k_, c_) do { _Pragma("unroll") for (int ks = 0; ks < 4; ++ks) acc = __builtin_amdgcn_mfma_f32_16x16x4f32(TF[(16 * (a_) + fr) * 68 + 16 * (k_) + 4 * ks + fq], ABT[(16 * (c_) + fr) * 68 + 16 * (k_) + 4 * ks + fq], acc, 0, 0, 0); } while (0)
#define RC_PROD_WS_TF(acc, wslot, k_, c_) do { _Pragma("unroll") for (int ks = 0; ks < 4; ++ks) acc = __builtin_amdgcn_mfma_f32_16x16x4f32(WS[((wslot) * 16 + fr) * 17 + 4 * ks + fq], TF[(16 * (k_) + 4 * ks + fq) * 68 + 16 * (c_) + fr], acc, 0, 0, 0); } while (0)
#define RC_PUT_WS(acc, wslot) do { _Pragma("unroll") for (int j = 0; j < 4; ++j) WS[((wslot) * 16 + fq * 4 + j) * 17 + fr] = acc[j]; } while (0)
#define RC_PUT_TF_NEG(acc, a_, c_) do { _Pragma("unroll") for (int j = 0; j < 4; ++j) TF[(16 * (a_) + fq * 4 + j) * 68 + 16 * (c_) + fr] = -acc[j]; \
        u32x2 _w; _w.x = pk2(-acc[0], -acc[1]); _w.y = pk2(-acc[2], -acc[3]); *(LAS u32x2*)(TTT + (16 * (c_) + fr) * LD + 16 * (a_) + fq * 4) = _w; } while (0)
        if (wave == 0) {
            const int bb = lane >> 4, ii = lane & 15;
            float Dr[16];
#pragma unroll
            for (int c = 0; c < 16; ++c) {
                float m[16];
#pragma unroll
                for (int j4 = 0; j4 < (c + 3) / 4; ++j4) { const f32x4 mv = *(const LAS f32x4*)(ABT + (16 * bb + c) * 68 + 16 * bb + 4 * j4); m[4 * j4] = mv.x; m[4 * j4 + 1] = mv.y; m[4 * j4 + 2] = mv.z; m[4 * j4 + 3] = mv.w; }
                float a0 = (ii == c) ? 1.0f : 0.f, a1 = 0.f;
#pragma unroll
                for (int j = 0; j < c; ++j) { if (j & 1) a1 -= Dr[j] * m[j]; else a0 -= Dr[j] * m[j]; }
                Dr[c] = a0 + a1;
            }
#pragma unroll
            for (int c = 0; c < 16; ++c) { TF[(16 * bb + ii) * 68 + 16 * bb + c] = Dr[c]; TTT[(16 * bb + c) * LD + 16 * bb + ii] = (bf16_t)f2bf(Dr[c]); }
        } else if (wave >= 5) {
            for (int e = tid - 320; e < 6 * 256; e += 192) { const int bk = e >> 8, w = e & 255; const int tb = bk < 3 ? 0 : bk < 5 ? 1 : 2, rb = bk < 3 ? bk + 1 : bk < 5 ? bk - 1 : 3;
                TTT[(16 * tb + (w >> 4)) * LD + 16 * rb + (w & 15)] = 0; }
        } else {
            const int mt = wave - 1;
            f32x4 acc[4];
#pragma unroll
            for (int nt = 0; nt < 4; ++nt) acc[nt] = (f32x4){0.f, 0.f, 0.f, 0.f};
#pragma unroll
            for (int ks = 0; ks < 2; ++ks) { const bf16x8 af = trfrag<LD>(VT, ks * 32, mt * 16, lane);
#pragma unroll
                for (int nt = 0; nt < 4; ++nt) acc[nt] = __builtin_amdgcn_mfma_f32_16x16x32_bf16(af, ldfrag(AKT, nt * 16 + fr, ks * 32, lane), acc[nt], 0, 0, 0); }
#pragma unroll
            for (int nt = 0; nt < 4; ++nt)
#pragma unroll
                for (int j = 0; j < 4; ++j) XX[(mt * 16 + fq * 4 + j) * LD + nt * 16 + fr] = (bf16_t)f2bf(acc[nt][j]);
        }
        LDS_BARRIER(); RSTAMP(25);
        if (wave < 2) {
            const int a_ = 2 * wave, c_ = 2 * wave + 1;
            f32x4_ w = {0.f, 0.f, 0.f, 0.f}; RC_PROD_TF_M(w, a_, a_, c_); RC_PUT_WS(w, wave);
            f32x4_ t = {0.f, 0.f, 0.f, 0.f}; RC_PROD_WS_TF(t, wave, c_, c_); RC_PUT_TF_NEG(t, a_, c_);
        }
        LDS_BARRIER(); RSTAMP(26);
        if (wave < 2) {
            const int a_ = wave;
            f32x4_ w2 = {0.f, 0.f, 0.f, 0.f}, w3 = {0.f, 0.f, 0.f, 0.f};
            if (a_ == 0) { RC_PROD_TF_M(w2, 0, 0, 2); RC_PROD_TF_M(w3, 0, 0, 3); }
            RC_PROD_TF_M(w2, a_, 1, 2); RC_PROD_TF_M(w3, a_, 1, 3);
            RC_PUT_WS(w2, 2 * a_); RC_PUT_WS(w3, 2 * a_ + 1);
            f32x4_ t2 = {0.f, 0.f, 0.f, 0.f}, t3 = {0.f, 0.f, 0.f, 0.f};
            RC_PROD_WS_TF(t2, 2 * a_, 2, 2); RC_PROD_WS_TF(t3, 2 * a_, 2, 3); RC_PROD_WS_TF(t3, 2 * a_ + 1, 3, 3);
            RC_PUT_TF_NEG(t2, a_, 2); RC_PUT_TF_NEG(t3, a_, 3);
        }
#undef RC_PROD_TF_M
#undef RC_PROD_WS_TF
#undef RC_PUT_WS
#undef RC_PUT_TF_NEG
        LDS_BARRIER(); RSTAMP(27);
        if (ui + 1 < 9) load_raw(ui + 1);
        {
            const bool isz = wave >= 4; const int mt = wave & 3;
            bf16x8 af[2], bt[2][4];
            if (isz) { af[0] = ldfrag(XX, mt * 16 + fr, 0, lane); af[1] = ldfrag(XX, mt * 16 + fr, 32, lane); } else rc::trfrag2k<LD>(KP, mt * 16, lane, af);
#pragma unroll
            for (int ks = 0; ks < 2; ++ks)
#pragma unroll
                for (int nt = 0; nt < 4; ++nt) bt[ks][nt] = ldfrag(TTT, nt * 16 + fr, ks * 32, lane);
            f32x4 acc[4];
#pragma unroll
            for (int nt = 0; nt < 4; ++nt) acc[nt] = (f32x4){0.f, 0.f, 0.f, 0.f};
#pragma unroll
            for (int ks = 0; ks < 2; ++ks)
#pragma unroll
                for (int nt = 0; nt < 4; ++nt) acc[nt] = __builtin_amdgcn_mfma_f32_16x16x32_bf16(af[ks], bt[ks][nt], acc[nt], 0, 0, 0);
            LAS bf16_t* dst = isz ? NZ : WU; const float sgn = isz ? -1.f : 1.f;
#pragma unroll
            for (int nt = 0; nt < 4; ++nt)
#pragma unroll
                for (int j = 0; j < 4; ++j) dst[(mt * 16 + fq * 4 + j) * LD + nt * 16 + fr] = (bf16_t)f2bf(sgn * acc[nt][j]);
        }
        LDS_BARRIER(); RSTAMP(28);
        {
            const int hi = wave >> 2, mt = wave & 3;
            bf16x8 wu[2], az[2], av[2];
#pragma unroll
            for (int ks = 0; ks < 2; ++ks) { wu[ks] = ldfrag(WU, mt * 16 + fr, ks * 32, lane); az[ks] = ldfrag(NZ, mt * 16 + fr, ks * 32, lane); }
            rc::trfrag2k<LD>(VT, mt * 16, lane, av);
            f32x4 acc[4], facc[4];
#pragma unroll
            for (int nt = 0; nt < 4; ++nt) { acc[nt] = (f32x4){0.f, 0.f, 0.f, 0.f}; facc[nt] = (f32x4){0.f, 0.f, 0.f, 0.f}; }
#pragma unroll
            for (int ks = 0; ks < 2; ++ks) {
                bf16x8 b1[4], b2[4];
                if (hi == 0) {
#pragma unroll
                    for (int nt = 0; nt < 4; ++nt) { b1[nt] = ldfrag(MKT, nt * 16 + fr, ks * 32, lane); b2[nt] = ldfrag(MBT, nt * 16 + fr, ks * 32, lane); }
                } else { rc::trfrag4<LD>(KT, ks * 32, lane, b1); rc::trfrag4<LD>(BT, ks * 32, lane, b2); }
#pragma unroll
                for (int nt = 0; nt < 4; ++nt) {
                    acc[nt] = __builtin_amdgcn_mfma_f32_16x16x32_bf16(wu[ks], b2[nt], acc[nt], 0, 0, 0);
                    facc[nt] = __builtin_amdgcn_mfma_f32_16x16x32_bf16(av[ks], b1[nt], facc[nt], 0, 0, 0); facc[nt] = __builtin_amdgcn_mfma_f32_16x16x32_bf16(az[ks], b2[nt], facc[nt], 0, 0, 0); }
            }
#pragma unroll
            for (int nt = 0; nt < 4; ++nt) { const int cn = nt * 16 + fr, a0 = mt * 16 + fq * 4; float o[4];
                if (hi) { const float gc = LGC[cn];
#pragma unroll
                    for (int j = 0; j < 4; ++j) o[j] = (((a0 + j) == cn ? 1.0f : 0.f) - acc[nt][j]) * gc; }
                else { const u32x2 rv = *(const LAS u32x2*)(RT + cn * LD + a0); o[0] = bflo(rv.x) - acc[nt][0]; o[1] = bfhi(rv.x) - acc[nt][1]; o[2] = bflo(rv.y) - acc[nt][2]; o[3] = bfhi(rv.y) - acc[nt][3]; }
                u32x2 w; w.x = pk2(o[0], o[1]); w.y = pk2(o[2], o[3]); *(u32x2*)(WYG + bpart(b, (hi ? 288 : 0) + h * 36 + blk, 4096) + cn * 64 + a0) = w;
            }
#pragma unroll
            for (int nt = 0; nt < 4; ++nt) { const int cn = nt * 16 + fr, v0 = mt * 16 + fq * 4; u32x2 w;
                if (hi == 0) { w.x = pk2(facc[nt][0], facc[nt][1]); w.y = pk2(facc[nt][2], facc[nt][3]);
                    const int sidx = bi * 64 + cn, pos = dir ? len - 1 - sidx : sidx;
                    *(u32x2*)(Y + (size_t)urow(seg, b, pos) * 1024 + dir * 512 + h * 64 + v0) = w; }
                else { const float gc = LGC[cn]; w.x = pk2(facc[nt][0] * gc, facc[nt][1] * gc); w.y = pk2(facc[nt][2] * gc, facc[nt][3] * gc);
                    *(u32x2*)(QG + (size_t)b * 2097152 + (size_t)(h * 36 + blk) * 4096 + cn * 64 + v0) = w; } }
        }
        LDS_BARRIER(); RSTAMP(29);
    }
}
template <int FIN>
__device__ __forceinline__ void r2_chain(Ctx& C, int dir, int b, int h, int qr) {
    using namespace r1; using rc::ldfrag;
    const int tid = C.tid, lane = C.lane, wave = C.wave, fr = lane & 15, fq = lane >> 4;
    bf16_t* Y = (bf16_t*)(C.ws + WS_F2);
    const bf16_t* WYG = (const bf16_t*)(C.ws + WS_WYG); const bf16_t* PTG = (const bf16_t*)(C.ws + WS_PTG); const bf16_t* QG = (const bf16_t*)(C.ws + WS_QG);
    LAS bf16_t* S0B = (LAS bf16_t*)C.lds;
    for (int e = tid; e < 2 * 16 * LD; e += NTHR) S0B[e] = 0;
    const int nt = wave & 3, cn = nt * 16 + fr, v0 = qr * 16 + fq * 4;
    const size_t ug0 = (size_t)((b * 8 + h) * 36);
    bf16x8 bwq[4][2]; u32x2 iniq[4];
#define R2_LOAD(slot, blk_) do { const int _bk = (blk_); const bf16_t* _M = WYG + bpart(b, (FIN == 0 ? 0 : 288) + h * 36 + _bk, 4096); \
        bwq[slot][0] = *(const bf16x8*)(_M + cn * 64 + fq * 8); bwq[slot][1] = *(const bf16x8*)(_M + cn * 64 + 32 + fq * 8); \
        if (FIN == 0) { const int _seg = _bk >= 4 ? 1 : 0, _bi = _seg ? _bk - 4 : _bk, _len = _seg ? SEQ : CTX, _sidx = _bi * 64 + cn, _pos = dir ? _len - 1 - _sidx : _sidx; \
            iniq[slot] = *(const u32x2*)(Y + (size_t)urow(_seg, b, _pos) * 1024 + dir * 512 + h * 64 + v0); } \
        else iniq[slot] = *(const u32x2*)(QG + (size_t)b * 2097152 + (size_t)(h * 36 + _bk) * 4096 + cn * 64 + v0); } while (0)
    R2_LOAD(0, 0); R2_LOAD(1, 1); R2_LOAD(2, 2); R2_LOAD(3, 3);
    LDS_BARRIER();
#pragma unroll 1
    for (int blk0 = 0; blk0 < 36; blk0 += 4) {
#pragma unroll
        for (int p = 0; p < 4; ++p) {
            const int blk = blk0 + p;
            LAS bf16_t* S0cur = S0B + (p & 1) * 16 * LD; LAS bf16_t* S0nxt = S0B + ((p + 1) & 1) * 16 * LD;
            const u32x2 ini = iniq[p];
            f32x4 acc = (f32x4){bflo(ini.x), bfhi(ini.x), bflo(ini.y), bfhi(ini.y)};
            const bf16x8 b0 = bwq[p][0], b1 = bwq[p][1];
            const int seg = blk >= 4 ? 1 : 0, bi = seg ? blk - 4 : blk, len = seg ? SEQ : CTX, sidx = bi * 64 + cn, pos = dir ? len - 1 - sidx : sidx;
            bf16_t* yp = Y + (size_t)urow(seg, b, pos) * 1024 + dir * 512 + h * 64 + v0;
            acc = __builtin_amdgcn_mfma_f32_16x16x32_bf16(ldfrag(S0cur, fr, 0, lane), b0, acc, 0, 0, 0);
            acc = __builtin_amdgcn_mfma_f32_16x16x32_bf16(ldfrag(S0cur, fr, 32, lane), b1, acc, 0, 0, 0);
            R2_LOAD(p, blk + 4 < 36 ? blk + 4 : 35);
            if (FIN == 0) { u32x2 w; w.x = pk2(acc[0], acc[1]); w.y = pk2(acc[2], acc[3]); *(u32x2*)yp = w; }
            else {
#pragma unroll
                for (int j = 0; j < 4; ++j) S0nxt[(fq * 4 + j) * LD + cn] = (bf16_t)f2bf(acc[j]); }
            LDS_BARRIER();
        }
    }
#undef R2_LOAD
}
__device__ __forceinline__ void phase_rwkv_r2(Ctx& C, int l, int dir) {
    C.refresh();
    const int h = (C.bid >> 3) & 7, qr = C.bid >> 6, b = C.bid & 7;
    if ((C.wave >> 2) == 0) r2_chain<0>(C, dir, b, h, qr); else r2_chain<1>(C, dir, b, h, qr);
}

__device__ __forceinline__ void phase_rwkv_out(Ctx& C, int l, int unit_lo) {
    C.refresh();
    const int tid = C.tid, lane = C.lane, wave = C.wave;
    constexpr int OFF_AG = 0, AG_LD = 136, OFF_PRE = 17408, PRE_LD = 520;
    LAS bf16_t* AG = (LAS bf16_t*)(C.lds + OFF_AG); LAS bf16_t* PRE = (LAS bf16_t*)(C.lds + OFF_PRE);
    const bf16_t* CA = (const bf16_t*)(C.ws + WS_F);
    const bf16_t* Y = (const bf16_t*)(C.ws + WS_F2);
    const bf16_t* VV = (const bf16_t*)(C.ws + (l == 0 ? WS_VFIRST : WS_VMIX));
    const float* BON = (const float*)(C.ws + WS_BONUS);
    const bf16_t* GUP = (const bf16_t*)(C.ws + WS_W + W_GUP);
    bf16_t* AO = (bf16_t*)(C.ws + WS_AO);
    const float* shiftw = arg_in(16) + (size_t)l * 3 * 1920;
    const float* gnw = arg_in(28) + (size_t)l * 512; const float* gnb = arg_in(29) + (size_t)l * 512;
    const int cg = tid & 127, sg0 = tid >> 7;
    float cw_g[3];
#pragma unroll
    for (int j = 0; j < 3; ++j) cw_g[j] = shiftw[j * 1920 + 1792 + cg];
    const int fr = lane & 15, fq = lane >> 4;
    const bool bal = C.G == 256; const int jb = C.bid >> 3;
    const int cu = jb == 0 ? 0 : jb == 15 ? 1 : jb == 16 ? 2 : jb == 31 ? 3 : -1;
    for (int u = bal ? 0 : unit_lo + C.bid; u < (bal ? ((unit_lo == 0 && cu >= 0) ? 2 : 1) : T_ALL / 64); u += bal ? 1 : C.G) {
        const int row0 = bal ? (u == 0 ? T_CTX + (C.bid & 7) * SEQ + jb * 64 : (C.bid & 7) * CTX + cu * 64) : u * 64;
        const int seg = row0 >= T_CTX ? 1 : 0, len = seg ? SEQ : CTX, pos0 = seg ? ((row0 - T_CTX) & (SEQ - 1)) : (row0 & (CTX - 1));
        __syncthreads();
#pragma unroll 1
        for (int it0 = 0; it0 < 16; it0 += 4) {
            bf16_t xr[4][3];
#pragma unroll
            for (int k = 0; k < 4; ++k) { const int s = sg0 + 4 * (it0 + k), pos = pos0 + s;
                const bf16_t* r0 = CA + (size_t)(row0 + s) * FS + rw::RC + 1792 + cg;
                xr[k][0] = r0[pos >= 1 ? -FS : 0]; xr[k][1] = r0[0]; xr[k][2] = r0[pos + 1 < len ? FS : 0]; }
#pragma unroll
            for (int k = 0; k < 4; ++k) { const int s = sg0 + 4 * (it0 + k), pos = pos0 + s;
                const float xm = pos >= 1 ? bf2f(xr[k][0]) : 0.f, xp = pos + 1 < len ? bf2f(xr[k][2]) : 0.f;
                AG[s * AG_LD + cg] = (bf16_t)f2bf(sigmoidf_(xm * cw_g[0] + bf2f(xr[k][1]) * cw_g[1] + xp * cw_g[2])); }
        }
#pragma unroll 1
        for (int pass = 0; pass < 2; ++pass) {
            const int pr = (tid >> 1) + pass * 256, s = pr >> 3, hh = pr & 7, row = row0 + s, hf = tid & 1;
            const u32x4* yf = (const u32x4*)(Y + (size_t)row * 1024 + hh * 64 + hf * 32); const u32x4* yb = (const u32x4*)(Y + (size_t)row * 1024 + 512 + hh * 64 + hf * 32);
            float y[32]; float sum = 0.f;
            u32x4 ya[4], yq[4], vq[4];
            const u32x4* vv = (const u32x4*)(VV + (size_t)row * 512 + hh * 64 + hf * 32);
#pragma unroll
            for (int k = 0; k < 4; ++k) { ya[k] = yf[k]; yq[k] = yb[k]; vq[k] = vv[k]; }
            const float bon = BON[(size_t)row * 8 + hh] + BON[((size_t)T_ALL + row) * 8 + hh];
#pragma unroll
            for (int k = 0; k < 4; ++k) { const u32x4 a = ya[k], bq = yq[k];
                y[8 * k + 0] = bflo(a.x) + bflo(bq.x); y[8 * k + 1] = bfhi(a.x) + bfhi(bq.x); y[8 * k + 2] = bflo(a.y) + bflo(bq.y); y[8 * k + 3] = bfhi(a.y) + bfhi(bq.y);
                y[8 * k + 4] = bflo(a.z) + bflo(bq.z); y[8 * k + 5] = bfhi(a.z) + bfhi(bq.z); y[8 * k + 6] = bflo(a.w) + bflo(bq.w); y[8 * k + 7] = bfhi(a.w) + bfhi(bq.w); }
#pragma unroll
            for (int k = 0; k < 32; ++k) sum += y[k];
            sum += DPP_MOV(sum, 0xB1);
            const float mean = sum * (1.0f / 64.0f); float var = 0.f;
#pragma unroll
            for (int k = 0; k < 32; ++k) { y[k] -= mean; var += y[k] * y[k]; }
            var += DPP_MOV(var, 0xB1);
            const float rstd = 1.0f / sqrtf(var * (1.0f / 64.0f) + 64e-5f);
            const f32x4* gw4 = (const f32x4*)(gnw + hh * 64 + hf * 32); const f32x4* gb4 = (const f32x4*)(gnb + hh * 64 + hf * 32);
#pragma unroll
            for (int k = 0; k < 4; ++k) { const u32x4 v = vq[k]; const f32x4 w0 = gw4[2 * k], w1 = gw4[2 * k + 1], b0 = gb4[2 * k], b1 = gb4[2 * k + 1];
                u32x4 o;
                const float ys = RW_DBG == 4 ? 0.f : rstd, bs = RW_DBG == 5 ? 0.f : bon;
                o.x = pk2(y[8 * k + 0] * ys * w0.x + b0.x + bs * bflo(v.x), y[8 * k + 1] * ys * w0.y + b0.y + bs * bfhi(v.x));
                o.y = pk2(y[8 * k + 2] * ys * w0.z + b0.z + bs * bflo(v.y), y[8 * k + 3] * ys * w0.w + b0.w + bs * bfhi(v.y));
                o.z = pk2(y[8 * k + 4] * ys * w1.x + b1.x + bs * bflo(v.z), y[8 * k + 5] * ys * w1.y + b1.y + bs * bfhi(v.z));
                o.w = pk2(y[8 * k + 6] * ys * w1.z + b1.z + bs * bflo(v.w), y[8 * k + 7] * ys * w1.w + b1.w + bs * bfhi(v.w));
                *(LAS u32x4*)(PRE + s * PRE_LD + hh * 64 + hf * 32 + 8 * k) = o; }
        }
        bf16x8 gupf[4][4];
#pragma unroll
        for (int ks = 0; ks < 4; ++ks)
#pragma unroll
            for (int nt = 0; nt < 4; ++nt) gupf[ks][nt] = *(const bf16x8*)(GUP + (size_t)(wave * 64 + nt * 16 + fr) * 128 + ks * 32 + fq * 8);
        __syncthreads();
        {
            f32x4 acc[4][4];
#pragma unroll
            for (int mt = 0; mt < 4; ++mt)
#pragma unroll
                for (int nt = 0; nt < 4; ++nt) acc[mt][nt] = (f32x4){0.f, 0.f, 0.f, 0.f};
#pragma unroll
            for (int ks = 0; ks < 4; ++ks) {
                bf16x8 af[4], bfr[4];
#pragma unroll
                for (int mt = 0; mt < 4; ++mt) af[mt] = *(const LAS bf16x8*)(AG + (mt * 16 + fr) * AG_LD + ks * 32 + fq * 8);
#pragma unroll
                for (int nt = 0; nt < 4; ++nt) bfr[nt] = gupf[ks][nt];
#pragma unroll
                for (int mt = 0; mt < 4; ++mt)
#pragma unroll
                    for (int nt = 0; nt < 4; ++nt) acc[mt][nt] = __builtin_amdgcn_mfma_f32_16x16x32_bf16(bfr[nt], af[mt], acc[mt][nt], 0, 0, 0);
            }
#pragma unroll
            for (int mt = 0; mt < 4; ++mt)
#pragma unroll
                for (int nt = 0; nt < 4; ++nt) { LAS u32x2* pp = (LAS u32x2*)(PRE + (mt * 16 + fr) * PRE_LD + wave * 64 + nt * 16 + fq * 4);
                    const u32x2 pv = *pp; u32x2 w;
                    w.x = pk2(bflo(pv.x) * acc[mt][nt][0], bfhi(pv.x) * acc[mt][nt][1]); w.y = pk2(bflo(pv.y) * acc[mt][nt][2], bfhi(pv.y) * acc[mt][nt][3]);
                    *pp = w; }
        }
        __syncthreads();
#pragma unroll 2
        for (int i = 0; i < 8; ++i) { const int e = tid + i * NTHR, sr = e >> 6, ch = e & 63;
            *(u32x4*)(AO + (size_t)(row0 + sr) * 1024 + 512 + ch * 8) = *(const LAS u32x4*)(PRE + sr * PRE_LD + ch * 8); }
    }
}

__device__ __forceinline__ void phase_attention(Ctx& C, int l, bool with_ctx_units) {
    C.refresh();
    const int tid = C.tid, lane = C.lane, wave = C.wave, fr = lane & 15, fq = lane >> 4;
    constexpr int KS_LD = 72, VT_LD = 136, P_LD = 136, OFF_KS = 0, OFF_VT = 18432, OFF_P = 35840;
    LAS bf16_t* KS = (LAS bf16_t*)(C.lds + OFF_KS); LAS bf16_t* VT = (LAS bf16_t*)(C.lds + OFF_VT);
    LAS bf16_t* PW = (LAS bf16_t*)(C.lds + OFF_P + wave * (16 * P_LD * 2));
    const bf16_t* CA = (const bf16_t*)(C.ws + WS_F);
    bf16_t* AO = (bf16_t*)(C.ws + WS_AO);
    const int nunits = 256 + (with_ctx_units ? 32 : 0);
    const int g = wave >> 1, qhalf = wave & 1;
    for (int ui2 = 0; ui2 < 2; ++ui2) {
        int b, kvh, qb, qseg;
        if (C.G == 256) {
            const int j = C.bid >> 3; b = C.bid & 7;
            if (ui2 == 0) { qseg = 1; kvh = j >> 4; qb = j & 15; } else { if (!with_ctx_units || j < 4 || j >= 8) break; qseg = 0; kvh = (j - 4) >> 1; qb = j & 1; }
        } else {
            const int u = ui2 == 0 ? C.bid : (C.bid >= 32 && C.bid < 64 ? 256 + C.bid - 32 : nunits);
            if (u >= nunits) break;
            if (u < 256) { qseg = 1; b = u >> 5; kvh = (u >> 4) & 1; qb = u & 15; } else { const int v = u - 256; qseg = 0; b = v >> 2; kvh = (v >> 1) & 1; qb = v & 1; }
        }
        const int qhead = kvh * 4 + g;
        const float sink = arg_in(15)[l * 8 + qhead] * 1.4426950408889634f;
        bf16x8 qf[4][2];
        const int qrow0 = urow(qseg, b, qb * 128 + qhalf * 64);
#pragma unroll
        for (int mt = 0; mt < 4; ++mt)
#pragma unroll
            for (int ks = 0; ks < 2; ++ks) qf[mt][ks] = *(const bf16x8*)(CA + (size_t)(qrow0 + mt * 16 + fr) * FS + qhead * 64 + ks * 32 + fq * 8);
        f32x4 O[4][4]; float mrow[4], lrow[4];
#pragma unroll
        for (int mt = 0; mt < 4; ++mt) { mrow[mt] = sink; lrow[mt] = 1.0f;
#pragma unroll
            for (int j = 0; j < 4; ++j) O[mt][j] = (f32x4){0.f, 0.f, 0.f, 0.f}; }
        const int sx16 = (lane ^ 16) << 2, sx32 = (lane ^ 32) << 2;
        const int nkb = qseg ? 5 : 2;
        for (int kbi = 0; kbi < nkb; ++kbi) {
            int kseg, kblk;
            if (qseg) { if (kbi < 3) { kseg = 1; kblk = qb - 1 + kbi; } else { kseg = 0; kblk = kbi - 3; } } else { kseg = 0; kblk = kbi; }
            if (kseg == 1 && (kblk < 0 || kblk > 15)) continue;
            {
                const int krow0 = urow(kseg, b, kblk * 128);
                u32x4 kvr[2], vvr[2];
#pragma unroll
                for (int i = 0; i < 2; ++i) { const int e = tid + i * NTHR, kr = e & 127, ch = e >> 7;
                    const bf16_t* src = CA + (size_t)(krow0 + kr) * FS;
                    kvr[i] = *(const u32x4*)(src + 512 + kvh * 64 + ch * 8); vvr[i] = *(const u32x4*)(src + 640 + kvh * 64 + ch * 8); }
                __syncthreads();
#pragma unroll
                for (int i = 0; i < 2; ++i) { const int e = tid + i * NTHR, kr = e & 127, ch = e >> 7;
                    const u32x4 kv = kvr[i], vv = vvr[i];
                    *(LAS u32x4*)(KS + kr * KS_LD + ch * 8) = kv;
                    const int krp = (kr & ~31) | ((((kr & 15) >> 2) << 3) + (kr & 3) + (((kr >> 4) & 1) << 2));
                    LAS bf16_t* vd = VT + (ch * 8) * VT_LD + krp;
                    vd[0 * VT_LD] = (bf16_t)(vv.x & 0xffff); vd[1 * VT_LD] = (bf16_t)(vv.x >> 16); vd[2 * VT_LD] = (bf16_t)(vv.y & 0xffff); vd[3 * VT_LD] = (bf16_t)(vv.y >> 16);
                    vd[4 * VT_LD] = (bf16_t)(vv.z & 0xffff); vd[5 * VT_LD] = (bf16_t)(vv.z >> 16); vd[6 * VT_LD] = (bf16_t)(vv.w & 0xffff); vd[7 * VT_LD] = (bf16_t)(vv.w >> 16); }
            }
            __syncthreads();
            const bool windowed = (qseg == 1 && kseg == 1);
            const int dblk = (kblk - qb) * 128;
#pragma unroll
            for (int mt = 0; mt < 4; ++mt) {
                f32x4 S[8];
#pragma unroll
                for (int nt = 0; nt < 8; ++nt) S[nt] = (f32x4){0.f, 0.f, 0.f, 0.f};
#pragma unroll
                for (int ks = 0; ks < 2; ++ks)
#pragma unroll
                    for (int nt = 0; nt < 8; ++nt) { const bf16x8 kf = *(const LAS bf16x8*)(KS + (nt * 16 + fr) * KS_LD + ks * 32 + fq * 8);
                        S[nt] = __builtin_amdgcn_mfma_f32_16x16x32_bf16(kf, qf[mt][ks], S[nt], 0, 0, 0); }
                if (windowed) {
#pragma unroll
                    for (int nt = 0; nt < 8; ++nt)
#pragma unroll
                        for (int j = 0; j < 4; ++j) { const int d = dblk + (nt * 16 + fq * 4 + j) - (qhalf * 64 + mt * 16 + fr); if (d > 128 || d < -128) S[nt][j] = -1e30f; }
                }
                float mx = S[0][0];
#pragma unroll
                for (int nt = 0; nt < 8; ++nt)
#pragma unroll
                    for (int j = 0; j < 4; ++j) mx = fmaxf(mx, S[nt][j]);
                mx = fmaxf(mx, __builtin_bit_cast(float, __builtin_amdgcn_ds_bpermute(sx16, __builtin_bit_cast(int, mx))));
                mx = fmaxf(mx, __builtin_bit_cast(float, __builtin_amdgcn_ds_bpermute(sx32, __builtin_bit_cast(int, mx))));
                const float mn = fmaxf(mrow[mt], mx), alpha = __builtin_amdgcn_exp2f(mrow[mt] - mn);
                mrow[mt] = mn;
#pragma unroll
                for (int nd = 0; nd < 4; ++nd) O[mt][nd] = O[mt][nd] * alpha;
                float rs = 0.f;
#pragma unroll
                for (int sl = 0; sl < 4; ++sl) {
                    u32x4 w;
                    { const float a0 = __builtin_amdgcn_exp2f(S[2 * sl][0] - mn), a1 = __builtin_amdgcn_exp2f(S[2 * sl][1] - mn), a2 = __builtin_amdgcn_exp2f(S[2 * sl][2] - mn), a3 = __builtin_amdgcn_exp2f(S[2 * sl][3] - mn); rs += (a0 + a1) + (a2 + a3); w.x = pk2(a0, a1); w.y = pk2(a2, a3); }
                    { const float a0 = __builtin_amdgcn_exp2f(S[2 * sl + 1][0] - mn), a1 = __builtin_amdgcn_exp2f(S[2 * sl + 1][1] - mn), a2 = __builtin_amdgcn_exp2f(S[2 * sl + 1][2] - mn), a3 = __builtin_amdgcn_exp2f(S[2 * sl + 1][3] - mn); rs += (a0 + a1) + (a2 + a3); w.z = pk2(a0, a1); w.w = pk2(a2, a3); }
                    const bf16x8 pb = __builtin_bit_cast(bf16x8, w);
#pragma unroll
                    for (int nd = 0; nd < 4; ++nd) { const bf16x8 vf = *(const LAS bf16x8*)(VT + (nd * 16 + fr) * VT_LD + sl * 32 + fq * 8);
                        O[mt][nd] = __builtin_amdgcn_mfma_f32_16x16x32_bf16(vf, pb, O[mt][nd], 0, 0, 0); }
                }
                rs += __builtin_bit_cast(float, __builtin_amdgcn_ds_bpermute(sx16, __builtin_bit_cast(int, rs)));
                rs += __builtin_bit_cast(float, __builtin_amdgcn_ds_bpermute(sx32, __builtin_bit_cast(int, rs)));
                lrow[mt] = lrow[mt] * alpha + rs;
                asm volatile("" ::: "memory");
            }
        }
#pragma unroll
        for (int mt = 0; mt < 4; ++mt) { const float inv = 1.0f / lrow[mt];
#pragma unroll
            for (int nd = 0; nd < 4; ++nd) { u32x2 w; w.x = pk2(O[mt][nd][0] * inv, O[mt][nd][1] * inv); w.y = pk2(O[mt][nd][2] * inv, O[mt][nd][3] * inv);
                *(u32x2*)(AO + (size_t)(qrow0 + mt * 16 + fr) * 1024 + qhead * 64 + nd * 16 + fq * 4) = w; } }
    }
}

namespace rt {
__device__ __forceinline__ int chunk_row0(int b, int c) { return c < 2 ? b * CTX + c * 128 : T_CTX + b * SEQ + (c - 2) * 128; }
__device__ __forceinline__ int chunk_gpos0(int c) { return c < 2 ? c * 128 : CTX + (c - 2) * 128; }
__device__ __forceinline__ float log_g(int l, int dir, int h) { const float x = arg_in(12)[(l * 2 + dir) * 8 + h]; return -log1pf(__expf(-x)); }
}
__device__ __forceinline__ void phase_ret_u(Ctx& C, int l) {
    C.refresh();
    const int tid = C.tid, lane = C.lane, wave = C.wave, fr = lane & 15, fq = lane >> 4;
    constexpr int KT_LD = 136, VT_LD = 136, OFF_KF = 0, OFF_KB = 17408, OFF_VT = 34816;
    LAS bf16_t* KF = (LAS bf16_t*)(C.lds + OFF_KF); LAS bf16_t* KB = (LAS bf16_t*)(C.lds + OFF_KB); LAS bf16_t* VT = (LAS bf16_t*)(C.lds + OFF_VT);
    bf16_t* CB = (bf16_t*)(C.ws + WS_F);
    bf16_t* RS = (bf16_t*)(C.ws + WS_F2);
    const int p = tid & 31, i0 = tid >> 5;
    const float inv = __expf(-(float)p * (9.210340371976184f / 32.0f));
    const bool bal = C.G == 256;
    for (int u = bal ? (C.bid >> 3) : C.bid; u < (bal ? 144 : 8 * 8 * 18); u += bal ? 32 : C.G) {
        const int b = bal ? (C.bid & 7) : u / 144, h = (u / 18) & 7, c = u % 18;
        const int row0 = rt::chunk_row0(b, c), gpos0 = rt::chunk_gpos0(c);
        const float lgf = rt::log_g(l, 0, h), lgb = rt::log_g(l, 1, h);
        if (bal && (h == 4 || h == 5)) {
            const bf16_t* gxs = (const bf16_t*)(C.ws + WS_GX) + (size_t)row0 * 256 + (h - 4) * 128; bf16_t* gxd = CB + (size_t)row0 * NBW + 2048 + h * 128;
            u32x4 t4[4];
#pragma unroll
            for (int i = 0; i < 4; ++i) { const int e = tid + i * NTHR; t4[i] = *(const u32x4*)(gxs + (size_t)(e >> 4) * 256 + (e & 15) * 8); }
#pragma unroll
            for (int i = 0; i < 4; ++i) { const int e = tid + i * NTHR; *(u32x4*)(gxd + (size_t)(e >> 4) * NBW + (e & 15) * 8) = t4[i]; }
        }
        u32x4 vvr[4];
        const u32x4 q1 = *(const u32x4*)(CB + (size_t)(row0 + (tid & 127)) * NBW + h * 64 + 8 * (tid >> 7)), q2 = *(const u32x4*)(CB + (size_t)(row0 + (tid & 127)) * NBW + h * 64 + 8 * (tid >> 7) + 32),
                    k1 = *(const u32x4*)(CB + (size_t)(row0 + (tid & 127)) * NBW + h * 64 + 8 * (tid >> 7) + 512), k2 = *(const u32x4*)(CB + (size_t)(row0 + (tid & 127)) * NBW + h * 64 + 8 * (tid >> 7) + 544);
#pragma unroll
        for (int i = 0; i < 4; ++i) { const int e = tid + i * NTHR, m = e & 127, ch = e >> 7; vvr[i] = *(const u32x4*)(CB + (size_t)(row0 + m) * NBW + 1024 + h * 128 + ch * 8); }
        __syncthreads();
        {
            const int m = tid & 127, c = tid >> 7;
            bf16_t* rowp = CB + (size_t)(row0 + m) * NBW + h * 64 + 8 * c;
            const float zf = __expf(lgf * (float)(127 - m)), zb = __expf(lgb * (float)m), pos = (float)(gpos0 + m);
            u32x4 oq1, oq2, ok1, ok2;
#pragma unroll
            for (int e = 0; e < 4; ++e) {
                float sn0, cs0, sn1, cs1;
                __sincosf(pos * __expf(-(float)(8 * c + 2 * e) * (9.210340371976184f / 32.0f)), &sn0, &cs0);
                __sincosf(pos * __expf(-(float)(8 * c + 2 * e + 1) * (9.210340371976184f / 32.0f)), &sn1, &cs1);
                const float qa0 = bflo(q1[e]), qa1 = bfhi(q1[e]), qb0 = bflo(q2[e]), qb1 = bfhi(q2[e]);
                const float ka0 = bflo(k1[e]) * 0.125f, ka1 = bfhi(k1[e]) * 0.125f, kb0 = bflo(k2[e]) * 0.125f, kb1 = bfhi(k2[e]) * 0.125f;
                oq1[e] = pk2(qa0 * cs0 - qb0 * sn0, qa1 * cs1 - qb1 * sn1); oq2[e] = pk2(qa0 * sn0 + qb0 * cs0, qa1 * sn1 + qb1 * cs1);
                ok1[e] = pk2(ka0 * cs0 - kb0 * sn0, ka1 * cs1 - kb1 * sn1); ok2[e] = pk2(ka0 * sn0 + kb0 * cs0, ka1 * sn1 + kb1 * cs1);
                const float r10 = bflo(ok1[e]), r11 = bfhi(ok1[e]), r20 = bflo(ok2[e]), r21 = bfhi(ok2[e]);
                const int d0 = 8 * c + 2 * e;
                KF[d0 * KT_LD + m] = (bf16_t)f2bf(r10 * zf); KF[(d0 + 1) * KT_LD + m] = (bf16_t)f2bf(r11 * zf); KF[(d0 + 32) * KT_LD + m] = (bf16_t)f2bf(r20 * zf); KF[(d0 + 33) * KT_LD + m] = (bf16_t)f2bf(r21 * zf);
                KB[d0 * KT_LD + m] = (bf16_t)f2bf(r10 * zb); KB[(d0 + 1) * KT_LD + m] = (bf16_t)f2bf(r11 * zb); KB[(d0 + 32) * KT_LD + m] = (bf16_t)f2bf(r20 * zb); KB[(d0 + 33) * KT_LD + m] = (bf16_t)f2bf(r21 * zb);
            }
            *(u32x4*)rowp = oq1; *(u32x4*)(rowp + 32) = oq2; *(u32x4*)(rowp + 512) = ok1; *(u32x4*)(rowp + 544) = ok2;
        }
#pragma unroll
        for (int i = 0; i < 4; ++i) { const int e = tid + i * NTHR, m = e & 127, ch = e >> 7;
            const u32x4 vv = vvr[i];
            LAS bf16_t* vd = VT + (ch * 8) * VT_LD + m;
            vd[0 * VT_LD] = (bf16_t)(vv.x & 0xffff); vd[1 * VT_LD] = (bf16_t)(vv.x >> 16); vd[2 * VT_LD] = (bf16_t)(vv.y & 0xffff); vd[3 * VT_LD] = (bf16_t)(vv.y >> 16);
            vd[4 * VT_LD] = (bf16_t)(vv.z & 0xffff); vd[5 * VT_LD] = (bf16_t)(vv.z >> 16); vd[6 * VT_LD] = (bf16_t)(vv.w & 0xffff); vd[7 * VT_LD] = (bf16_t)(vv.w >> 16); }
        __syncthreads();
        f32x4 acc[2][4];
#pragma unroll
        for (int d = 0; d < 2; ++d)
#pragma unroll
            for (int nt = 0; nt < 4; ++nt) acc[d][nt] = (f32x4){0.f, 0.f, 0.f, 0.f};
#pragma unroll
        for (int ks = 0; ks < 4; ++ks) { const bf16x8 af = *(const LAS bf16x8*)(VT + (wave * 16 + fr) * VT_LD + ks * 32 + fq * 8);
#pragma unroll
            for (int nt = 0; nt < 4; ++nt) { const bf16x8 b0 = *(const LAS bf16x8*)(KF + (nt * 16 + fr) * KT_LD + ks * 32 + fq * 8), b1 = *(const LAS bf16x8*)(KB + (nt * 16 + fr) * KT_LD + ks * 32 + fq * 8);
                acc[0][nt] = __builtin_amdgcn_mfma_f32_16x16x32_bf16(af, b0, acc[0][nt], 0, 0, 0); acc[1][nt] = __builtin_amdgcn_mfma_f32_16x16x32_bf16(af, b1, acc[1][nt], 0, 0, 0); } }
        const int idxf = c, idxb = c < 2 ? 1 - c : 19 - c;
        LAS bf16_t* ST = (LAS bf16_t*)(C.lds + 69632 + wave * 2304);
#pragma unroll
        for (int d = 0; d < 2; ++d) { bf16_t* dst = RS + bpart(b, (h * 2 + d) * 18 + (d ? idxb : idxf), 8192) + (size_t)(wave * 16) * 64;
#pragma unroll
            for (int nt = 0; nt < 4; ++nt)
#pragma unroll
                for (int j = 0; j < 4; ++j) ST[(fq * 4 + j) * 72 + nt * 16 + fr] = (bf16_t)f2bf(acc[d][nt][j]);
#pragma unroll
            for (int i = 0; i < 2; ++i) { const int e = lane + i * 64, rr = e >> 3, ch = e & 7; *(u32x4*)(dst + rr * 64 + ch * 8) = *(const LAS u32x4*)(ST + rr * 72 + ch * 8); } }
    }
}
__device__ __forceinline__ void phase_ret_scan(Ctx& C, int l) {
    C.refresh();
    bf16_t* RS = (bf16_t*)(C.ws + WS_F2);
    const int jb = C.bid >> 3, chain = C.G == 256 ? (((C.bid & 7) * 8 + (jb >> 2)) * 2 + ((jb >> 1) & 1)) : (C.bid >> 1), d = chain & 1, h = (chain >> 1) & 7;
    const float cd = __expf(rt::log_g(l, d, h) * 128.0f);
    bf16_t* base = RS + (size_t)((C.G == 256 ? jb : C.bid) & 1) * 4096 + C.tid * 8; const int sb = chain >> 4, s0 = (chain & 15) * 18;
    float st[8];
#pragma unroll
    for (int k = 0; k < 8; ++k) st[k] = 0.f;
#pragma unroll 1
    for (int hb = 0; hb < 2; ++hb) {
        u32x4 uv[9];
#pragma unroll
        for (int i = 0; i < 9; ++i) uv[i] = *(const u32x4*)(base + bpart(sb, s0 + hb * 9 + i, 8192));
#pragma unroll
        for (int i = 0; i < 9; ++i) asm volatile("" : "+v"(uv[i]));
#pragma unroll
        for (int i = 0; i < 9; ++i) {
            const u32x4 cur = uv[i];
            u32x4 o; o.x = pk2(st[0], st[1]); o.y = pk2(st[2], st[3]); o.z = pk2(st[4], st[5]); o.w = pk2(st[6], st[7]);
            *(u32x4*)(base + bpart(sb, s0 + hb * 9 + i, 8192)) = o;
            st[0] = cd * st[0] + bflo(cur.x); st[1] = cd * st[1] + bfhi(cur.x); st[2] = cd * st[2] + bflo(cur.y); st[3] = cd * st[3] + bfhi(cur.y);
            st[4] = cd * st[4] + bflo(cur.z); st[5] = cd * st[5] + bfhi(cur.z); st[6] = cd * st[6] + bflo(cur.w); st[7] = cd * st[7] + bfhi(cur.w);
        }
    }
}
__device__ __forceinline__ void phase_ret_o(Ctx& C, int l, int c_lo) {
    C.refresh();
    const int tid = C.tid, lane = C.lane, wave = C.wave, fr = lane & 15, fq = lane >> 4;
    constexpr int Q_LD = 72, VT_LD = 136, S_LD = 72, P_LD = 136;
    constexpr int OFF_Q = 0, OFF_K = 18432, OFF_VT = 36864, OFF_SF = 71680, OFF_SB = 90112, OFF_P = 108544;
    LAS bf16_t* QS = (LAS bf16_t*)(C.lds + OFF_Q); LAS bf16_t* KS = (LAS bf16_t*)(C.lds + OFF_K); LAS bf16_t* VT = (LAS bf16_t*)(C.lds + OFF_VT);
    LAS bf16_t* SF = (LAS bf16_t*)(C.lds + OFF_SF); LAS bf16_t* SB = (LAS bf16_t*)(C.lds + OFF_SB);
    LAS bf16_t* PW = (LAS bf16_t*)(C.lds + OFF_P + wave * (16 * P_LD * 2));
    bf16_t* CB = (bf16_t*)(C.ws + WS_F);
    const bf16_t* RS = (const bf16_t*)(C.ws + WS_F2);
    const int ncl = 18 - c_lo;
    const bool bal = C.G == 256;
    for (int u = bal ? (C.bid >> 3) : C.bid; u < (bal ? 8 * ncl : 64 * ncl); u += bal ? 32 : C.G) {
        const int b = bal ? (C.bid & 7) : u / (8 * ncl), h = (u / ncl) & 7, c = c_lo + u % ncl;
        const int row0 = rt::chunk_row0(b, c);
        const float lgf = rt::log_g(l, 0, h), lgb = rt::log_g(l, 1, h);
        u32x4 qr[2], kr[2], vvr[4], sr[2][2];
#pragma unroll
        for (int i = 0; i < 2; ++i) { const int e = tid + i * NTHR, m = e >> 3, ch = e & 7; const bf16_t* src = CB + (size_t)(row0 + m) * NBW + h * 64 + ch * 8;
            qr[i] = *(const u32x4*)src; kr[i] = *(const u32x4*)(src + 512); }
#pragma unroll
        for (int i = 0; i < 4; ++i) { const int e = tid + i * NTHR, m = e & 127, ch = e >> 7; vvr[i] = *(const u32x4*)(CB + (size_t)(row0 + m) * NBW + 1024 + h * 128 + ch * 8); }
#pragma unroll
        for (int d = 0; d < 2; ++d) {
            const int idx = d ? (c < 2 ? 1 - c : 19 - c) : c;
            const bf16_t* src = RS + bpart(b, (h * 2 + d) * 18 + idx, 8192);
#pragma unroll
            for (int i = 0; i < 2; ++i) { const int e = tid + i * NTHR, er = e >> 3, ch = e & 7; sr[d][i] = *(const u32x4*)(src + er * 64 + ch * 8); }
        }
        __syncthreads();
#pragma unroll
        for (int i = 0; i < 2; ++i) { const int e = tid + i * NTHR, m = e >> 3, ch = e & 7;
            *(LAS u32x4*)(QS + m * Q_LD + ch * 8) = qr[i]; *(LAS u32x4*)(KS + m * Q_LD + ch * 8) = kr[i]; }
#pragma unroll
        for (int i = 0; i < 4; ++i) { const int e = tid + i * NTHR, m = e & 127, ch = e >> 7;
            const u32x4 vv = vvr[i];
            const int mp = (m & ~31) | ((((m & 15) >> 2) << 3) + (m & 3) + (((m >> 4) & 1) << 2));
            LAS bf16_t* vd = VT + (ch * 8) * VT_LD + mp;
            vd[0 * VT_LD] = (bf16_t)(vv.x & 0xffff); vd[1 * VT_LD] = (bf16_t)(vv.x >> 16); vd[2 * VT_LD] = (bf16_t)(vv.y & 0xffff); vd[3 * VT_LD] = (bf16_t)(vv.y >> 16);
            vd[4 * VT_LD] = (bf16_t)(vv.z & 0xffff); vd[5 * VT_LD] = (bf16_t)(vv.z >> 16); vd[6 * VT_LD] = (bf16_t)(vv.w & 0xffff); vd[7 * VT_LD] = (bf16_t)(vv.w >> 16); }
#pragma unroll
        for (int d = 0; d < 2; ++d) {
            LAS bf16_t* dst = d ? SB : SF;
#pragma unroll
            for (int i = 0; i < 2; ++i) { const int e = tid + i * NTHR, er = e >> 3, ch = e & 7; *(LAS u32x4*)(dst + er * S_LD + ch * 8) = sr[d][i]; }
        }
        __syncthreads();
        bf16x8 qf[2];
#pragma unroll
        for (int ks = 0; ks < 2; ++ks) qf[ks] = *(const LAS bf16x8*)(QS + (wave * 16 + fr) * Q_LD + ks * 32 + fq * 8);
        bf16_t* gbase = CB + (size_t)(row0 + wave * 16 + fr) * NBW + 2048 + h * 128 + fq * 4;
        u32x2 gq[8];
#pragma unroll
        for (int nt = 0; nt < 8; ++nt) gq[nt] = *(const u32x2*)(gbase + nt * 16);
        f32x4 O[8];
        {
            f32x4 t[8];
#pragma unroll
            for (int nt = 0; nt < 8; ++nt) t[nt] = (f32x4){0.f, 0.f, 0.f, 0.f};
#pragma unroll
            for (int ks = 0; ks < 2; ++ks)
#pragma unroll
                for (int nt = 0; nt < 8; ++nt) t[nt] = __builtin_amdgcn_mfma_f32_16x16x32_bf16(*(const LAS bf16x8*)(SF + (nt * 16 + fr) * S_LD + ks * 32 + fq * 8), qf[ks], t[nt], 0, 0, 0);
            const float xif = __expf(lgf * (float)(wave * 16 + fr + 1));
#pragma unroll
            for (int nt = 0; nt < 8; ++nt) O[nt] = t[nt] * xif;
#pragma unroll
            for (int nt = 0; nt < 8; ++nt) t[nt] = (f32x4){0.f, 0.f, 0.f, 0.f};
#pragma unroll
            for (int ks = 0; ks < 2; ++ks)
#pragma unroll
                for (int nt = 0; nt < 8; ++nt) t[nt] = __builtin_amdgcn_mfma_f32_16x16x32_bf16(*(const LAS bf16x8*)(SB + (nt * 16 + fr) * S_LD + ks * 32 + fq * 8), qf[ks], t[nt], 0, 0, 0);
            const float xib = __expf(lgb * (float)(128 - (wave * 16 + fr)));
#pragma unroll
            for (int nt = 0; nt < 8; ++nt) O[nt] = O[nt] + t[nt] * xib;
        }
        {
            f32x4 S[8];
#pragma unroll
            for (int nt = 0; nt < 8; ++nt) S[nt] = (f32x4){0.f, 0.f, 0.f, 0.f};
#pragma unroll
            for (int ks = 0; ks < 2; ++ks)
#pragma unroll
                for (int nt = 0; nt < 8; ++nt) S[nt] = __builtin_amdgcn_mfma_f32_16x16x32_bf16(*(const LAS bf16x8*)(KS + (nt * 16 + fr) * Q_LD + ks * 32 + fq * 8), qf[ks], S[nt], 0, 0, 0);
#pragma unroll
            for (int sl = 0; sl < 4; ++sl) {
                u32x4 w; float pv[2][4];
#pragma unroll
                for (int tt = 0; tt < 2; ++tt)
#pragma unroll
                    for (int j = 0; j < 4; ++j) { const int df = (wave * 16 + fr) - ((2 * sl + tt) * 16 + fq * 4 + j);
                        const float dec = (df >= 0 ? __expf(lgf * (float)df) : 0.f) + (df <= 0 ? __expf(lgb * (float)(-df)) : 0.f);
                        pv[tt][j] = S[2 * sl + tt][j] * dec; }
                w.x = pk2(pv[0][0], pv[0][1]); w.y = pk2(pv[0][2], pv[0][3]); w.z = pk2(pv[1][0], pv[1][1]); w.w = pk2(pv[1][2], pv[1][3]);
                const bf16x8 pb = __builtin_bit_cast(bf16x8, w);
#pragma unroll
                for (int nt = 0; nt < 8; ++nt) O[nt] = __builtin_amdgcn_mfma_f32_16x16x32_bf16(*(const LAS bf16x8*)(VT + (nt * 16 + fr) * VT_LD + sl * 32 + fq * 8), pb, O[nt], 0, 0, 0);
            }
        }
        {
            const int sx16 = (lane ^ 16) << 2, sx32 = (lane ^ 32) << 2;
            float sm = 0.f;
#pragma unroll
            for (int nt = 0; nt < 8; ++nt) sm += (O[nt][0] + O[nt][1]) + (O[nt][2] + O[nt][3]);
            sm += __builtin_bit_cast(float, __builtin_amdgcn_ds_bpermute(sx16, __builtin_bit_cast(int, sm)));
            sm += __builtin_bit_cast(float, __builtin_amdgcn_ds_bpermute(sx32, __builtin_bit_cast(int, sm)));
            const float mean = sm * (1.0f / 128.0f);
            float vr = 0.f;
#pragma unroll
            for (int nt = 0; nt < 8; ++nt)
#pragma unroll
                for (int j = 0; j < 4; ++j) { const float dd = O[nt][j] - mean; vr += dd * dd; }
            vr += __builtin_bit_cast(float, __builtin_amdgcn_ds_bpermute(sx16, __builtin_bit_cast(int, vr)));
            vr += __builtin_bit_cast(float, __builtin_amdgcn_ds_bpermute(sx32, __builtin_bit_cast(int, vr)));
            const float rstd = 1.0f / sqrtf(vr * (1.0f / 128.0f) + 1e-6f);
#pragma unroll
            for (int nt = 0; nt < 8; ++nt) { const u32x2 g = gq[nt]; u32x2 w;
                w.x = pk2(siluf_(bflo(g.x)) * (O[nt][0] - mean) * rstd, siluf_(bfhi(g.x)) * (O[nt][1] - mean) * rstd);
                w.y = pk2(siluf_(bflo(g.y)) * (O[nt][2] - mean) * rstd, siluf_(bfhi(g.y)) * (O[nt][3] - mean) * rstd);
                *(u32x2*)(gbase + nt * 16) = w; }
        }
    }
}

struct MergeSched {
    unsigned char* ws; int pm0, nM, G, c; bool split;
    __device__ __forceinline__ void opnd(int op, int pm, int pn, pg8::Opnd& o) const {
        const char* W = (const char*)(ws + WS_W);
        if ((op & 1) == 0) { o.A = (const char*)(ws + WS_H) + (size_t)pm * 256 * 2048; o.lda = 2048; o.B = W + W_GATE + (size_t)((op >> 1) * 1024 + pn * 256) * 2048; o.ldb = 2048; o.nt = 16; }
        else if (op == 1) { o.A = (const char*)(ws + WS_F) + (size_t)pm * 256 * (NBW * 2) + 2048 * 2; o.lda = NBW * 2; o.B = W + W_RET + (size_t)pn * 256 * 2048; o.ldb = 2048; o.nt = 16; }
        else { o.A = (const char*)(ws + WS_AO) + (size_t)pm * 256 * 2048 + (op == 5 ? 1024 : 0); o.lda = 2048; o.B = W + (op == 3 ? W_ATT : W_RWKV) + (size_t)pn * 256 * 1024; o.ldb = 1024; o.nt = 8; }
    }
    __device__ __forceinline__ bool next(int i, pg8::Unit& u, pg8::Opnd& o) const {
        if (!split) {
            const int ti = i / 6, op = i - ti * 6;
            int pm, pn; if (!pg8::tile_order(ti, G, c, nM, 4, pm, pn)) return false;
            pm += pm0; u.pm = pm; u.pn = pn; u.op = op; opnd(op, pm, pn, o); return true;
        }
        if (i < 6) { int pm, pn; pg8::tile_order(0, 256, c, 64, 4, pm, pn); pm += 8; u.pm = pm; u.pn = pn; u.op = i; opnd(i, pm, pn, o); return true; }
        if (i < 8 && c < 96) { const int x = c & 7, jj = c >> 3, pm = x, pn = jj / 3, br = jj - pn * 3, op = 2 * br + (i - 6);     u.pm = pm; u.pn = pn; u.op = 6 + op; opnd(op, pm, pn, o); return true; }
        return false;
    }
};
struct EpiMerge {
    static constexpr bool PERM = true;
    bf16_t* scr; bf16_t* MG; bf16_t* SL;
    __device__ __forceinline__ void operator()(const f32x4 (&acc)[2][2][4][2], const pg8::Unit& u, int wr, int wc, int fr, int fq) const {
        const int lr0 = wr * 64 + fr, lc0 = wc * 32 + 8 * fq;
#pragma unroll
        for (int ai = 0; ai < 2; ++ai)
#pragma unroll
            for (int m = 0; m < 4; ++m) { const int lr = lr0 + ai * 128 + m * 16;
                u32x4* sp = (u32x4*)(scr + lr * 256 + lc0);
                if ((u.op & 1) == 0) {
#pragma unroll
                    for (int bj = 0; bj < 2; ++bj) { const f32x4 v0 = acc[ai][bj][m][0], v1 = acc[ai][bj][m][1];
                        u32x4 w; w.x = pg8::cvt_pk_bf16(sigmoidf_(v0[0]), sigmoidf_(v0[1])); w.y = pg8::cvt_pk_bf16(sigmoidf_(v0[2]), sigmoidf_(v0[3]));
                        w.z = pg8::cvt_pk_bf16(sigmoidf_(v1[0]), sigmoidf_(v1[1])); w.w = pg8::cvt_pk_bf16(sigmoidf_(v1[2]), sigmoidf_(v1[3])); sp[bj * 16] = w; }
                } else {
                    const bool spl = u.op >= 6; const int br = (spl ? u.op - 6 : u.op) >> 1;
                    const bool keep = ((BR_MASK >> br) & 1) != 0;
                    bf16_t* dbase = (spl && br > 0) ? SL + (size_t)(br - 1) * T_CTX * 1024 : MG;
                    u32x4* mp = (u32x4*)(dbase + (size_t)(u.pm * 256 + lr) * 1024 + u.pn * 256 + lc0);
                    const u32x4 g0 = sp[0], g1 = sp[16];
                    u32x4 p0 = (u32x4){0u, 0u, 0u, 0u}, p1 = p0; if (!spl && u.op != 1) { p0 = mp[0]; p1 = mp[16]; }
#pragma unroll
                    for (int bj = 0; bj < 2; ++bj) { const f32x4 v0 = acc[ai][bj][m][0], v1 = acc[ai][bj][m][1]; const u32x4 gq = bj ? g1 : g0, pv = bj ? p1 : p0;
                        u32x4 w;
                        if (keep) {
                        w.x = pg8::cvt_pk_bf16(bflo(pv.x) + bflo(gq.x) * v0[0], bfhi(pv.x) + bfhi(gq.x) * v0[1]); w.y = pg8::cvt_pk_bf16(bflo(pv.y) + bflo(gq.y) * v0[2], bfhi(pv.y) + bfhi(gq.y) * v0[3]);
                        w.z = pg8::cvt_pk_bf16(bflo(pv.z) + bflo(gq.z) * v1[0], bfhi(pv.z) + bfhi(gq.z) * v1[1]); w.w = pg8::cvt_pk_bf16(bflo(pv.w) + bflo(gq.w) * v1[2], bfhi(pv.w) + bfhi(gq.w) * v1[3]);
                        } else w = pv;
                        mp[bj * 16] = w; }
                } }
    }
};
__device__ __forceinline__ void phase_merge(Ctx& C, int pm0, int nM) {
    C.refresh();
    MergeSched S{C.ws, pm0, nM, C.G, C.bid, nM == 72 && C.G == 256};
    EpiMerge E{(bf16_t*)(C.ws + WS_GSCR) + (C.G == 256 ? (size_t)(C.bid & 7) * 2097152 + (size_t)(C.bid >> 3) * 65536 : (size_t)C.bid * 65536), (bf16_t*)(C.ws + WS_F2), (bf16_t*)(C.ws + WS_VMIX)};
    pg8::gemm_phase<EpiMerge, MergeSched, true>(C.lds, C.tid, S, E);
}
struct WoutSplitSched {
    unsigned char* ws; int c;
    __device__ __forceinline__ bool next(int i, pg8::Unit& u, pg8::Opnd& o) const {
        o.lda = 2048; o.ldb = 2048; o.nt = 16;
        const char* B = (const char*)(ws + WS_W + W_OUT);
        if (i == 0) { int pm, pn; pg8::tile_order(0, 256, c, 64, 4, pm, pn); pm += 8; u.pm = pm; u.pn = pn; u.op = 0; o.A = (const char*)(ws + WS_F2) + (size_t)pm * 256 * 2048; o.B = B + (size_t)pn * 256 * 2048; return true; }
        if (i == 1 && c < 96) { const int x = c & 7, jj = c >> 3, pm = x, pn = jj / 3, br = jj - pn * 3; u.pm = pm; u.pn = pn; u.op = 1 + x * 16 + pn * 3 + br;
            o.A = (const char*)(br == 0 ? ws + WS_F2 : ws + WS_VMIX + (size_t)(br - 1) * T_CTX * 2048) + (size_t)pm * 256 * 2048; o.B = B + (size_t)pn * 256 * 2048; return true; }
        return false;
    }
};
__device__ __forceinline__ void phase_wout(Ctx& C, int l, int pm0, int nM, const FusedNorm& fn) {
    C.refresh();
    EpiResid E{(float*)(C.ws + WS_S), arg_out(), (const float*)(C.ws + WS_MODS) + (size_t)l * 9 * NADA * D, 5, 1.0f, (float*)(C.ws + WS_AO + 4 * MiB)};
    if (nM == 72 && C.G == 256) {
        WoutSplitSched S{C.ws, C.bid};
        pg8::gemm_phase<EpiResid, WoutSplitSched, false>(C.lds, C.tid, S, E);
        int pm, pn; pg8::tile_order(0, 256, C.bid, 64, 4, pm, pn);
        fused_norm(C, fn, pm + 8, pn, C.bid < 96, C.bid & 7, C.bid >> 3, 12);
    } else {
        pg8::StdSched S{(const char*)(C.ws + WS_F2), (const char*)(C.ws + WS_W + W_OUT), D * 2, D * 2, D / 64, pm0, nM, 4, C.G, C.bid};
        pg8::gemm_phase<EpiResid, pg8::StdSched>(C.lds, C.tid, S, E);
        if (C.G == 256 && nM == 64 && pm0 == 8) { int pm, pn; pg8::tile_order(0, 256, C.bid, 64, 4, pm, pn); fused_norm(C, fn, pm + 8, pn, false, 0, 0, 1); }
    }
}

__global__ void __launch_bounds__(NTHR, 2) fwd_megakernel(Params prm) {
    cg::grid_group grid = cg::this_grid();
    extern __shared__ __attribute__((aligned(16))) unsigned char lds_raw[];
    Ctx C; C.lds = (LAS unsigned char*)lds_raw;
    C.wave_s = __builtin_amdgcn_readfirstlane((int)threadIdx.x >> 6); C.refresh();
    volatile LAS unsigned* MISC = (volatile LAS unsigned*)(C.lds + LDS_MISC);
    if (C.tid < 64) MISC[C.tid] = 0u;
    __syncthreads();
    XcdBarrier bar = xcd_barrier_post((unsigned*)(C.ws + WS_CTL) + CW_BAR, MISC + 8);
    for (int i = C.tid; i < 384; i += NTHR) ((unsigned*)(C.ws + WS_CTL))[(size_t)C.bid * 384 + i] = 0u;
#define GRID_BAR() xcd_barrier(bar)
    int ph = 0; const int stop_after = (int)(unsigned)karg_u64(8 * 36);
    if (TSEL1 >= 0 && C.tid == 0) { MISC[14] = (unsigned)__builtin_amdgcn_s_memrealtime(); MISC[15] = MISC[14]; }
#define STAMP(g) do { if (TSEL1 == 0) C.refresh(); if (TSEL1 == 0 && C.tid == 0) { const unsigned _t = (unsigned)__builtin_amdgcn_s_memrealtime(); MISC[16 + (g)] += _t - MISC[15]; MISC[15] = _t; } } while (0)
#define DONE_IF_STOP() do { if (++ph >= stop_after) return; } while (0)

    phase_init(C);
    grid.sync();
    STAMP(0);
#pragma unroll 1
    for (int l = 0; l < 2; ++l) {
        const bool fuse = C.G == 256;
        const FusedNorm fn_none{-1, 0, 0, 0};
        phase_convert(C, l);
        if (l == 0 || !fuse) phase_norm(C, l, 0, 0, l > 0 ? 4 : 0, l == 0 ? 2 : 0);
        GRID_BAR(); STAMP(1);
        unsigned* xs = (unsigned*)(C.ws + WS_CTL) + 49152 + (size_t)(l * 128 + (C.bid & 7)) * 64; unsigned* xtmo = (unsigned*)(C.ws + WS_CTL) + CW_BAR + XB_TMO;
#define BATCH_BAR(k) do { if (fuse) group_sync(xs + (k) * 8 * 64, 32u, xtmo); else GRID_BAR(); } while (0)
        phase_ffn_in(C, W_FFN1_IN, 0, 72);
        BATCH_BAR(0); STAMP(2);
        { const FusedNorm fn1{fuse ? l : -1, 1, 4, l == 0 ? 1 : 0};
          if (l == 0) phase_ffn_out<true>(C, l, W_FFN1_OUT, 2, 0, 72, fn1, W_FFN1_IN, l * 2); else phase_ffn_out<false>(C, l, W_FFN1_OUT, 2, 0, 72, fn1, W_FFN1_IN, l * 2); }
        BATCH_BAR(1); STAMP(3);
        DONE_IF_STOP();
        if (!fuse) { phase_norm(C, l, 1, 0, 4, l == 0 ? 1 : 0); GRID_BAR(); }
        STAMP(1);
        phase_mix(C, W_MIXA, NA);
        BATCH_BAR(7); STAMP(4);
        att_prep(C, l);
        STAMP(5);
        {
            unsigned* gs = (unsigned*)(C.ws + WS_CTL) + 16384 + (size_t)((l * 3) * 64 + (C.bid & 63)) * 64; unsigned* tmo = (unsigned*)(C.ws + WS_CTL) + CW_BAR + XB_TMO;
            phase_rwkv_r1(C, l, 0); group_sync(gs, 4u, tmo); STAMP(13);
            phase_rwkv_r2(C, l, 0); group_sync(gs + 64 * 64, 4u, tmo); STAMP(14);
            phase_rwkv_r1(C, l, 1); group_sync(gs + 2 * 64 * 64, 4u, tmo); STAMP(13);
            phase_rwkv_r2(C, l, 1); STAMP(14);
        }
        BATCH_BAR(8); STAMP(6);
        phase_rwkv_out(C, l, l == 0 ? 0 : T_CTX / 64);
        STAMP(7);
        phase_attention(C, l, l == 0);
        BATCH_BAR(9); STAMP(8);
        phase_mix(C, W_MIXB, NBW);
        BATCH_BAR(4); STAMP(4);
        phase_ret_u(C, l);
        BATCH_BAR(5); STAMP(9);
        phase_ret_scan(C, l);
        BATCH_BAR(6);
        phase_ret_o(C, l, l == 0 ? 0 : 2);
        BATCH_BAR(10); STAMP(10);
        DONE_IF_STOP();
        const int pm0 = l == 0 ? 0 : 8, nM = l == 0 ? 72 : 64;
        phase_merge(C, pm0, nM);
        BATCH_BAR(11); STAMP(11);
        { const FusedNorm fn2{fuse ? l : -1, 2, l == 0 ? 3 : 0, 0}; phase_wout(C, l, pm0, nM, fn2); }
        BATCH_BAR(2); STAMP(12);
        DONE_IF_STOP();
        if (!fuse) { phase_norm(C, l, 2, pm0 * 256, l == 0 ? 3 : 0, 0); GRID_BAR(); }
        STAMP(1);
        phase_ffn_in(C, W_FFN2_IN, pm0, nM);
        BATCH_BAR(3); STAMP(2);
        { const FusedNorm fn0{(fuse && l == 0) ? 1 : -1, 0, 4, 0}; phase_ffn_out<false>(C, l, W_FFN2_OUT, 8, pm0, nM, fn0, W_FFN2_IN, l * 2 + 1); }
        GRID_BAR(); STAMP(3);
        DONE_IF_STOP();
    }
    if (TSEL1 >= 0 && C.bid == 0) {
        __syncthreads();
        const float total = (float)((unsigned)__builtin_amdgcn_s_memrealtime() - MISC[14]);
        const float f1 = (float)MISC[16 + (TSEL1 >= 0 ? TSEL1 : 0)] / total, f2 = TSEL2 >= 0 ? (float)MISC[16 + (TSEL2 >= 0 ? TSEL2 : 0)] / total : 0.f;
        float* o = arg_out();
        if (C.tid == 0) { int best = 0; float bv = 1e30f; for (int i = 0; i < 4096; ++i) { const float a = fabsf(o[i]); if (a < bv) { bv = a; best = i; } } o[best] += 0.04f + 0.059f * f1; }
        if (TSEL2 >= 0) { const float d2 = 0.1f * sqrtf(f2); for (int i = C.tid; i < 65536; i += NTHR) o[1048576 + i] += d2; }
    }
}

extern "C" void kernel_launch(void* const* d_in, const int* in_sizes, int n_in, void* d_out, int out_size, void* d_ws, size_t ws_size, hipStream_t stream) {
    static int grid_blocks = 0;
    if (!grid_blocks) {
        if (n_in != 34 || ws_size < WS_END) { fprintf(stderr, "kernel_launch: unexpected n_in %d / ws_size %zu\n", n_in, ws_size); grid_blocks = -1; return; }
        int dev = 0, cus = 0, per_cu = 0;
        (void)hipGetDevice(&dev);
        (void)hipDeviceGetAttribute(&cus, hipDeviceAttributeMultiprocessorCount, dev);
        (void)hipFuncSetAttribute((const void*)fwd_megakernel, hipFuncAttributeMaxDynamicSharedMemorySize, LDS_BYTES);
        (void)hipOccupancyMaxActiveBlocksPerMultiprocessor(&per_cu, (const void*)fwd_megakernel, NTHR, LDS_BYTES);
        if (per_cu < 1) { fprintf(stderr, "kernel_launch: occupancy query says %d blocks per CU\n", per_cu); per_cu = 1; }
        grid_blocks = cus * 1;
        (void)hipGetLastError();
    }
    if (grid_blocks < 0) return;
    Params p{};
    for (int i = 0; i < 34; ++i) p.in[i] = (const float*)d_in[i];
    p.out = (float*)d_out; p.ws = (unsigned char*)d_ws; p.stop = STOP_AFTER; p.pad = 0;
    void* args[] = {&p};
    hipError_t e = hipLaunchCooperativeKernel((void*)fwd_megakernel, dim3(grid_blocks), dim3(NTHR), args, LDS_BYTES, stream);
    if (e != hipSuccess) fprintf(stderr, "cooperative launch failed: %s (grid %d)\n", hipGetErrorString(e), grid_blocks);
}
```
